# Optimizing an MI355X kernel written in HIP

```python
import jax, jax.numpy as jnp
from jax import lax
import numpy as np

D_MODEL = 1024
BATCH = 4
SEQ = 8192
DEPTH = 1

MIX_WIDTH = D_MODEL
CONV_WIDTH = MIX_WIDTH // 2
CONV_GROUPS = 8
CONV_K = 3
HGRN_WIDTH = MIX_WIDTH - CONV_WIDTH
HGRN_HEAD_DIM = 128
HGRN_HEADS = HGRN_WIDTH // HGRN_HEAD_DIM
CHUNK = 64
IN_COLS = 3 * CONV_WIDTH + 4 * HGRN_WIDTH
N_MEM = 256
MEM_HEADS = 4
MEM_HEAD_DIM = D_MODEL // MEM_HEADS
PEER_HEADS = 8
PEER_N_KEYS = 128
PEER_N_EXPERTS = PEER_N_KEYS * PEER_N_KEYS
PEER_DK = 128
PEER_TOPK = 16
PEER_BLOCK = 128
EPS = 1e-6

kernel_name = "hymba_conv_hgrn2_memxattn_peer"


def rmsnorm(x, w):
    xf = x.astype(jnp.float32)
    y = xf * lax.rsqrt(jnp.mean(xf * xf, axis=-1, keepdims=True) + EPS)
    return (y * w.astype(jnp.float32)).astype(x.dtype)


def short_conv_mixer(b_gate, c_gate, v, conv_w):
    T = v.shape[1]
    u = c_gate * v
    up = jnp.pad(u, ((0, 0), (CONV_K - 1, 0), (0, 0)))
    y = up[:, 0:T] * conv_w[0]
    for j in range(1, CONV_K):
        y = y + up[:, j:j + T] * conv_w[j]
    return b_gate * y


def hgrn2_mixer(q, f, i, g, lb, norm_w):
    B, T, _ = q.shape
    H, Dh, C = HGRN_HEADS, HGRN_HEAD_DIM, CHUNK
    N = T // C
    f32 = jnp.float32
    qa = jax.nn.silu(q.astype(f32))
    fg = lb.astype(f32) + (1.0 - lb.astype(f32)) * jax.nn.sigmoid(f.astype(f32))
    k = 1.0 - fg
    logf = jnp.log(fg)

    def heads(a):
        return a.reshape(B, N, C, H, Dh).transpose(0, 3, 1, 2, 4)

    qh, kh, lh, vh = heads(qa), heads(k), heads(logf), heads(i.astype(f32))
    G = jnp.cumsum(lh, axis=3)
    G_last = G[:, :, :, -1:]
    q_dec = qh * jnp.exp(G)
    k_inv = kh * jnp.exp(-G)
    k_to_end = kh * jnp.exp(G_last - G)
    causal = jnp.tril(jnp.ones((C, C), dtype=bool))
    A = jnp.where(causal, jnp.einsum('bhnck,bhnsk->bhncs', q_dec, k_inv), 0.0)
    o_intra = jnp.einsum('bhncs,bhnsv->bhncv', A, vh)
    U = jnp.einsum('bhnck,bhncv->bhnkv', k_to_end, vh)
    decay = jnp.exp(G_last[:, :, :, 0])

    def step(S, xs):
        d_n, U_n = xs
        return d_n[..., None] * S + U_n, S

    S0 = jnp.zeros((B, H, Dh, Dh), f32)
    _, S_start = lax.scan(step, S0, (jnp.moveaxis(decay, 2, 0), jnp.moveaxis(U, 2, 0)))
    S_start = jnp.moveaxis(S_start, 0, 2)
    o = o_intra + jnp.einsum('bhnck,bhnkv->bhncv', q_dec, S_start)
    o = o.transpose(0, 2, 3, 1, 4).reshape(B, T, H, Dh)
    o = o * lax.rsqrt(jnp.mean(o * o, axis=-1, keepdims=True) + EPS)
    o = o.reshape(B, T, H * Dh) * norm_w.astype(f32) * jax.nn.silu(g.astype(f32))
    return o.astype(q.dtype)


def memory_cross_attention(h, mem_n, wq, wkv, wo):
    B, T, _ = h.shape
    M = mem_n.shape[1]
    q = (h @ wq).reshape(B, T, MEM_HEADS, MEM_HEAD_DIM)
    kv = mem_n @ wkv
    k = kv[..., :D_MODEL].reshape(B, M, MEM_HEADS, MEM_HEAD_DIM)
    v = kv[..., D_MODEL:].reshape(B, M, MEM_HEADS, MEM_HEAD_DIM)
    s = jnp.einsum('bthd,bmhd->bhtm', q, k).astype(jnp.float32) * (MEM_HEAD_DIM ** -0.5)
    p = jax.nn.softmax(s, axis=-1).astype(v.dtype)
    o = jnp.einsum('bhtm,bmhd->bthd', p, v).reshape(B, T, D_MODEL)
    return o @ wo


def peer_ffn(h, w_query, sub_keys, expert_down, expert_up):
    B, T, D = h.shape
    Ntok = B * T
    K = PEER_TOPK
    tokens = h.reshape(Ntok, D)
    q = (tokens @ w_query).reshape(Ntok, PEER_HEADS, 2, PEER_DK)
    s = jnp.einsum('nhpd,hpkd->nhpk', q, sub_keys).astype(jnp.float32)
    s_top, i_top = lax.top_k(s, K)
    cand = (s_top[:, :, 0, :, None] + s_top[:, :, 1, None, :]).reshape(Ntok, PEER_HEADS, K * K)
    cand_idx = (i_top[:, :, 0, :, None] * PEER_N_KEYS + i_top[:, :, 1, None, :]).reshape(Ntok, PEER_HEADS, K * K)
    best, pos = lax.top_k(cand, K)
    expert_idx = jnp.take_along_axis(cand_idx, pos, axis=-1)
    gate = jax.nn.softmax(best, axis=-1)
    nb = Ntok // PEER_BLOCK

    def block(args):
        xb, idx, gb = args
        u = jnp.take(expert_down, idx, axis=0)
        a = jax.nn.gelu(jnp.einsum('nd,nhkd->nhk', xb, u).astype(jnp.float32), approximate=False)
        w = (gb * a).astype(xb.dtype)
        v = jnp.take(expert_up, idx, axis=0)
        return jnp.einsum('nhk,nhkd->nd', w, v)

    out = lax.map(block, (tokens.reshape(nb, PEER_BLOCK, D),
                          expert_idx.reshape(nb, PEER_BLOCK, PEER_HEADS, K),
                          gate.reshape(nb, PEER_BLOCK, PEER_HEADS, K)))
    return out.reshape(B, T, D)


def setup_inputs(seed: int = 0) -> dict:
    key = jax.random.key(seed)
    ks = jax.random.split(key, 24)
    f32 = jnp.float32
    L, D = DEPTH, D_MODEL

    def nrm(k, shape, scale):
        return jax.random.normal(k, shape, f32) * scale

    def gain(k, shape):
        return 1.0 + 0.02 * jax.random.normal(k, shape, f32)

    return {
        "x": jax.random.normal(ks[0], (BATCH, SEQ, D), f32),
        "mem": jax.random.normal(ks[1], (BATCH, N_MEM, D), f32),
        "mix_norm_w": gain(ks[2], (L, D)),
        "w_in": nrm(ks[3], (L, D, IN_COLS), D ** -0.5),
        "conv_w": nrm(ks[4], (L, CONV_K, CONV_WIDTH), CONV_K ** -0.5),
        "conv_norm_w": gain(ks[5], (L, CONV_WIDTH)),
        "hgrn_lb_logits": 0.1 * jax.random.normal(ks[6], (L + 1, HGRN_WIDTH), f32),
        "hgrn_norm_w": gain(ks[7], (L, HGRN_WIDTH)),
        "w_out": nrm(ks[8], (L, MIX_WIDTH, D), MIX_WIDTH ** -0.5),
        "xattn_norm_w": gain(ks[9], (L, D)),
        "mem_norm_w": gain(ks[10], (L, D)),
        "wq_mem": nrm(ks[11], (L, D, D), D ** -0.5),
        "wkv_mem": nrm(ks[12], (L, D, 2 * D), D ** -0.5),
        "wo_mem": nrm(ks[13], (L, D, D), D ** -0.5),
        "ffn_norm_w": gain(ks[14], (L, D)),
        "peer_w_query": nrm(ks[15], (L, D, PEER_HEADS * 2 * PEER_DK), D ** -0.5),
        "peer_sub_keys": nrm(ks[16], (L, PEER_HEADS, 2, PEER_N_KEYS, PEER_DK), PEER_DK ** -0.5),
        "peer_down": nrm(ks[17], (L, PEER_N_EXPERTS, D), D ** -0.5),
        "peer_up": nrm(ks[18], (L, PEER_N_EXPERTS, D), 0.5),
        "final_norm_w": gain(ks[19], (D,)),
    }


def reference(x, mem, mix_norm_w, w_in, conv_w, conv_norm_w, hgrn_lb_logits, hgrn_norm_w, w_out,
              xattn_norm_w, mem_norm_w, wq_mem, wkv_mem, wo_mem, ffn_norm_w,
              peer_w_query, peer_sub_keys, peer_down, peer_up, final_norm_w):
    lb_all = jnp.cumsum(jax.nn.softmax(hgrn_lb_logits.astype(jnp.float32), axis=0), axis=0)
    cw, hw = CONV_WIDTH, HGRN_WIDTH
    for l in range(DEPTH):
        h = rmsnorm(x, mix_norm_w[l])
        proj = h @ w_in[l]
        b_gate = proj[..., 0:cw]
        c_gate = proj[..., cw:2 * cw]
        v_conv = proj[..., 2 * cw:3 * cw]
        o0 = 3 * cw
        q_h = proj[..., o0:o0 + hw]
        f_h = proj[..., o0 + hw:o0 + 2 * hw]
        i_h = proj[..., o0 + 2 * hw:o0 + 3 * hw]
        g_h = proj[..., o0 + 3 * hw:o0 + 4 * hw]
        y_conv = rmsnorm(short_conv_mixer(b_gate, c_gate, v_conv, conv_w[l]), conv_norm_w[l])
        y_hgrn = hgrn2_mixer(q_h, f_h, i_h, g_h, lb_all[l], hgrn_norm_w[l])
        x = x + jnp.concatenate([y_conv, y_hgrn], axis=-1) @ w_out[l]
        h = rmsnorm(x, xattn_norm_w[l])
        mem_n = rmsnorm(mem, mem_norm_w[l])
        x = x + memory_cross_attention(h, mem_n, wq_mem[l], wkv_mem[l], wo_mem[l])
        h = rmsnorm(x, ffn_norm_w[l])
        x = x + peer_ffn(h, peer_w_query[l], peer_sub_keys[l], peer_down[l], peer_up[l])
    return rmsnorm(x, final_norm_w)
```

```cpp
#include <hip/hip_runtime.h>
#include <hip/hip_cooperative_groups.h>
#include <cstdio>
#include <cstdint>
namespace cg = cooperative_groups;

#ifndef MK_N_LAUNCHES
#define MK_N_LAUNCHES 1
#endif

#ifndef PROBE_REP
#define PROBE_REP 1
#endif
#ifndef PROBE_MASK
#define PROBE_MASK 0
#endif

#ifndef PROBE_SUB
#define PROBE_SUB 7
#endif

namespace pg8 {
#define PG8_LAS __attribute__((address_space(3)))
typedef unsigned short bf16_t;
typedef short bf16x8 __attribute__((ext_vector_type(8)));
typedef float f32x4 __attribute__((ext_vector_type(4)));
typedef unsigned u32x4 __attribute__((ext_vector_type(4)));
constexpr int BM = 256, BK = 64, HALF = 128, HTB = HALF * BK * 2  , STAGE_BYTES = 8 * HTB, NXCD = 8, WGM = 8;

__host__ __device__ __forceinline__ int lds_byte(int r, int c) { const int st = (r >> 4) * 2 + (c >> 5), rr = r & 15, cc = c & 31, ob = rr * 64 + cc * 2; return st * 1024 + (ob ^ (((ob >> 9) & 1) << 5)); }
__host__ __device__ __forceinline__ void stage_rc(int b, int& R, int& C) { const int st = b / 1024, sb = b % 1024, swz = sb ^ (((sb >> 9) & 1) << 5); R = (st >> 1) * 16 + swz / 64; C = (st & 1) * 32 + (swz % 64) / 2; }
__host__ __device__ __forceinline__ int perm32(int rho) { const int n = rho >> 4, i = rho & 15; return 8 * (i >> 2) + 4 * n + (i & 3); }

struct Unit { int pm, pn; };
struct Gemm { const bf16_t* A; const bf16_t* Bt; int M, N, K; int lda; };

struct StaticOrder {
    int nM, nN, nwg, G, c, rep;
    __host__ __device__ void init(int M, int N, int G_, int c_, int rep_ = 1) { nM = M / BM; nN = N / BM; nwg = nM * nN; G = G_; c = c_; rep = rep_; }
    __host__ __device__ bool next(int i, Unit& u) const {
        long L = (long)i * G + c; if (L >= (long)nwg * rep) return false; L %= nwg;
        int wgid = (int)L; { const int q = nwg / NXCD, r = nwg % NXCD, xcd = wgid % NXCD, off = wgid / NXCD; wgid = (xcd < r ? xcd * (q + 1) : r * (q + 1) + (xcd - r) * q) + off; }
        const int nig = WGM * nN, gid = wgid / nig, fm = gid * WGM, gsz = (nM - fm) < WGM ? (nM - fm) : WGM;
        u.pm = fm + ((wgid % nig) % gsz); u.pn = (wgid % nig) / gsz; return true;
    }
    __device__ __forceinline__ void a_ready(const Unit&) const {}
    __device__ __forceinline__ void done(const Unit&) const {}
};


__device__ __forceinline__ float sum_x16_x32(float v) {
    { const auto r = __builtin_amdgcn_permlane16_swap(__float_as_uint(v), __float_as_uint(v), false, false); v = __uint_as_float(r[0]) + __uint_as_float(r[1]); }
    { const auto r = __builtin_amdgcn_permlane32_swap(__float_as_uint(v), __float_as_uint(v), false, false); v = __uint_as_float(r[0]) + __uint_as_float(r[1]); }
    return v;
}
__device__ __forceinline__ unsigned cvt_pk_bf16(float lo, float hi) { unsigned r; asm volatile("v_cvt_pk_bf16_f32 %0, %1, %2" : "=v"(r) : "v"(lo), "v"(hi)); return r; }

struct EpiBf16 {
    static constexpr bool PERM = true, AFTER_DRAIN = false;
    bf16_t* O; int ldc;
    __device__ __forceinline__ void operator()(const f32x4 (&acc)[2][2][4][2], const Unit& u, int wr, int wc, int fr, int fq) const {
        const int row0 = u.pm * BM + wr * 64 + fr, col0 = u.pn * BM + wc * 32 + 8 * fq;
#pragma unroll
        for (int ai = 0; ai < 2; ++ai)
#pragma unroll
            for (int m = 0; m < 4; ++m) { bf16_t* rowp = O + (size_t)(row0 + ai * HALF + m * 16) * ldc + col0;
#pragma unroll
                for (int bj = 0; bj < 2; ++bj) { const f32x4 v0 = acc[ai][bj][m][0], v1 = acc[ai][bj][m][1];
                    u32x4 w; w.x = cvt_pk_bf16(v0[0], v0[1]); w.y = cvt_pk_bf16(v0[2], v0[3]); w.z = cvt_pk_bf16(v1[0], v1[1]); w.w = cvt_pk_bf16(v1[2], v1[3]);
                    *(u32x4*)(rowp + bj * HALF) = w; } }
    }
};
struct EpiTile {
    static constexpr bool PERM = true, AFTER_DRAIN = false;
    bf16_t* O; int sm, sn;
    __device__ __forceinline__ void operator()(const f32x4 (&acc)[2][2][4][2], const Unit& u, int wr, int wc, int fr, int fq) const {
        bf16_t* base = O + (size_t)(u.pm * sm + u.pn * sn) * 65536 + (size_t)(wr * 64 + fr) * 256 + wc * 32 + 8 * fq;
#pragma unroll
        for (int ai = 0; ai < 2; ++ai)
#pragma unroll
            for (int m = 0; m < 4; ++m) { bf16_t* rowp = base + (size_t)(ai * HALF + m * 16) * 256;
#pragma unroll
                for (int bj = 0; bj < 2; ++bj) { const f32x4 v0 = acc[ai][bj][m][0], v1 = acc[ai][bj][m][1];
                    u32x4 w; w.x = cvt_pk_bf16(v0[0], v0[1]); w.y = cvt_pk_bf16(v0[2], v0[3]); w.z = cvt_pk_bf16(v1[0], v1[1]); w.w = cvt_pk_bf16(v1[2], v1[3]);
                    *(u32x4*)(rowp + bj * HALF) = w; } }
    }
};
struct EpiResid {
    static constexpr bool PERM = true, AFTER_DRAIN = false;
    const float* basef; const bf16_t* baseb; bf16_t* xb; float* part; int sliced;
    __device__ __forceinline__ void operator()(const f32x4 (&acc)[2][2][4][2], const Unit& u, int wr, int wc, int fr, int fq) const {
        const int row0 = u.pm * BM + wr * 64 + fr, col0 = u.pn * BM + wc * 32 + 8 * fq;
#pragma unroll
        for (int ai = 0; ai < 2; ++ai)
#pragma unroll
            for (int m = 0; m < 4; ++m) { const int row = row0 + ai * HALF + m * 16; const size_t off = (size_t)row * 1024 + col0; float s = 0.f;
#pragma unroll
                for (int bj = 0; bj < 2; ++bj) {
                    f32x4 b0, b1;
                    if (basef) { b0 = *(const f32x4*)(basef + off + bj * HALF); b1 = *(const f32x4*)(basef + off + bj * HALF + 4); }
                    else { const u32x4 bw = *(const u32x4*)(baseb + off + bj * HALF);
                        b0 = (f32x4){__uint_as_float(bw.x << 16), __uint_as_float(bw.x & 0xffff0000u), __uint_as_float(bw.y << 16), __uint_as_float(bw.y & 0xffff0000u)};
                        b1 = (f32x4){__uint_as_float(bw.z << 16), __uint_as_float(bw.z & 0xffff0000u), __uint_as_float(bw.w << 16), __uint_as_float(bw.w & 0xffff0000u)}; }
                    const f32x4 v0 = acc[ai][bj][m][0] + b0, v1 = acc[ai][bj][m][1] + b1;
                    u32x4 w; w.x = cvt_pk_bf16(v0[0], v0[1]); w.y = cvt_pk_bf16(v0[2], v0[3]); w.z = cvt_pk_bf16(v1[0], v1[1]); w.w = cvt_pk_bf16(v1[2], v1[3]);
                    if (sliced) { const int col = col0 + bj * HALF; *(u32x4*)(xb + ((size_t)(col >> 6) * sliced + row) * 64 + (col & 63)) = w; }
                    else *(u32x4*)(xb + off + bj * HALF) = w;
                    s += (v0[0] * v0[0] + v0[1] * v0[1]) + (v0[2] * v0[2] + v0[3] * v0[3]) + (v1[0] * v1[0] + v1[1] * v1[1]) + (v1[2] * v1[2] + v1[3] * v1[3]); }
                s = sum_x16_x32(s);
                if (fq == 0) part[(size_t)row * 16 + u.pn * 4 + wc] = s; }
    }
};
__device__ __forceinline__ float row_rstd(const float* part, int row, int fq) {
    const f32x4 p = *(const f32x4*)(part + (size_t)row * 16 + 4 * fq); float t = (p[0] + p[1]) + (p[2] + p[3]);
    t = sum_x16_x32(t);
    return rsqrtf(t * (1.0f / 1024.0f) + 1e-6f);
}
struct EpiScaleBf16 {
    static constexpr bool PERM = true, AFTER_DRAIN = false;
    bf16_t* O; int ldc; const float* part; float scale;
    __device__ __forceinline__ void operator()(const f32x4 (&acc)[2][2][4][2], const Unit& u, int wr, int wc, int fr, int fq) const {
        const int row0 = u.pm * BM + wr * 64 + fr, col0 = u.pn * BM + wc * 32 + 8 * fq;
#pragma unroll
        for (int ai = 0; ai < 2; ++ai)
#pragma unroll
            for (int m = 0; m < 4; ++m) { const int row = row0 + ai * HALF + m * 16; const float sc = row_rstd(part, row, fq) * scale; bf16_t* rowp = O + (size_t)row * ldc + col0;
#pragma unroll
                for (int bj = 0; bj < 2; ++bj) { const f32x4 v0 = acc[ai][bj][m][0] * sc, v1 = acc[ai][bj][m][1] * sc;
                    u32x4 w; w.x = cvt_pk_bf16(v0[0], v0[1]); w.y = cvt_pk_bf16(v0[2], v0[3]); w.z = cvt_pk_bf16(v1[0], v1[1]); w.w = cvt_pk_bf16(v1[2], v1[3]);
                    *(u32x4*)(rowp + bj * HALF) = w; } }
    }
};
typedef int i32x4e __attribute__((ext_vector_type(4)));
typedef _Float16 f16x4 __attribute__((ext_vector_type(4)));
typedef _Float16 f16x2 __attribute__((ext_vector_type(2)));
struct EpiScoresT {
    static constexpr bool PERM = false, AFTER_DRAIN = false;
    unsigned short* scT; int Mtok; const float* part;
    __device__ __forceinline__ void operator()(const f32x4 (&acc)[2][2][4][2], const Unit& u, int wr, int wc, int fr, int fq) const {
        const int row0 = u.pm * BM + wr * 64 + fr;
#pragma unroll
        for (int ai = 0; ai < 2; ++ai)
#pragma unroll
            for (int m = 0; m < 4; ++m) { const int row = row0 + ai * HALF + m * 16; const float sc = row_rstd(part, row, fq);
#pragma unroll
                for (int bj = 0; bj < 2; ++bj)
#pragma unroll
                    for (int n = 0; n < 2; ++n) { const int hp = 2 * u.pn + bj, kq = 8 * wc + 4 * n + fq; const f32x4 v = acc[ai][bj][m][n] * sc;
                        *(f16x4*)(scT + ((size_t)(hp * 32 + kq) * Mtok + row) * 4) = (f16x4){(_Float16)v[0], (_Float16)v[1], (_Float16)v[2], (_Float16)v[3]}; } }
    }
};
struct EpiBf16I8 {
    static constexpr bool PERM = true, AFTER_DRAIN = false;
    bf16_t* O; int ldc; const float* rowscale; const float* colscale;
    __device__ __forceinline__ void operator()(const i32x4e (&acc)[2][2][4][2], const Unit& u, int wr, int wc, int fr, int fq) const {
        const int row0 = u.pm * BM + wr * 64 + fr, col0 = u.pn * BM + wc * 32 + 8 * fq;
        f32x4 cs[2][2];
#pragma unroll
        for (int bj = 0; bj < 2; ++bj) { cs[bj][0] = *(const f32x4*)(colscale + col0 + bj * HALF); cs[bj][1] = *(const f32x4*)(colscale + col0 + bj * HALF + 4); }
        float rs[2][4];
#pragma unroll
        for (int ai = 0; ai < 2; ++ai)
#pragma unroll
            for (int m = 0; m < 4; ++m) rs[ai][m] = rowscale[row0 + ai * HALF + m * 16];
#pragma unroll
        for (int ai = 0; ai < 2; ++ai)
#pragma unroll
            for (int m = 0; m < 4; ++m) { bf16_t* rowp = O + (size_t)(row0 + ai * HALF + m * 16) * ldc + col0; const float r_ = rs[ai][m];
#pragma unroll
                for (int bj = 0; bj < 2; ++bj) { const i32x4e a0 = acc[ai][bj][m][0], a1 = acc[ai][bj][m][1]; const f32x4 c0 = cs[bj][0] * r_, c1 = cs[bj][1] * r_;
                    u32x4 w; w.x = cvt_pk_bf16((float)a0[0] * c0[0], (float)a0[1] * c0[1]); w.y = cvt_pk_bf16((float)a0[2] * c0[2], (float)a0[3] * c0[3]);
                    w.z = cvt_pk_bf16((float)a1[0] * c1[0], (float)a1[1] * c1[1]); w.w = cvt_pk_bf16((float)a1[2] * c1[2], (float)a1[3] * c1[3]);
                    *(u32x4*)(rowp + bj * HALF) = w; } }
    }
};
struct EpiScoresI8 {
    static constexpr bool PERM = false, AFTER_DRAIN = false;
    unsigned short* scT; int Mtok; const float* part; const float* xscale; const float* wscale;
    __device__ __forceinline__ void operator()(const i32x4e (&acc)[2][2][4][2], const Unit& u, int wr, int wc, int fr, int fq) const {
        const int row0 = u.pm * BM + wr * 64 + fr, colb = u.pn * BM + wc * 32 + 4 * fq;
        f32x4 ws[2][2];
#pragma unroll
        for (int bj = 0; bj < 2; ++bj)
#pragma unroll
            for (int n = 0; n < 2; ++n) ws[bj][n] = *(const f32x4*)(wscale + colb + bj * HALF + 16 * n);
#pragma unroll
        for (int ai = 0; ai < 2; ++ai)
#pragma unroll
            for (int m = 0; m < 4; ++m) { const int row = row0 + ai * HALF + m * 16; const float sc = row_rstd(part, row, fq) * xscale[row];
#pragma unroll
                for (int bj = 0; bj < 2; ++bj)
#pragma unroll
                    for (int n = 0; n < 2; ++n) { const int hp = 2 * u.pn + bj, kq = 8 * wc + 4 * n + fq; const i32x4e a = acc[ai][bj][m][n]; const f32x4 w = ws[bj][n];
                        *(f16x4*)(scT + ((size_t)(hp * 32 + kq) * Mtok + row) * 4) = (f16x4){(_Float16)((float)a[0] * sc * w[0]), (_Float16)((float)a[1] * sc * w[1]), (_Float16)((float)a[2] * sc * w[2]), (_Float16)((float)a[3] * sc * w[3])}; } }
    }
};

template <class Epi, class Sched, bool ALIGN_EPI = false, bool SP2 = false>
__device__ __forceinline__ void gemm_phase(PG8_LAS unsigned char* lds, const Gemm g, const Sched& S, const Epi& E) {
    const int tid = threadIdx.x, wid = __builtin_amdgcn_readfirstlane(tid >> 6), lane = tid & 63, wr = wid >> 2, wc = wid & 3, fr = lane & 15, fq = lane >> 4;
    const int K = g.K, nt = K / BK;
    const int ldA = g.lda ? g.lda : K;
    unsigned voffA[2], voffB[2];
#pragma unroll
    for (int i = 0; i < 2; ++i) { int R, C; stage_rc(tid * 16 + i * 8192, R, C); const int Rb = Epi::PERM ? ((R & ~31) + perm32(R & 31)) : R;
        voffA[i] = (unsigned)(R * ldA + C) * 2u; voffB[i] = (unsigned)(Rb * K + C) * 2u; }
    const size_t kstepA = g.lda ? (size_t)g.M * 64 * 2 : (size_t)(BK * 2);
    const size_t hstepA = (size_t)HALF * ldA * 2, tstepA = 2 * hstepA;
    const size_t kstep = (size_t)(BK * 2);
    const size_t hstep = (size_t)HALF * K * 2;
    const size_t tstep = 2 * hstep;
    const unsigned ldsw = (unsigned)wid * 1024u;
    const int aoff = lds_byte(wr * 64 + fr, fq * 8), boff = lds_byte(wc * 32 + fr, fq * 8);
#define PG8_SA(b, h) (((b) * 2 + (h)) * HTB)
#define PG8_SB(b, h) ((4 + (b) * 2 + (h)) * HTB)
#define PG8_STAGE(bufoff, gbase, voff) do { _Pragma("unroll") for (int _i = 0; _i < 2; ++_i) \
        __builtin_amdgcn_global_load_lds((const unsigned*)((const char*)(gbase) + (voff)[_i]), (PG8_LAS unsigned*)(lds + (bufoff) + ldsw + _i * 8192), 16, 0, 0); } while (0)
#define PG8_LDA(dst, b, h) do { _Pragma("unroll") for (int m = 0; m < 4; ++m) _Pragma("unroll") for (int k = 0; k < 2; ++k) dst[m][k] = *(const PG8_LAS bf16x8*)(lds + PG8_SA(b, h) + aoff + m * 2048 + k * 1024); } while (0)
#define PG8_LDB(dst, b, h) do { _Pragma("unroll") for (int n = 0; n < 2; ++n) _Pragma("unroll") for (int k = 0; k < 2; ++k) dst[n][k] = *(const PG8_LAS bf16x8*)(lds + PG8_SB(b, h) + boff + n * 2048 + k * 1024); } while (0)
#define PG8_MMA(ai, bj, At, Bt) do { __builtin_amdgcn_s_setprio(1); _Pragma("unroll") for (int m = 0; m < 4; ++m) _Pragma("unroll") for (int n = 0; n < 2; ++n) _Pragma("unroll") for (int k = 0; k < 2; ++k) \
        acc[ai][bj][m][n] = __builtin_amdgcn_mfma_f32_16x16x32_bf16(Bt[n][k], At[m][k], acc[ai][bj][m][n], 0, 0, 0); __builtin_amdgcn_s_setprio(0); } while (0)
#define PG8_WAIT_V(n) asm volatile("s_waitcnt vmcnt(" #n ")" ::: "memory")
#define PG8_WAIT_L(n) asm volatile("s_waitcnt lgkmcnt(" #n ")" ::: "memory")
#define PG8_BAR __builtin_amdgcn_s_barrier()
#define PG8_SCHED __builtin_amdgcn_sched_barrier(0)
    Unit cur, nxt; int ui = 0;
    if (!S.next(0, cur)) return;
    f32x4 acc[2][2][4][2];
#pragma unroll
    for (int a = 0; a < 2; ++a)
#pragma unroll
        for (int b = 0; b < 2; ++b)
#pragma unroll
            for (int m = 0; m < 4; ++m)
#pragma unroll
                for (int n = 0; n < 2; ++n) acc[a][b][m][n] = (f32x4){0.f, 0.f, 0.f, 0.f};
    bf16x8 At[4][2], B0[2][2], B1[2][2];
    const char* cA = (const char*)g.A + (size_t)cur.pm * tstepA; const char* cB = (const char*)g.Bt + (size_t)cur.pn * tstep;
    S.a_ready(cur);
    if constexpr (SP2) {
        PG8_STAGE(PG8_SB(0, 0), cB, voffB); PG8_STAGE(PG8_SB(0, 1), cB + hstep, voffB); PG8_STAGE(PG8_SA(0, 0), cA, voffA); PG8_STAGE(PG8_SA(0, 1), cA + hstepA, voffA);
        if (wr == 1) PG8_BAR;
        PG8_WAIT_V(2); PG8_BAR;
        PG8_STAGE(PG8_SB(1, 0), cB + kstep, voffB); PG8_STAGE(PG8_SA(1, 0), cA + kstepA, voffA); PG8_STAGE(PG8_SB(1, 1), cB + hstep + kstep, voffB);
        PG8_WAIT_V(6); PG8_BAR;
    } else {
        PG8_STAGE(PG8_SB(0, 0), cB, voffB); PG8_STAGE(PG8_SA(0, 0), cA, voffA); PG8_STAGE(PG8_SB(0, 1), cB + hstep, voffB); PG8_STAGE(PG8_SA(0, 1), cA + hstepA, voffA);
        if (wr == 1) PG8_BAR;
        PG8_WAIT_V(4); PG8_BAR;
        PG8_STAGE(PG8_SB(1, 0), cB + kstep, voffB); PG8_STAGE(PG8_SA(1, 0), cA + kstepA, voffA); PG8_STAGE(PG8_SB(1, 1), cB + hstep + kstep, voffB);
        PG8_WAIT_V(6); PG8_BAR;
    }
    for (;;) {
        const bool has_next = S.next(ui + 1, nxt);
        const char* nA = has_next ? (const char*)g.A + (size_t)nxt.pm * tstepA : cA; const char* nB = has_next ? (const char*)g.Bt + (size_t)nxt.pn * tstep : cB;
        for (int t = 0; t < nt; t += 2) {
            const bool last = (t == nt - 2);
            const char* a1 = cA + (size_t)(t + 1) * kstepA;
            const char* a2 = last ? nA : cA + (size_t)(t + 2) * kstepA; const char* b2 = last ? nB : cB + (size_t)(t + 2) * kstep;
            const char* a3 = a2 + kstepA; const char* b3 = b2 + kstep;
            if (last && has_next) S.a_ready(nxt);
            if constexpr (SP2) {
            PG8_LDB(B0, 0, 0); PG8_LDB(B1, 0, 1); PG8_SCHED; PG8_LDA(At, 0, 0); PG8_STAGE(PG8_SA(1, 1), a1 + hstepA, voffA);
            PG8_WAIT_V(8); PG8_WAIT_L(0); PG8_BAR; PG8_MMA(0, 0, At, B0); PG8_MMA(0, 1, At, B1); PG8_BAR; PG8_SCHED;
            PG8_LDA(At, 0, 1); PG8_STAGE(PG8_SB(0, 0), b2, voffB); PG8_STAGE(PG8_SB(0, 1), b2 + hstep, voffB); PG8_STAGE(PG8_SA(0, 0), a2, voffA);
            PG8_WAIT_V(8); PG8_WAIT_L(0); PG8_BAR; PG8_MMA(1, 0, At, B0); PG8_MMA(1, 1, At, B1); PG8_BAR; PG8_SCHED;
            PG8_LDB(B0, 1, 0); PG8_LDB(B1, 1, 1); PG8_SCHED; PG8_LDA(At, 1, 0); PG8_STAGE(PG8_SA(0, 1), a2 + hstepA, voffA);
            PG8_WAIT_V(8); PG8_WAIT_L(0); PG8_BAR; PG8_MMA(0, 0, At, B0); PG8_MMA(0, 1, At, B1); PG8_BAR; PG8_SCHED;
            PG8_LDA(At, 1, 1); PG8_STAGE(PG8_SB(1, 0), b3, voffB); PG8_STAGE(PG8_SB(1, 1), b3 + hstep, voffB); PG8_STAGE(PG8_SA(1, 0), a3, voffA);
            PG8_WAIT_V(8); PG8_WAIT_L(0); PG8_BAR; PG8_MMA(1, 0, At, B0); PG8_MMA(1, 1, At, B1); PG8_BAR; PG8_SCHED;
            } else {
            PG8_LDB(B0, 0, 0); PG8_SCHED; PG8_LDA(At, 0, 0); PG8_STAGE(PG8_SA(1, 1), a1 + hstepA, voffA);
            PG8_WAIT_L(8); PG8_BAR; PG8_WAIT_L(0); PG8_MMA(0, 0, At, B0); PG8_BAR; PG8_SCHED;
            PG8_LDB(B1, 0, 1); PG8_STAGE(PG8_SB(0, 0), b2, voffB);
            PG8_BAR; PG8_WAIT_L(0); PG8_MMA(0, 1, At, B1); PG8_BAR;
            PG8_LDA(At, 0, 1); PG8_STAGE(PG8_SA(0, 0), a2, voffA);
            PG8_BAR; PG8_WAIT_L(0); PG8_MMA(1, 0, At, B0); PG8_BAR; PG8_SCHED;
            PG8_STAGE(PG8_SB(0, 1), b2 + hstep, voffB);
            PG8_WAIT_V(6); PG8_BAR; PG8_MMA(1, 1, At, B1); PG8_BAR;
            PG8_LDB(B0, 1, 0); PG8_SCHED; PG8_LDA(At, 1, 0); PG8_STAGE(PG8_SA(0, 1), a2 + hstepA, voffA);
            PG8_WAIT_L(8); PG8_BAR; PG8_WAIT_L(0); PG8_MMA(0, 0, At, B0); PG8_BAR; PG8_SCHED;
            PG8_LDB(B1, 1, 1); PG8_STAGE(PG8_SB(1, 0), b3, voffB);
            PG8_BAR; PG8_WAIT_L(0); PG8_MMA(0, 1, At, B1); PG8_BAR;
            PG8_LDA(At, 1, 1); PG8_STAGE(PG8_SA(1, 0), a3, voffA);
            PG8_BAR; PG8_WAIT_L(0); PG8_MMA(1, 0, At, B0); PG8_BAR; PG8_SCHED;
            PG8_STAGE(PG8_SB(1, 1), b3 + hstep, voffB);
            PG8_WAIT_V(6); PG8_BAR; PG8_MMA(1, 1, At, B1); PG8_BAR;
            }
        }
        if constexpr (ALIGN_EPI) { if (wr == 0) PG8_BAR; }
        if constexpr (!Epi::AFTER_DRAIN) { E(acc, cur, wr, wc, fr, fq); S.done(cur); }
        if (!has_next) break;
#pragma unroll
        for (int a = 0; a < 2; ++a)
#pragma unroll
            for (int b = 0; b < 2; ++b)
#pragma unroll
                for (int m = 0; m < 4; ++m)
#pragma unroll
                    for (int n = 0; n < 2; ++n) acc[a][b][m][n] = (f32x4){0.f, 0.f, 0.f, 0.f};
        cur = nxt; cA = nA; cB = nB; ++ui;
        if constexpr (ALIGN_EPI) { if (wr == 1) PG8_BAR; }
    }
    PG8_WAIT_V(0);
    if constexpr (!ALIGN_EPI) { if (wr == 0) PG8_BAR; }
    PG8_BAR;
    if constexpr (Epi::AFTER_DRAIN) { E.fused(acc, cur, wr, wc, fr, fq, lds, wid, lane); S.done(cur); }
#undef PG8_SA
#undef PG8_SB
#undef PG8_STAGE
#undef PG8_LDA
#undef PG8_LDB
#undef PG8_MMA
#undef PG8_WAIT_V
#undef PG8_WAIT_L
#undef PG8_BAR
#undef PG8_SCHED
}
typedef int i32x4 __attribute__((ext_vector_type(4)));
template <class Epi, class Sched, bool ALIGN_EPI = false, bool SP2 = false>
__device__ __forceinline__ void gemm_phase_i8(PG8_LAS unsigned char* lds, const Gemm g, const Sched& S, const Epi& E) {
    const int tid = threadIdx.x, wid = __builtin_amdgcn_readfirstlane(tid >> 6), lane = tid & 63, wr = wid >> 2, wc = wid & 3, fr = lane & 15, fq = lane >> 4;
    const int K = g.K, nt = K / BK;
    const int ldA = g.lda ? g.lda : K;
    unsigned voffA[2], voffB[2];
#pragma unroll
    for (int i = 0; i < 2; ++i) { int R, C; stage_rc(tid * 16 + i * 8192, R, C); const int Rb = Epi::PERM ? ((R & ~31) + perm32(R & 31)) : R;
        voffA[i] = (unsigned)(R * ldA + C) * 2u; voffB[i] = (unsigned)(Rb * K + C) * 2u; }
    const size_t kstepA = g.lda ? (size_t)g.M * 64 * 2 : (size_t)(BK * 2);
    const size_t hstepA = (size_t)HALF * ldA * 2, tstepA = 2 * hstepA;
    const size_t kstep = (size_t)(BK * 2);
    const size_t hstep = (size_t)HALF * K * 2;
    const size_t tstep = 2 * hstep;
    const unsigned ldsw = (unsigned)wid * 1024u;
    const int aoff = lds_byte(wr * 64 + fr, fq * 8), boff = lds_byte(wc * 32 + fr, fq * 8);
#define PG8_SA(b, h) (((b) * 2 + (h)) * HTB)
#define PG8_SB(b, h) ((4 + (b) * 2 + (h)) * HTB)
#define PG8_STAGE(bufoff, gbase, voff) do { _Pragma("unroll") for (int _i = 0; _i < 2; ++_i) \
        __builtin_amdgcn_global_load_lds((const unsigned*)((const char*)(gbase) + (voff)[_i]), (PG8_LAS unsigned*)(lds + (bufoff) + ldsw + _i * 8192), 16, 0, 0); } while (0)
#define PG8_LDA(dst, b, h) do { _Pragma("unroll") for (int m = 0; m < 4; ++m) _Pragma("unroll") for (int k = 0; k < 2; ++k) dst[m][k] = *(const PG8_LAS bf16x8*)(lds + PG8_SA(b, h) + aoff + m * 2048 + k * 1024); } while (0)
#define PG8_LDB(dst, b, h) do { _Pragma("unroll") for (int n = 0; n < 2; ++n) _Pragma("unroll") for (int k = 0; k < 2; ++k) dst[n][k] = *(const PG8_LAS bf16x8*)(lds + PG8_SB(b, h) + boff + n * 2048 + k * 1024); } while (0)
#define PG8_MMA(ai, bj, At, Bt) do { __builtin_amdgcn_s_setprio(1); _Pragma("unroll") for (int m = 0; m < 4; ++m) _Pragma("unroll") for (int n = 0; n < 2; ++n) _Pragma("unroll") for (int k = 0; k < 2; ++k) \
        acc[ai][bj][m][n] = __builtin_amdgcn_mfma_i32_16x16x64_i8(__builtin_bit_cast(i32x4, Bt[n][k]), __builtin_bit_cast(i32x4, At[m][k]), acc[ai][bj][m][n], 0, 0, 0); __builtin_amdgcn_s_setprio(0); } while (0)
#define PG8_WAIT_V(n) asm volatile("s_waitcnt vmcnt(" #n ")" ::: "memory")
#define PG8_WAIT_L(n) asm volatile("s_waitcnt lgkmcnt(" #n ")" ::: "memory")
#define PG8_BAR __builtin_amdgcn_s_barrier()
#define PG8_SCHED __builtin_amdgcn_sched_barrier(0)
    Unit cur, nxt; int ui = 0;
    if (!S.next(0, cur)) return;
    i32x4 acc[2][2][4][2];
#pragma unroll
    for (int a = 0; a < 2; ++a)
#pragma unroll
        for (int b = 0; b < 2; ++b)
#pragma unroll
            for (int m = 0; m < 4; ++m)
#pragma unroll
                for (int n = 0; n < 2; ++n) acc[a][b][m][n] = (i32x4){0, 0, 0, 0};
    bf16x8 At[4][2], B0[2][2], B1[2][2];
    const char* cA = (const char*)g.A + (size_t)cur.pm * tstepA; const char* cB = (const char*)g.Bt + (size_t)cur.pn * tstep;
    S.a_ready(cur);
    if constexpr (SP2) {
        PG8_STAGE(PG8_SB(0, 0), cB, voffB); PG8_STAGE(PG8_SB(0, 1), cB + hstep, voffB); PG8_STAGE(PG8_SA(0, 0), cA, voffA); PG8_STAGE(PG8_SA(0, 1), cA + hstepA, voffA);
        if (wr == 1) PG8_BAR;
        PG8_WAIT_V(2); PG8_BAR;
        PG8_STAGE(PG8_SB(1, 0), cB + kstep, voffB); PG8_STAGE(PG8_SA(1, 0), cA + kstepA, voffA); PG8_STAGE(PG8_SB(1, 1), cB + hstep + kstep, voffB);
        PG8_WAIT_V(6); PG8_BAR;
    } else {
        PG8_STAGE(PG8_SB(0, 0), cB, voffB); PG8_STAGE(PG8_SA(0, 0), cA, voffA); PG8_STAGE(PG8_SB(0, 1), cB + hstep, voffB); PG8_STAGE(PG8_SA(0, 1), cA + hstepA, voffA);
        if (wr == 1) PG8_BAR;
        PG8_WAIT_V(4); PG8_BAR;
        PG8_STAGE(PG8_SB(1, 0), cB + kstep, voffB); PG8_STAGE(PG8_SA(1, 0), cA + kstepA, voffA); PG8_STAGE(PG8_SB(1, 1), cB + hstep + kstep, voffB);
        PG8_WAIT_V(6); PG8_BAR;
    }
    for (;;) {
        const bool has_next = S.next(ui + 1, nxt);
        const char* nA = has_next ? (const char*)g.A + (size_t)nxt.pm * tstepA : cA; const char* nB = has_next ? (const char*)g.Bt + (size_t)nxt.pn * tstep : cB;
        for (int t = 0; t < nt; t += 2) {
            const bool last = (t == nt - 2);
            const char* a1 = cA + (size_t)(t + 1) * kstepA;
            const char* a2 = last ? nA : cA + (size_t)(t + 2) * kstepA; const char* b2 = last ? nB : cB + (size_t)(t + 2) * kstep;
            const char* a3 = a2 + kstepA; const char* b3 = b2 + kstep;
            if (last && has_next) S.a_ready(nxt);
            if constexpr (SP2) {
            PG8_LDB(B0, 0, 0); PG8_LDB(B1, 0, 1); PG8_SCHED; PG8_LDA(At, 0, 0); PG8_STAGE(PG8_SA(1, 1), a1 + hstepA, voffA);
            PG8_WAIT_V(8); PG8_WAIT_L(0); PG8_BAR; PG8_MMA(0, 0, At, B0); PG8_MMA(0, 1, At, B1); PG8_BAR; PG8_SCHED;
            PG8_LDA(At, 0, 1); PG8_STAGE(PG8_SB(0, 0), b2, voffB); PG8_STAGE(PG8_SB(0, 1), b2 + hstep, voffB); PG8_STAGE(PG8_SA(0, 0), a2, voffA);
            PG8_WAIT_V(8); PG8_WAIT_L(0); PG8_BAR; PG8_MMA(1, 0, At, B0); PG8_MMA(1, 1, At, B1); PG8_BAR; PG8_SCHED;
            PG8_LDB(B0, 1, 0); PG8_LDB(B1, 1, 1); PG8_SCHED; PG8_LDA(At, 1, 0); PG8_STAGE(PG8_SA(0, 1), a2 + hstepA, voffA);
            PG8_WAIT_V(8); PG8_WAIT_L(0); PG8_BAR; PG8_MMA(0, 0, At, B0); PG8_MMA(0, 1, At, B1); PG8_BAR; PG8_SCHED;
            PG8_LDA(At, 1, 1); PG8_STAGE(PG8_SB(1, 0), b3, voffB); PG8_STAGE(PG8_SB(1, 1), b3 + hstep, voffB); PG8_STAGE(PG8_SA(1, 0), a3, voffA);
            PG8_WAIT_V(8); PG8_WAIT_L(0); PG8_BAR; PG8_MMA(1, 0, At, B0); PG8_MMA(1, 1, At, B1); PG8_BAR; PG8_SCHED;
            } else {
            PG8_LDB(B0, 0, 0); PG8_SCHED; PG8_LDA(At, 0, 0); PG8_STAGE(PG8_SA(1, 1), a1 + hstepA, voffA);
            PG8_WAIT_L(8); PG8_BAR; PG8_WAIT_L(0); PG8_MMA(0, 0, At, B0); PG8_BAR; PG8_SCHED;
            PG8_LDB(B1, 0, 1); PG8_STAGE(PG8_SB(0, 0), b2, voffB);
            PG8_BAR; PG8_WAIT_L(0); PG8_MMA(0, 1, At, B1); PG8_BAR;
            PG8_LDA(At, 0, 1); PG8_STAGE(PG8_SA(0, 0), a2, voffA);
            PG8_BAR; PG8_WAIT_L(0); PG8_MMA(1, 0, At, B0); PG8_BAR; PG8_SCHED;
            PG8_STAGE(PG8_SB(0, 1), b2 + hstep, voffB);
            PG8_WAIT_V(6); PG8_BAR; PG8_MMA(1, 1, At, B1); PG8_BAR;
            PG8_LDB(B0, 1, 0); PG8_SCHED; PG8_LDA(At, 1, 0); PG8_STAGE(PG8_SA(0, 1), a2 + hstepA, voffA);
            PG8_WAIT_L(8); PG8_BAR; PG8_WAIT_L(0); PG8_MMA(0, 0, At, B0); PG8_BAR; PG8_SCHED;
            PG8_LDB(B1, 1, 1); PG8_STAGE(PG8_SB(1, 0), b3, voffB);
            PG8_BAR; PG8_WAIT_L(0); PG8_MMA(0, 1, At, B1); PG8_BAR;
            PG8_LDA(At, 1, 1); PG8_STAGE(PG8_SA(1, 0), a3, voffA);
            PG8_BAR; PG8_WAIT_L(0); PG8_MMA(1, 0, At, B0); PG8_BAR; PG8_SCHED;
            PG8_STAGE(PG8_SB(1, 1), b3 + hstep, voffB);
            PG8_WAIT_V(6); PG8_BAR; PG8_MMA(1, 1, At, B1); PG8_BAR;
            }
        }
        if constexpr (ALIGN_EPI) { if (wr == 0) PG8_BAR; }
        if constexpr (!Epi::AFTER_DRAIN) { E(acc, cur, wr, wc, fr, fq); S.done(cur); }
        if (!has_next) break;
#pragma unroll
        for (int a = 0; a < 2; ++a)
#pragma unroll
            for (int b = 0; b < 2; ++b)
#pragma unroll
                for (int m = 0; m < 4; ++m)
#pragma unroll
                    for (int n = 0; n < 2; ++n) acc[a][b][m][n] = (i32x4){0, 0, 0, 0};
        cur = nxt; cA = nA; cB = nB; ++ui;
        if constexpr (ALIGN_EPI) { if (wr == 1) PG8_BAR; }
    }
    PG8_WAIT_V(0);
    if constexpr (!ALIGN_EPI) { if (wr == 0) PG8_BAR; }
    PG8_BAR;
    if constexpr (Epi::AFTER_DRAIN) { E.fused(acc, cur, wr, wc, fr, fq, lds, wid, lane); S.done(cur); }
#undef PG8_SA
#undef PG8_SB
#undef PG8_STAGE
#undef PG8_LDA
#undef PG8_LDB
#undef PG8_MMA
#undef PG8_WAIT_V
#undef PG8_WAIT_L
#undef PG8_BAR
#undef PG8_SCHED
}
}

#ifndef PG8_SP2
#define PG8_SP2 true
#endif
#ifndef PG8_ALIGN
#define PG8_ALIGN true
#endif

constexpr int NWAVES = 8, NT = NWAVES * 64;
constexpr int BATCH = 4, SEQ = 8192, D = 1024, M = BATCH * SEQ;
constexpr int IN_COLS = 3584;
constexpr int NMEM = 256, MROWS = BATCH * NMEM;
constexpr int NEXP = 16384;
constexpr float EPS = 1e-6f;
constexpr float QSCALE = 0.0625f * 1.4426950408889634f;

constexpr size_t MiB = 1u << 20;
constexpr size_t WS_CTL = 0, CTL_ZERO_BYTES = 64 * 1024;
constexpr size_t WS_PART1 = 1 * MiB;
constexpr size_t WS_DECAY = 5 * MiB;
constexpr size_t WS_WIN = 6 * MiB, WS_WOUT = 13 * MiB, WS_WQ = 15 * MiB, WS_WKV = 17 * MiB, WS_WO = 21 * MiB, WS_WEFF = 23 * MiB;
constexpr size_t WS_MEMN = 27 * MiB, WS_KB = 29 * MiB, WS_VT = 31 * MiB;
constexpr size_t WS_PUP = 1 * MiB;
constexpr size_t WS_A = 33 * MiB;
constexpr size_t WS_X = 97 * MiB;
constexpr size_t WS_PROJ = WS_X, WS_US = WS_X + 224 * MiB;
constexpr size_t WS_B1 = WS_X, WS_Q = WS_X + 64 * MiB;
constexpr size_t WS_X2S = WS_X + 64 * MiB;
constexpr size_t WS_SCT = WS_X + 128 * MiB;
constexpr size_t WS_PDOWN = WS_X;
constexpr size_t WS_IDX = WS_A, WS_GATE = WS_A + 8 * MiB;
constexpr size_t WS_PART2 = WS_X + 384 * MiB;
constexpr size_t WS_SSQ = WS_PART2 + 2 * MiB;
constexpr size_t WS_DSCALE = WS_SSQ + 2 * MiB, WS_USCALE = WS_DSCALE + 65536;
constexpr size_t WS_XSCALE = WS_USCALE + 65536, WS_CORR = WS_XSCALE + 131072;
constexpr size_t WS_WPK = WS_A + 56 * MiB;
constexpr size_t WS_XQ = WS_A + 24 * MiB;
constexpr size_t WS_END = WS_CORR + 131072;

constexpr size_t WS_PROBE_DUMMY = WS_X + 256 * MiB;
constexpr int RING_BYTES = 131072, LDS_BYTES = 147456;

#define LAS __attribute__((address_space(3)))
typedef unsigned short bf16;
typedef float f32x2 __attribute__((ext_vector_type(2)));
typedef float f32x4 __attribute__((ext_vector_type(4)));
typedef float f32x16 __attribute__((ext_vector_type(16)));
typedef short bf16x8 __attribute__((ext_vector_type(8)));
typedef unsigned v4u __attribute__((ext_vector_type(4)));
typedef unsigned v2u __attribute__((ext_vector_type(2)));
typedef __bf16 bf16x2_t __attribute__((ext_vector_type(2)));
#define LDS_WAIT() asm volatile("s_waitcnt lgkmcnt(0)" ::: "memory")
__device__ __forceinline__ float bf2f(unsigned short b) { return __uint_as_float(((unsigned)b) << 16); }
__device__ __forceinline__ float bflo(unsigned u) { return __uint_as_float(u << 16); }
__device__ __forceinline__ float bfhi(unsigned u) { return __uint_as_float(u & 0xffff0000u); }
__device__ __forceinline__ unsigned pk2(float lo, float hi) { f32x2 v = {lo, hi}; bf16x2_t b = __builtin_convertvector(v, bf16x2_t); return __builtin_bit_cast(unsigned, b); }
__device__ __forceinline__ float xlane_dpp_b1(float v) { return __uint_as_float((unsigned)__builtin_amdgcn_update_dpp(0, (int)__float_as_uint(v), 0xB1, 0xF, 0xF, false)); }
__device__ __forceinline__ float xlane_dpp_4e(float v) { return __uint_as_float((unsigned)__builtin_amdgcn_update_dpp(0, (int)__float_as_uint(v), 0x4E, 0xF, 0xF, false)); }
__device__ __forceinline__ float xlane_dpp_x4(float v) { int r = __builtin_amdgcn_update_dpp(0, (int)__float_as_uint(v), 0x12C, 0xF, 0x5, false); r = __builtin_amdgcn_update_dpp(r, (int)__float_as_uint(v), 0x124, 0xF, 0xA, false); return __uint_as_float((unsigned)r); }
__device__ __forceinline__ float xlane_dpp_x8(float v) { return __uint_as_float((unsigned)__builtin_amdgcn_update_dpp(0, (int)__float_as_uint(v), 0x128, 0xF, 0xF, false)); }
__device__ __forceinline__ float xlane_x16(float v) { const auto r = __builtin_amdgcn_permlane16_swap(__float_as_uint(v), __float_as_uint(v), false, false); return __uint_as_float((__builtin_amdgcn_mbcnt_lo(~0u, 0u) + __builtin_amdgcn_mbcnt_hi(~0u, 0u)) & 16 ? r[0] : r[1]); }
__device__ __forceinline__ float xlane_x32(float v) { const auto r = __builtin_amdgcn_permlane32_swap(__float_as_uint(v), __float_as_uint(v), false, false); return __uint_as_float((__builtin_amdgcn_mbcnt_lo(~0u, 0u) + __builtin_amdgcn_mbcnt_hi(~0u, 0u)) & 32 ? r[0] : r[1]); }
__device__ __forceinline__ float wave_sum(float v) {
    v += xlane_dpp_b1(v); v += xlane_dpp_4e(v); v += xlane_dpp_x4(v); v += xlane_dpp_x8(v);
    { const auto r = __builtin_amdgcn_permlane16_swap(__float_as_uint(v), __float_as_uint(v), false, false); v = __uint_as_float(r[0]) + __uint_as_float(r[1]); }
    { const auto r = __builtin_amdgcn_permlane32_swap(__float_as_uint(v), __float_as_uint(v), false, false); v = __uint_as_float(r[0]) + __uint_as_float(r[1]); }
    return v;
}
__device__ __forceinline__ float wave_max(float v) {
    v = fmaxf(v, xlane_dpp_b1(v)); v = fmaxf(v, xlane_dpp_4e(v)); v = fmaxf(v, xlane_dpp_x4(v)); v = fmaxf(v, xlane_dpp_x8(v));
    { const auto r = __builtin_amdgcn_permlane16_swap(__float_as_uint(v), __float_as_uint(v), false, false); v = fmaxf(__uint_as_float(r[0]), __uint_as_float(r[1])); }
    { const auto r = __builtin_amdgcn_permlane32_swap(__float_as_uint(v), __float_as_uint(v), false, false); v = fmaxf(__uint_as_float(r[0]), __uint_as_float(r[1])); }
    return v;
}
__device__ __forceinline__ float sigmoidf_(float x) { return __builtin_amdgcn_rcpf(1.0f + __expf(-x)); }
__device__ __forceinline__ int kappa(int rho) { return (rho & 0x13) | ((rho & 4) << 1) | ((rho & 8) >> 1); }
__device__ __forceinline__ bf16x8 as_bf16x8(v4u v) { return __builtin_bit_cast(bf16x8, v); }

__device__ __forceinline__ void p0_transpose_item(const float* W, int K, int N, bf16* WT, const float* gain, LAS float* scr, int item, int lane) {
    const int nblk = N / 32, kb = item / nblk, nb = item % nblk, k0 = 64 * kb, n0 = 32 * nb;
    float wv[32];
#pragma unroll
    for (int i = 0; i < 32; ++i) { const int kk = 2 * i + (lane >> 5); wv[i] = W[(size_t)(k0 + kk) * N + n0 + (lane & 31)]; }
#pragma unroll
    for (int i = 0; i < 32; ++i) { const int kk = 2 * i + (lane >> 5); const float g = gain ? gain[k0 + kk] : 1.0f; scr[kk * 33 + (lane & 31)] = wv[i] * g; }
    LDS_WAIT();
    const int c = lane & 7;
#pragma unroll
    for (int j = 0; j < 4; ++j) { const int n = (lane >> 3) + 8 * j; const LAS float* s = scr + (8 * c) * 33 + n;
        v4u o; o.x = pk2(s[0 * 33], s[1 * 33]); o.y = pk2(s[2 * 33], s[3 * 33]); o.z = pk2(s[4 * 33], s[5 * 33]); o.w = pk2(s[6 * 33], s[7 * 33]);
        *(v4u*)(WT + (size_t)(n0 + n) * K + k0 + 8 * c) = o; }
    LDS_WAIT();
}
__device__ __forceinline__ void rms_row_to_bf16(const float* xrow, const float* gain, bf16* orow, int lane) {
    const f32x4* xr = (const f32x4*)xrow + lane; f32x4 v[4]; float s = 0.f;
#pragma unroll
    for (int j = 0; j < 4; ++j) { v[j] = xr[64 * j]; s += (v[j].x * v[j].x + v[j].y * v[j].y) + (v[j].z * v[j].z + v[j].w * v[j].w); }
    const float r = rsqrtf(wave_sum(s) * (1.0f / 1024.0f) + EPS);
    const f32x4* gr = (const f32x4*)gain + lane; unsigned long long* o8 = (unsigned long long*)orow + lane;
#pragma unroll
    for (int j = 0; j < 4; ++j) { const f32x4 g = gr[64 * j]; o8[64 * j] = (unsigned long long)pk2(v[j].x * r * g.x, v[j].y * r * g.y) | ((unsigned long long)pk2(v[j].z * r * g.z, v[j].w * r * g.w) << 32); }
}
__device__ __forceinline__ void p0_weffq_wg(const float* wquery, const float* subkeys, const float* gain, signed char* WQ, float* wscale, int item, LAS unsigned char* lds, int tid) {
    const int hp = item >> 4, kg = item & 15, lane = tid & 63, wave = tid >> 6;
    LAS f32x4* sk = (LAS f32x4*)lds;
    LAS float* am_s = (LAS float*)(lds + 8192);
    if (tid < 256) sk[tid] = ((const f32x4*)(subkeys + (size_t)(hp * 128 + kg * 8) * 128))[tid];
    __syncthreads();
    float acc[2][8];
#pragma unroll
    for (int ph = 0; ph < 2; ++ph) { const int k = (ph * 8 + wave) * 64 + lane; const f32x4* wrow = (const f32x4*)(wquery + (size_t)k * 2048 + hp * 128);
#pragma unroll
        for (int i = 0; i < 8; ++i) acc[ph][i] = 0.f;
#pragma unroll 4
        for (int d4 = 0; d4 < 32; ++d4) { const f32x4 w = wrow[d4];
#pragma unroll
            for (int key = 0; key < 8; ++key) { const f32x4 sv = sk[key * 32 + d4]; acc[ph][key] += (w.x * sv.x + w.y * sv.y) + (w.z * sv.z + w.w * sv.w); } }
        const float g = gain[k];
#pragma unroll
        for (int i = 0; i < 8; ++i) acc[ph][i] *= g; }
#pragma unroll
    for (int key = 0; key < 8; ++key) { const float m = wave_max(fmaxf(fabsf(acc[0][key]), fabsf(acc[1][key]))); if (lane == 0) am_s[wave * 8 + key] = m; }
    __syncthreads();
    if (tid < 8) { float m = 0.f;
#pragma unroll
        for (int w8 = 0; w8 < 8; ++w8) m = fmaxf(m, am_s[w8 * 8 + tid]);
        am_s[256 + tid] = m; wscale[hp * 128 + kg * 8 + tid] = m * (1.0f / 127.0f); }
    __syncthreads();
#pragma unroll
    for (int key = 0; key < 8; ++key) { const float am = am_s[256 + key]; const float inv = am > 0.f ? 127.0f / am : 0.f;
#pragma unroll
        for (int ph = 0; ph < 2; ++ph) WQ[(size_t)(hp * 128 + kg * 8 + key) * 1024 + (ph * 8 + wave) * 64 + lane] = (signed char)(int)rintf(acc[ph][key] * inv); }
    __syncthreads();
}
__device__ __forceinline__ void p0_win_wg(const float* W, signed char* WQ, float* wscale, int item, LAS unsigned char* lds, int tid) {
    const int n0 = 14 * item, nl = tid & 15, kr = tid >> 4; const bool act = nl < 14;
    LAS float* am_s = (LAS float*)lds;
    LAS unsigned char* tile = lds + 4096;
    float wv[32]; float am = 0.f;
#pragma unroll
    for (int i = 0; i < 32; ++i) wv[i] = act ? W[(size_t)(kr + 32 * i) * IN_COLS + n0 + nl] : 0.f;
#pragma unroll
    for (int i = 0; i < 32; ++i) am = fmaxf(am, fabsf(wv[i]));
    am_s[kr * 16 + nl] = am;
    __syncthreads();
    if (tid < 16) { float m = 0.f;
#pragma unroll
        for (int r = 0; r < 32; ++r) m = fmaxf(m, am_s[r * 16 + tid]);
        am_s[512 + tid] = m; if (tid < 14) wscale[n0 + tid] = m * (1.0f / 127.0f); }
    __syncthreads();
    { const float amx = am_s[512 + nl]; const float inv = amx > 0.f ? 127.0f / amx : 0.f;
      if (act) {
#pragma unroll
          for (int i = 0; i < 32; ++i) tile[nl * 1028 + kr + 32 * i] = (unsigned char)((int)rintf(wv[i] * inv) & 255); } }
    __syncthreads();
    for (int p = tid; p < 14 * 64; p += NT) { const int n = p >> 6, c = p & 63; const LAS unsigned* src = (const LAS unsigned*)(tile + n * 1028 + 16 * c);
        *(v4u*)(WQ + (size_t)(n0 + n) * 1024 + 16 * c) = (v4u){src[0], src[1], src[2], src[3]}; }
    __syncthreads();
}
__device__ __forceinline__ void p0_prologue(const float* const* in, unsigned char* ws, LAS unsigned char* lds, int vcu, int G, int tid, int sel) {
    const int lane = tid & 63, wave = __builtin_amdgcn_readfirstlane(tid >> 6), gw = vcu * NWAVES + wave, NGW = G * NWAVES;
    LAS float* scr = (LAS float*)(lds + wave * 16384);
    const float *x = in[0], *mem = in[1], *mix_norm_w = in[2], *w_in = in[3], *w_out = in[8], *xattn_norm_w = in[9], *mem_norm_w = in[10], *wq = in[11], *wkv = in[12], *wo = in[13],
                *ffn_norm_w = in[14], *w_query = in[15], *sub_keys = in[16];
    if (sel & 1) for (int it = vcu; it < 256; it += G) { p0_weffq_wg(w_query, sub_keys, ffn_norm_w, (signed char*)(ws + WS_WEFF), (float*)(ws + WS_WEFF + 2 * MiB), it, lds, tid);
                                                          p0_win_wg(w_in, (signed char*)(ws + WS_WIN), (float*)(ws + WS_WIN + 4 * MiB), it, lds, tid); }
    constexpr int I_SQ = 16 * 32, I_KV = 16 * 64;
    constexpr int NITEMS = 3 * I_SQ + I_KV;
    if (sel & 2) for (int it = gw; it < NITEMS; it += NGW) {
        int r = it;
        if (r < I_SQ) { p0_transpose_item(w_out, 1024, 1024, (bf16*)(ws + WS_WOUT), nullptr, scr, r, lane); continue; } r -= I_SQ;
        if (r < I_SQ) { p0_transpose_item(wq, 1024, 1024, (bf16*)(ws + WS_WQ), xattn_norm_w, scr, r, lane); continue; } r -= I_SQ;
        if (r < I_KV) { p0_transpose_item(wkv, 1024, 2048, (bf16*)(ws + WS_WKV), nullptr, scr, r, lane); continue; } r -= I_KV;
        p0_transpose_item(wo, 1024, 1024, (bf16*)(ws + WS_WO), nullptr, scr, r, lane);
    }
    if (!(sel & 4)) return;
    for (int m = gw; m < MROWS; m += NGW) rms_row_to_bf16(mem + (size_t)m * D, mem_norm_w, (bf16*)(ws + WS_MEMN) + (size_t)m * D, lane);
    for (int m = gw; m < M; m += 4 * NGW) {
        f32x4 v[4][4]; float ss[4], am[4];
#pragma unroll
        for (int r = 0; r < 4; ++r) { const int mr = m + r * NGW < M ? m + r * NGW : m; const f32x4* xr = (const f32x4*)(x + (size_t)mr * D) + lane;
#pragma unroll
            for (int j = 0; j < 4; ++j) v[r][j] = xr[64 * j]; }
        const f32x4* gr = (const f32x4*)mix_norm_w + lane;
#pragma unroll
        for (int r = 0; r < 4; ++r) { float s = 0.f, a_ = 0.f;
#pragma unroll
            for (int j = 0; j < 4; ++j) { s += (v[r][j].x * v[r][j].x + v[r][j].y * v[r][j].y) + (v[r][j].z * v[r][j].z + v[r][j].w * v[r][j].w); v[r][j] = v[r][j] * gr[64 * j];
                a_ = fmaxf(a_, fmaxf(fmaxf(fabsf(v[r][j].x), fabsf(v[r][j].y)), fmaxf(fabsf(v[r][j].z), fabsf(v[r][j].w)))); }
            ss[r] = s; am[r] = a_; }
#pragma unroll
        for (int r = 0; r < 4; ++r) { ss[r] = wave_sum(ss[r]); am[r] = wave_max(am[r]); }
#pragma unroll
        for (int r = 0; r < 4; ++r) { if (m + r * NGW < M) { const int mr = m + r * NGW; const float rr = rsqrtf(ss[r] * (1.0f / 1024.0f) + EPS), inv = am[r] > 0.f ? 127.0f / am[r] : 0.f;
            unsigned* o4 = (unsigned*)(ws + WS_A + (size_t)mr * D) + lane;
#pragma unroll
            for (int j = 0; j < 4; ++j) { const int q0 = (int)rintf(v[r][j].x * inv), q1 = (int)rintf(v[r][j].y * inv), q2 = (int)rintf(v[r][j].z * inv), q3 = (int)rintf(v[r][j].w * inv);
                o4[64 * j] = (unsigned)(q0 & 255) | ((unsigned)(q1 & 255) << 8) | ((unsigned)(q2 & 255) << 16) | ((unsigned)(q3 & 255) << 24); }
            if (lane == 0) ((float*)(ws + WS_PART1))[mr] = rr * am[r] * (1.0f / 127.0f); } }
    }
}

struct ConvIn { v4u bg, cg0, vv0, cg1, vv1, cg2, vv2; };
__device__ __forceinline__ ConvIn conv_load(const bf16* P, int m, int lane) {
    const int t = m & (SEQ - 1), c0 = 8 * lane; const bf16* row = P + (size_t)m * IN_COLS; ConvIn in;
    in.bg = *(const v4u*)(row + c0); in.cg0 = *(const v4u*)(row + 512 + c0); in.vv0 = *(const v4u*)(row + 1024 + c0);
    in.cg1 = (v4u){0, 0, 0, 0}; in.vv1 = (v4u){0, 0, 0, 0}; in.cg2 = (v4u){0, 0, 0, 0}; in.vv2 = (v4u){0, 0, 0, 0};
    if (t >= 1) { in.cg1 = *(const v4u*)(row - IN_COLS + 512 + c0); in.vv1 = *(const v4u*)(row - IN_COLS + 1024 + c0); }
    if (t >= 2) { in.cg2 = *(const v4u*)(row - 2 * IN_COLS + 512 + c0); in.vv2 = *(const v4u*)(row - 2 * IN_COLS + 1024 + c0); }
    return in;
}
__device__ __forceinline__ void conv_finish(const ConvIn& in, const float* conv_w, const float* conv_norm_w, bf16* Y, int m, int lane) {
    const int c0 = 8 * lane;
    const f32x4 w0a = *(const f32x4*)(conv_w + c0), w0b = *(const f32x4*)(conv_w + c0 + 4);
    const f32x4 w1a = *(const f32x4*)(conv_w + 512 + c0), w1b = *(const f32x4*)(conv_w + 512 + c0 + 4);
    const f32x4 w2a = *(const f32x4*)(conv_w + 1024 + c0), w2b = *(const f32x4*)(conv_w + 1024 + c0 + 4);
    float y[8]; float ss = 0.f;
#pragma unroll
    for (int q = 0; q < 4; ++q) {
#pragma unroll
        for (int hl = 0; hl < 2; ++hl) { const int e = 2 * q + hl;
            const float b = hl ? bfhi(in.bg[q]) : bflo(in.bg[q]);
            const float u0 = (hl ? bfhi(in.cg0[q]) : bflo(in.cg0[q])) * (hl ? bfhi(in.vv0[q]) : bflo(in.vv0[q]));
            const float u1 = (hl ? bfhi(in.cg1[q]) : bflo(in.cg1[q])) * (hl ? bfhi(in.vv1[q]) : bflo(in.vv1[q]));
            const float u2 = (hl ? bfhi(in.cg2[q]) : bflo(in.cg2[q])) * (hl ? bfhi(in.vv2[q]) : bflo(in.vv2[q]));
            const float wt0 = e < 4 ? w0a[e & 3] : w0b[e & 3], wt1 = e < 4 ? w1a[e & 3] : w1b[e & 3], wt2 = e < 4 ? w2a[e & 3] : w2b[e & 3];
            y[e] = b * (wt0 * u2 + wt1 * u1 + wt2 * u0); ss += y[e] * y[e]; } }
    const float r = rsqrtf(wave_sum(ss) * (1.0f / 512.0f) + EPS);
    const f32x4 ga = *(const f32x4*)(conv_norm_w + c0), gb = *(const f32x4*)(conv_norm_w + c0 + 4);
    v4u o; o.x = pk2(y[0] * r * ga[0], y[1] * r * ga[1]); o.y = pk2(y[2] * r * ga[2], y[3] * r * ga[3]); o.z = pk2(y[4] * r * gb[0], y[5] * r * gb[1]); o.w = pk2(y[6] * r * gb[2], y[7] * r * gb[3]);
    *(v4u*)(Y + (size_t)m * 1024 + c0) = o;
}
__device__ __forceinline__ void conv_tokens4(const bf16* P, const float* conv_w, const float* conv_norm_w, bf16* Y, int m0, int lane) {
    const int t0 = m0 & (SEQ - 1), c0 = 8 * lane; const bf16* row = P + (size_t)m0 * IN_COLS;
    v4u bg[4], cg[6], vv[6];
#pragma unroll
    for (int r = 0; r < 4; ++r) bg[r] = *(const v4u*)(row + (size_t)r * IN_COLS + c0);
#pragma unroll
    for (int r = 0; r < 6; ++r) { if (t0 + r - 2 >= 0) { cg[r] = *(const v4u*)(row + (ptrdiff_t)(r - 2) * IN_COLS + 512 + c0); vv[r] = *(const v4u*)(row + (ptrdiff_t)(r - 2) * IN_COLS + 1024 + c0); } else { cg[r] = (v4u){0, 0, 0, 0}; vv[r] = (v4u){0, 0, 0, 0}; } }
    const f32x4 w0a = *(const f32x4*)(conv_w + c0), w0b = *(const f32x4*)(conv_w + c0 + 4);
    const f32x4 w1a = *(const f32x4*)(conv_w + 512 + c0), w1b = *(const f32x4*)(conv_w + 512 + c0 + 4);
    const f32x4 w2a = *(const f32x4*)(conv_w + 1024 + c0), w2b = *(const f32x4*)(conv_w + 1024 + c0 + 4);
    const f32x4 ga = *(const f32x4*)(conv_norm_w + c0), gb = *(const f32x4*)(conv_norm_w + c0 + 4);
    float u[6][8];
#pragma unroll
    for (int r = 0; r < 6; ++r)
#pragma unroll
        for (int q = 0; q < 4; ++q) { u[r][2 * q] = bflo(cg[r][q]) * bflo(vv[r][q]); u[r][2 * q + 1] = bfhi(cg[r][q]) * bfhi(vv[r][q]); }
    float y[4][8], ss[4];
#pragma unroll
    for (int r = 0; r < 4; ++r) { float s = 0.f;
#pragma unroll
        for (int e = 0; e < 8; ++e) { const float b = (e & 1) ? bfhi(bg[r][e >> 1]) : bflo(bg[r][e >> 1]);
            const float wt0 = e < 4 ? w0a[e & 3] : w0b[e & 3], wt1 = e < 4 ? w1a[e & 3] : w1b[e & 3], wt2 = e < 4 ? w2a[e & 3] : w2b[e & 3];
            y[r][e] = b * (wt0 * u[r][e] + wt1 * u[r + 1][e] + wt2 * u[r + 2][e]); s += y[r][e] * y[r][e]; }
        ss[r] = s; }
#pragma unroll
    for (int r = 0; r < 4; ++r) { const float rr = rsqrtf(wave_sum(ss[r]) * (1.0f / 512.0f) + EPS);
        v4u o; o.x = pk2(y[r][0] * rr * ga[0], y[r][1] * rr * ga[1]); o.y = pk2(y[r][2] * rr * ga[2], y[r][3] * rr * ga[3]); o.z = pk2(y[r][4] * rr * gb[0], y[r][5] * rr * gb[1]); o.w = pk2(y[r][6] * rr * gb[2], y[r][7] * rr * gb[3]);
        *(v4u*)(Y + (size_t)(m0 + r) * 1024 + c0) = o; }
}

__device__ __forceinline__ void h1_unit(int b, int n, const bf16* P, const float* lbl, bf16* UsT, float* decay, LAS unsigned char* lds, int tid) {
    const int c = tid, h = c >> 7, kch = c & 127, lane = tid & 63, w = tid >> 6;
    const size_t tok0 = (size_t)b * SEQ + (size_t)n * 64;
    const float lb = sigmoidf_(lbl[c] - lbl[512 + c]), oml = 1.0f - lb;
    LAS unsigned char* KT = lds; LAS unsigned char* IT = lds + 65536; LAS float* DEC = (LAS float*)(lds + 131072);
    {
        const bf16* pf = P + tok0 * IN_COLS + 2048 + c;
        float Pf = 1.f;
#pragma unroll 1
        for (int seg = 0; seg < 2; ++seg) {
            float fv[32]; unsigned iv[16];
#pragma unroll
            for (int j = 0; j < 32; ++j) fv[j] = bf2f(pf[(size_t)j * IN_COLS]);
#pragma unroll
            for (int j = 0; j < 16; ++j) iv[j] = (unsigned)pf[(size_t)(2 * j) * IN_COLS + 512] | ((unsigned)pf[(size_t)(2 * j + 1) * IN_COLS + 512] << 16);
            pf += (size_t)32 * IN_COLS;
#pragma unroll
            for (int q = 0; q < 4; ++q) { unsigned pk[4];
#pragma unroll
                for (int e = 0; e < 4; ++e) { float kt2[2];
#pragma unroll
                    for (int hl = 0; hl < 2; ++hl) { const float sg = sigmoidf_(fv[8 * q + 2 * e + hl]); Pf *= lb + oml * sg; kt2[hl] = oml * (1.0f - sg) * __builtin_amdgcn_rcpf(Pf); }
                    pk[e] = pk2(kt2[0], kt2[1]); }
                *(LAS v4u*)(KT + c * 128 + (((4 * seg + q) ^ (c & 7)) * 16)) = (v4u){pk[0], pk[1], pk[2], pk[3]}; }
#pragma unroll
            for (int q = 0; q < 4; ++q) *(LAS v4u*)(IT + c * 128 + (((4 * seg + q) ^ (c & 7)) * 16)) = (v4u){iv[4 * q], iv[4 * q + 1], iv[4 * q + 2], iv[4 * q + 3]};
        }
        const float dcy = Pf;
        DEC[c] = dcy;
        decay[((size_t)(b * 4 + h) * 128 + n) * 128 + kch] = dcy;
    }
    __syncthreads();
    {
        const int hd = w >> 1, half = w & 1, l31 = lane & 31, hh = lane >> 5;
        bf16* ub = UsT + ((size_t)(b * 4 + hd) * 128 + n) * 16384;
#pragma unroll 1
        for (int vb = 0; vb < 2; ++vb) {
            f32x16 acc[4];
#pragma unroll
            for (int bq = 0; bq < 4; ++bq)
#pragma unroll
                for (int r = 0; r < 16; ++r) acc[bq][r] = 0.f;
            const int v = hd * 128 + (half * 2 + vb) * 32 + l31;
#pragma unroll
            for (int s = 0; s < 4; ++s) { const int chunk = 2 * s + hh; bf16x8 bfr[4];
                const bf16x8 af = *(const LAS bf16x8*)(IT + v * 128 + ((chunk ^ (v & 7)) * 16));
#pragma unroll
                for (int kb = 0; kb < 4; ++kb) { const int k = hd * 128 + kb * 32 + l31; bfr[kb] = *(const LAS bf16x8*)(KT + k * 128 + ((chunk ^ (k & 7)) * 16)); }
#pragma unroll
                for (int kb = 0; kb < 4; ++kb) acc[kb] = __builtin_amdgcn_mfma_f32_32x32x16_bf16(af, bfr[kb], acc[kb], 0, 0, 0); }
#pragma unroll
            for (int kb = 0; kb < 4; ++kb) { const float dk = DEC[hd * 128 + kb * 32 + l31];
#pragma unroll
                for (int r = 0; r < 16; ++r) { const int vr = (half * 2 + vb) * 32 + (r & 3) + 8 * (r >> 2) + 4 * hh; ub[(size_t)vr * 128 + kb * 32 + l31] = (bf16)(pk2(acc[kb][r] * dk, 0.f) & 0xffffu); } }
        }
    }
    __syncthreads();
}

__device__ __forceinline__ void h2_scan(bf16* UsT, const float* decay, int gw, int NGW, int lane, long dry_off) {
    for (int task = gw; task < 16 * 128; task += NGW) {
        const int bh = task >> 7, v = task & 127;
        unsigned* p = (unsigned*)(UsT + (size_t)bh * 128 * 16384 + (size_t)v * 128) + lane;
        const f32x2* dp = (const f32x2*)(decay + (size_t)bh * 128 * 128) + lane;
        f32x2 S = {0.f, 0.f};
        for (int n0 = 0; n0 < 128; n0 += 16) { unsigned u[16]; f32x2 d[16];
#pragma unroll
            for (int j = 0; j < 16; ++j) { u[j] = p[(size_t)(n0 + j) * 8192]; d[j] = dp[(size_t)(n0 + j) * 64]; }
#pragma unroll
            for (int j = 0; j < 16; ++j) { p[(size_t)(n0 + j) * 8192 + dry_off] = pk2(S.x, S.y); S = d[j] * S + (f32x2){bflo(u[j]), bfhi(u[j])}; } }
    }
}

__device__ __forceinline__ void h3_unit(int b, int n, int h, const bf16* P, const float* lbl, const bf16* UsT, const float* hnw, bf16* Y, LAS unsigned char* lds, int tid) {
    const int lane = tid & 63, w = tid >> 6, bh = b * 4 + h;
    const size_t tok0 = (size_t)b * SEQ + (size_t)n * 64;
    LAS unsigned char* RAW = lds; LAS unsigned char* QD = lds + 49152; LAS unsigned char* KI = lds + 65536; LAS unsigned char* IT = lds + 81920; LAS unsigned char* ST = lds + 98304;
    LAS float* OS = (LAS float*)lds; LAS float* TOT = (LAS float*)(lds + 131072);
    {
        { v4u raw[3][2];
#pragma unroll
          for (int tl = 0; tl < 3; ++tl)
#pragma unroll
              for (int i = 0; i < 2; ++i) { const int idx = tid + 512 * i, row = idx >> 4, ch = idx & 15; raw[tl][i] = *(const v4u*)(P + (tok0 + row) * IN_COLS + 1536 + 512 * tl + h * 128 + 8 * ch); }
          const int v = tid >> 2, kq = tid & 3; const v4u* src = (const v4u*)(UsT + ((size_t)bh * 128 + n) * 16384 + (size_t)v * 128 + 32 * kq); v4u stv[4];
#pragma unroll
          for (int i = 0; i < 4; ++i) stv[i] = src[i];
#pragma unroll
          for (int tl = 0; tl < 3; ++tl)
#pragma unroll
              for (int i = 0; i < 2; ++i) *(LAS v4u*)(RAW + tl * 16384 + (tid + 512 * i) * 16) = raw[tl][i];
#pragma unroll
          for (int i = 0; i < 4; ++i) *(LAS v4u*)(ST + v * 256 + (((4 * kq + i) ^ (v & 15)) * 16)) = stv[i]; }
        __syncthreads();
        const int k = tid & 127, tq = tid >> 7;
        const float lb = sigmoidf_(lbl[h * 128 + k] - lbl[512 + h * 128 + k]), oml = 1.0f - lb;
        const LAS bf16* rq = (const LAS bf16*)RAW + (16 * tq) * 128 + k; const LAS bf16* rf = rq + 8192; const LAS bf16* ri = rq + 16384;
        float sg[16], cs[16], qv[16]; float c = 1.f;
#pragma unroll
        for (int j = 0; j < 16; ++j) { const float f = bf2f(rf[j * 128]); qv[j] = bf2f(rq[j * 128]); sg[j] = sigmoidf_(f); c *= lb + oml * sg[j]; cs[j] = c; }
        TOT[tq * 128 + k] = c;
        { unsigned iv[8];
#pragma unroll
          for (int j = 0; j < 8; ++j) iv[j] = (unsigned)ri[(2 * j) * 128] | ((unsigned)ri[(2 * j + 1) * 128] << 16);
          const int sw = (k >> 1) & 7;
          *(LAS v4u*)(IT + k * 128 + (((2 * tq) ^ sw) * 16)) = (v4u){iv[0], iv[1], iv[2], iv[3]};
          *(LAS v4u*)(IT + k * 128 + (((2 * tq + 1) ^ sw) * 16)) = (v4u){iv[4], iv[5], iv[6], iv[7]}; }
        __syncthreads();
        float off = 1.f;
#pragma unroll
        for (int q = 0; q < 4; ++q) off *= (q < tq) ? TOT[q * 128 + k] : 1.f;
#pragma unroll
        for (int j = 0; j < 16; ++j) { const int t = 16 * tq + j; const float eg = off * cs[j];
            const float qd = qv[j] * sigmoidf_(qv[j]) * eg, ki = oml * (1.0f - sg[j]) * __builtin_amdgcn_rcpf(eg);
            const int o = t * 256 + (((k >> 3) ^ (t & 15)) * 16) + (k & 7) * 2;
            *(LAS bf16*)(QD + o) = (bf16)(pk2(qd, 0.f) & 0xffffu); *(LAS bf16*)(KI + o) = (bf16)(pk2(ki, 0.f) & 0xffffu); }
    }
    __syncthreads();
    {
        const int tb = w & 1, vb = w >> 1, l31 = lane & 31, hh = lane >> 5, t = 32 * tb + l31;
        bf16x8 qf[8];
#pragma unroll
        for (int ks = 0; ks < 8; ++ks) qf[ks] = *(const LAS bf16x8*)(QD + t * 256 + (((2 * ks + hh) ^ (t & 15)) * 16));
        f32x16 o;
#pragma unroll
        for (int r = 0; r < 16; ++r) o[r] = 0.f;
        const int v = 32 * vb + l31;
#pragma unroll
        for (int sb = 0; sb < 2; ++sb) {
            if (sb <= tb) {
                f32x16 x;
#pragma unroll
                for (int r = 0; r < 16; ++r) x[r] = 0.f;
                const int srow = 32 * sb + kappa(l31);
#pragma unroll
                for (int ks = 0; ks < 8; ++ks) { const bf16x8 a = *(const LAS bf16x8*)(KI + srow * 256 + (((2 * ks + hh) ^ (srow & 15)) * 16)); x = __builtin_amdgcn_mfma_f32_32x32x16_bf16(a, qf[ks], x, 0, 0, 0); }
                if (sb == tb) {
#pragma unroll
                    for (int r = 0; r < 16; ++r) { const int sp = 16 * ((r >> 3) & 1) + 8 * hh + 4 * ((r >> 2) & 1) + (r & 3); if (sp > l31) x[r] = 0.f; } }
#pragma unroll
                for (int st = 0; st < 2; ++st) {
                    const v4u pb = {pk2(x[8 * st + 0], x[8 * st + 1]), pk2(x[8 * st + 2], x[8 * st + 3]), pk2(x[8 * st + 4], x[8 * st + 5]), pk2(x[8 * st + 6], x[8 * st + 7])};
                    const bf16x8 a = *(const LAS bf16x8*)(IT + v * 128 + (((4 * sb + 2 * st + hh) ^ ((v >> 1) & 7)) * 16));
                    o = __builtin_amdgcn_mfma_f32_32x32x16_bf16(a, as_bf16x8(pb), o, 0, 0, 0); }
            }
        }
#pragma unroll
        for (int ks = 0; ks < 8; ++ks) { const bf16x8 a = *(const LAS bf16x8*)(ST + v * 256 + (((2 * ks + hh) ^ (v & 15)) * 16)); o = __builtin_amdgcn_mfma_f32_32x32x16_bf16(a, qf[ks], o, 0, 0, 0); }
#pragma unroll
        for (int r = 0; r < 16; ++r) OS[t * 129 + 32 * vb + (r & 3) + 8 * (r >> 2) + 4 * hh] = o[r];
    }
    __syncthreads();
    {
        const int t = tid >> 3, vc = tid & 7; float ov[16]; float ss = 0.f;
#pragma unroll
        for (int j = 0; j < 16; ++j) { ov[j] = OS[t * 129 + 16 * vc + j]; ss += ov[j] * ov[j]; }
        ss += xlane_dpp_b1(ss); ss += xlane_dpp_4e(ss); ss += xlane_dpp_x4(ss);
        const float r = rsqrtf(ss * (1.0f / 128.0f) + EPS);
        const bf16* gp = P + (tok0 + t) * IN_COLS + 3072 + h * 128 + 16 * vc;
        const v4u g0 = *(const v4u*)gp, g1 = *(const v4u*)(gp + 8);
        const float* nw = hnw + h * 128 + 16 * vc;
        unsigned ow[8];
#pragma unroll
        for (int j = 0; j < 8; ++j) { const unsigned gw_ = j < 4 ? g0[j] : g1[j - 4]; const float ga = bflo(gw_), gb = bfhi(gw_);
            ow[j] = pk2(ov[2 * j] * r * nw[2 * j] * (ga * sigmoidf_(ga)), ov[2 * j + 1] * r * nw[2 * j + 1] * (gb * sigmoidf_(gb))); }
        bf16* yp = Y + (tok0 + t) * 1024 + 512 + h * 128 + 16 * vc;
        *(v4u*)yp = (v4u){ow[0], ow[1], ow[2], ow[3]}; *(v4u*)(yp + 8) = (v4u){ow[4], ow[5], ow[6], ow[7]};
    }
    __syncthreads();
}

typedef float f32x4a __attribute__((ext_vector_type(4)));
__device__ __forceinline__ int kswz(int row) { return (row & 3) | (((row >> 3) & 3) << 2); }
__device__ __forceinline__ void attn_unit(int b, int hd, int qb, const bf16* Q, const bf16* Kb, const bf16* VT, bf16* O, LAS unsigned char* lds, int tid) {
    const int lane = tid & 63, w = __builtin_amdgcn_readfirstlane(tid >> 6), l15 = lane & 15, kq = lane >> 4, bh = b * 4 + hd;
    const size_t tok = (size_t)b * SEQ + (size_t)qb * 128 + 16 * w + l15;
    const bf16* kbase = Kb + (size_t)bh * 65536; const bf16* vbase = VT + (size_t)bh * 65536;
#define ATT_LOAD(j) do { _Pragma("unroll") for (int i = 0; i < 4; ++i) { const int idx = tid + 512 * i; const bf16* src_; \
        if ((j) < 4) { const int row = idx >> 5, ch = idx & 31; src_ = kbase + (size_t)(j) * 16384 + row * 256 + ((ch ^ kswz(row)) * 8); } \
        else { const int row = idx >> 3, ch = idx & 7; src_ = vbase + (size_t)row * 256 + 64 * ((j) - 4) + ((ch ^ ((row >> 1) & 7)) * 8); } \
        __builtin_amdgcn_global_load_lds((const unsigned*)src_, (LAS unsigned*)(lds + ((j) & 1) * 32768 + i * 8192 + w * 1024), 16, 0, 0); } } while (0)
#define ATT_LANDED() do { asm volatile("s_waitcnt vmcnt(0)" ::: "memory"); __syncthreads(); } while (0)
    bf16x8 qf[8];
    { const bf16* qp = Q + tok * 1024 + hd * 256 + 8 * kq;
#pragma unroll
      for (int ks = 0; ks < 8; ++ks) qf[ks] = *(const bf16x8*)(qp + 32 * ks); }
    ATT_LOAD(0);
    ATT_LANDED();
    f32x4a p[16];
#pragma unroll
    for (int j = 0; j < 4; ++j) {
        ATT_LOAD(j + 1);
        const LAS unsigned char* buf = lds + (j & 1) * 32768;
#pragma unroll
        for (int blk = 0; blk < 4; ++blk) { f32x4a x = {0.f, 0.f, 0.f, 0.f};
            const int row = 32 * (blk >> 1) + 8 * (l15 >> 2) + 4 * (blk & 1) + (l15 & 3);
#pragma unroll
            for (int ks = 0; ks < 8; ++ks) { const bf16x8 a = *(const LAS bf16x8*)(buf + row * 512 + (((4 * ks + kq) ^ kswz(row)) * 16)); x = __builtin_amdgcn_mfma_f32_16x16x32_bf16(a, qf[ks], x, 0, 0, 0); }
            p[4 * j + blk] = x; }
        ATT_LANDED();
    }
    float mx = p[0][0];
#pragma unroll
    for (int i = 0; i < 16; ++i)
#pragma unroll
        for (int r = 0; r < 4; ++r) mx = fmaxf(mx, p[i][r]);
    mx = fmaxf(mx, __shfl_xor(mx, 16)); mx = fmaxf(mx, __shfl_xor(mx, 32));
    float lsum = 0.f;
#pragma unroll
    for (int i = 0; i < 16; ++i)
#pragma unroll
        for (int r = 0; r < 4; ++r) { p[i][r] = __builtin_amdgcn_exp2f(p[i][r] - mx); lsum += p[i][r]; }
    lsum += __shfl_xor(lsum, 16); lsum += __shfl_xor(lsum, 32);
    const float inv = 1.0f / lsum;
    v4u pb[8];
#pragma unroll
    for (int s = 0; s < 8; ++s) pb[s] = (v4u){pk2(p[2 * s][0], p[2 * s][1]), pk2(p[2 * s][2], p[2 * s][3]), pk2(p[2 * s + 1][0], p[2 * s + 1][1]), pk2(p[2 * s + 1][2], p[2 * s + 1][3])};
    f32x4a ot[16];
#pragma unroll
    for (int i = 0; i < 16; ++i) ot[i] = (f32x4a){0.f, 0.f, 0.f, 0.f};
#pragma unroll
    for (int j = 4; j < 8; ++j) {
        if (j + 1 < 8) ATT_LOAD(j + 1);
        const LAS unsigned char* buf = lds + (j & 1) * 32768;
#pragma unroll
        for (int db = 0; db < 16; ++db) { const int row = 16 * db + l15;
#pragma unroll
            for (int s = 0; s < 2; ++s) { const bf16x8 a = *(const LAS bf16x8*)(buf + row * 128 + (((4 * s + kq) ^ ((row >> 1) & 7)) * 16));
                ot[db] = __builtin_amdgcn_mfma_f32_16x16x32_bf16(a, as_bf16x8(pb[2 * (j - 4) + s]), ot[db], 0, 0, 0); } }
        ATT_LANDED();
    }
    bf16* op = O + tok * 1024 + hd * 256 + 4 * kq;
#pragma unroll
    for (int db = 0; db < 16; ++db) { v2u o2 = {pk2(ot[db][0] * inv, ot[db][1] * inv), pk2(ot[db][2] * inv, ot[db][3] * inv)}; *(v2u*)(op + 16 * db) = o2; }
#undef ATT_LOAD
#undef ATT_LANDED
}

__device__ __forceinline__ unsigned ord_f32(float f) { const unsigned u = __float_as_uint(f); return u ^ ((unsigned)((int)u >> 31) | 0x80000000u); }
__device__ __forceinline__ float unord_f32(unsigned o) { return __uint_as_float(o ^ (~(unsigned)((int)o >> 31) | 0x80000000u)); }
__device__ __forceinline__ void ce_desc(unsigned& a, unsigned& b) { const unsigned hi = a > b ? a : b, lo = a > b ? b : a; a = hi; b = lo; }
__device__ __forceinline__ void sort16_desc(unsigned (&a)[16]) {
    ce_desc(a[0], a[1]); ce_desc(a[2], a[3]); ce_desc(a[0], a[2]); ce_desc(a[1], a[3]); ce_desc(a[1], a[2]); ce_desc(a[4], a[5]); ce_desc(a[6], a[7]); ce_desc(a[4], a[6]); ce_desc(a[5], a[7]); ce_desc(a[5], a[6]);
    ce_desc(a[0], a[4]); ce_desc(a[2], a[6]); ce_desc(a[2], a[4]); ce_desc(a[1], a[5]); ce_desc(a[3], a[7]); ce_desc(a[3], a[5]); ce_desc(a[1], a[2]); ce_desc(a[3], a[4]); ce_desc(a[5], a[6]); ce_desc(a[8], a[9]);
    ce_desc(a[10], a[11]); ce_desc(a[8], a[10]); ce_desc(a[9], a[11]); ce_desc(a[9], a[10]); ce_desc(a[12], a[13]); ce_desc(a[14], a[15]); ce_desc(a[12], a[14]); ce_desc(a[13], a[15]); ce_desc(a[13], a[14]);
    ce_desc(a[8], a[12]); ce_desc(a[10], a[14]); ce_desc(a[10], a[12]); ce_desc(a[9], a[13]); ce_desc(a[11], a[15]); ce_desc(a[11], a[13]); ce_desc(a[9], a[10]); ce_desc(a[11], a[12]); ce_desc(a[13], a[14]);
    ce_desc(a[0], a[8]); ce_desc(a[4], a[12]); ce_desc(a[4], a[8]); ce_desc(a[2], a[10]); ce_desc(a[6], a[14]); ce_desc(a[6], a[10]); ce_desc(a[2], a[4]); ce_desc(a[6], a[8]); ce_desc(a[10], a[12]); ce_desc(a[1], a[9]);
    ce_desc(a[5], a[13]); ce_desc(a[5], a[9]); ce_desc(a[3], a[11]); ce_desc(a[7], a[15]); ce_desc(a[7], a[11]); ce_desc(a[3], a[5]); ce_desc(a[7], a[9]); ce_desc(a[11], a[13]); ce_desc(a[1], a[2]); ce_desc(a[3], a[4]);
    ce_desc(a[5], a[6]); ce_desc(a[7], a[8]); ce_desc(a[9], a[10]); ce_desc(a[11], a[12]); ce_desc(a[13], a[14]);
}
__device__ __forceinline__ void merge_prune16(unsigned (&top)[16], const unsigned (&nw)[16]) {
#pragma unroll
    for (int i = 0; i < 16; ++i) top[i] = top[i] > nw[15 - i] ? top[i] : nw[15 - i];
#pragma unroll
    for (int j = 8; j > 0; j >>= 1)
#pragma unroll
        for (int i = 0; i < 16; ++i) { const int l = i ^ j; if (l > i) ce_desc(top[i], top[l]); }
}
__device__ __forceinline__ void topk_load(const unsigned short* scT, int hp, int token, v2u (&raw)[32]) {
#pragma unroll
    for (int kq = 0; kq < 32; ++kq) raw[kq] = *(const v2u*)(scT + ((size_t)(hp * 32 + kq) * M + token) * 4);
}
typedef short s16x2v __attribute__((ext_vector_type(2)));
__device__ __forceinline__ unsigned ord_f16x2(unsigned w) { const s16x2v m = __builtin_bit_cast(s16x2v, w) >> 15; return w ^ (__builtin_bit_cast(unsigned, m) | 0x80008000u); }
__device__ __forceinline__ float unord_f16_hi(unsigned key) { const unsigned o = key >> 16; const unsigned h = o ^ ((o & 0x8000u) ? 0x8000u : 0xffffu); return (float)__builtin_bit_cast(_Float16, (unsigned short)h); }
__device__ __forceinline__ void topk_half(const v2u (&raw)[32], unsigned (&top)[16]) {
#pragma unroll
    for (int c = 0; c < 8; ++c) { unsigned nw[16];
#pragma unroll
        for (int q = 0; q < 4; ++q) { const unsigned x0 = ord_f16x2(raw[4 * c + q].x), x1 = ord_f16x2(raw[4 * c + q].y); const int b0 = 127 - (16 * c + 4 * q);
            nw[4 * q + 0] = (x0 << 16) | (unsigned)b0;         nw[4 * q + 1] = (x0 & 0xffff0000u) | (unsigned)(b0 - 1);
            nw[4 * q + 2] = (x1 << 16) | (unsigned)(b0 - 2);   nw[4 * q + 3] = (x1 & 0xffff0000u) | (unsigned)(b0 - 3); }
        sort16_desc(nw);
        if (c == 0) {
#pragma unroll
            for (int i = 0; i < 16; ++i) top[i] = nw[i]; }
        else merge_prune16(top, nw); }
}
__device__ __forceinline__ void peer_topk_task(const unsigned short* scT, int head, int token, unsigned short* idx_out, float* gate_out, LAS unsigned char* slot) {
    unsigned ta[16], tb[16];
    { v2u ra[32], rb[32]; topk_load(scT, 2 * head, token, ra); topk_load(scT, 2 * head + 1, token, rb); topk_half(ra, ta); topk_half(rb, tb); }
    float av[16], bv[16];
#pragma unroll
    for (int i = 0; i < 16; ++i) { av[i] = unord_f16_hi(ta[i]); bv[i] = unord_f16_hi(tb[i]); }
#pragma unroll
    for (int q = 0; q < 4; ++q) {
        unsigned wa = 0, wb = 0;
#pragma unroll
        for (int e = 0; e < 4; ++e) { wa |= (127u - (ta[4 * q + e] & 127u)) << (8 * e); wb |= (127u - (tb[4 * q + e] & 127u)) << (8 * e); }
        *(LAS unsigned*)(slot + 4 * q) = wa; *(LAS unsigned*)(slot + 16 + 4 * q) = wb; }
    unsigned cd[4][16];
#pragma unroll
    for (int q = 0; q < 4; ++q)
#pragma unroll
        for (int e = 0; e < 16; ++e) cd[q][e] = 0u;
    {
        constexpr int cnt[16] = {16, 8, 5, 4, 3, 2, 2, 2, 1, 1, 1, 1, 1, 1, 1, 1};
        constexpr int stt[16] = {0, 16, 24, 29, 33, 36, 38, 40, 42, 43, 44, 45, 46, 47, 48, 49};
#pragma unroll
        for (int i = 0; i < 16; ++i)
#pragma unroll
            for (int j = 0; j < 16; ++j) if (j < cnt[i]) { const int t = stt[i] + j; const int ch = t < 16 ? 0 : t < 24 ? 1 : t < 40 ? 2 : 3, ps = t < 16 ? t : t < 24 ? t - 16 : t < 40 ? t - 24 : t - 40;
                cd[ch][ps] = (ord_f32(av[i] + bv[j]) & ~63u) | (unsigned)(63 - t); }
    }
    sort16_desc(cd[2]); sort16_desc(cd[3]);
    merge_prune16(cd[0], cd[1]); merge_prune16(cd[2], cd[3]); merge_prune16(cd[0], cd[2]);
    LDS_WAIT();
    float gv[16]; float gs = 0.f; const float vmax = unord_f32(cd[0][0] & ~63u);
    unsigned ex[16];
#pragma unroll
    for (int r = 0; r < 16; ++r) {
        const int t = 63 - (int)(cd[0][r] & 63u);
        int i = (t >= 16) + (t >= 24) + (t >= 29) + (t >= 33) + (t >= 36) + (t >= 38) + (t >= 40);
        int st = t >= 40 ? 40 : t >= 38 ? 38 : t >= 36 ? 36 : t >= 33 ? 33 : t >= 29 ? 29 : t >= 24 ? 24 : t >= 16 ? 16 : 0;
        int j = t - st;
        if (t >= 42) { i = 8 + (t - 42); j = 0; }
        const unsigned ia = *(LAS unsigned char*)(slot + i), ib = *(LAS unsigned char*)(slot + 16 + j);
        ex[r] = ia * 128u + ib;
        gv[r] = __expf(unord_f32(cd[0][r] & ~63u) - vmax); gs += gv[r]; }
    const float ginv = 1.0f / gs;
    float* gp = gate_out + (size_t)token * 128 + head * 16;
#pragma unroll
    for (int jj = 0; jj < 8; ++jj) *(unsigned*)(idx_out + (size_t)token * 128 + jj * 16 + 2 * head) = ex[jj] | (ex[jj + 8] << 16);
#pragma unroll
    for (int q = 0; q < 4; ++q) *(f32x4*)(gp + 4 * q) = (f32x4){gv[4 * q] * ginv, gv[4 * q + 1] * ginv, gv[4 * q + 2] * ginv, gv[4 * q + 3] * ginv};
}

__device__ __forceinline__ float quant_row_sliced(const float* src, const float* gain, unsigned char* dst, int rows, int r, int offset, int lane) {
    f32x4 v[4]; float am = 0.f;
#pragma unroll
    for (int jq = 0; jq < 4; ++jq) { v[jq] = ((const f32x4*)src)[64 * jq + lane]; if (gain) v[jq] = v[jq] * ((const f32x4*)gain)[64 * jq + lane];
        am = fmaxf(am, fmaxf(fmaxf(fabsf(v[jq].x), fabsf(v[jq].y)), fmaxf(fabsf(v[jq].z), fabsf(v[jq].w)))); }
    am = wave_max(am);
    const float inv = am > 0.f ? 127.0f / am : 0.f;
#pragma unroll
    for (int jq = 0; jq < 4; ++jq) { const int sl = 2 * jq + (lane >> 5);
        const int q0 = (int)rintf(v[jq].x * inv) + offset, q1 = (int)rintf(v[jq].y * inv) + offset, q2 = (int)rintf(v[jq].z * inv) + offset, q3 = (int)rintf(v[jq].w * inv) + offset;
        *(unsigned*)(dst + ((size_t)sl * rows + r) * 128 + 4 * (lane & 31)) = (unsigned)(q0 & 255) | ((unsigned)(q1 & 255) << 8) | ((unsigned)(q2 & 255) << 16) | ((unsigned)(q3 & 255) << 24); }
    return am * (1.0f / 127.0f);
}
template <bool EO = false>
__device__ __forceinline__ void quant_store_row(const f32x4 (&v)[4], float inv, unsigned char* dst, int rows, int r, int lane) {
#pragma unroll
    for (int jq = 0; jq < 4; ++jq) { const int sl = 2 * jq + (lane >> 5);
        const int q0 = (int)rintf(v[jq].x * inv), q1 = (int)rintf(v[jq].y * inv), q2 = (int)rintf(v[jq].z * inv), q3 = (int)rintf(v[jq].w * inv);
        unsigned char* d_ = dst + ((size_t)sl * rows + r) * 128;
        if (EO) { *(unsigned short*)(d_ + 2 * (lane & 31)) = (unsigned short)((q0 & 255) | ((q2 & 255) << 8)); *(unsigned short*)(d_ + 64 + 2 * (lane & 31)) = (unsigned short)((q1 & 255) | ((q3 & 255) << 8)); }
        else *(unsigned*)(d_ + 4 * (lane & 31)) = (unsigned)(q0 & 255) | ((unsigned)(q1 & 255) << 8) | ((unsigned)(q2 & 255) << 16) | ((unsigned)(q3 & 255) << 24); }
}
__device__ __forceinline__ float row_amax(const f32x4 (&v)[4]) { float am = 0.f;
#pragma unroll
    for (int jq = 0; jq < 4; ++jq) am = fmaxf(am, fmaxf(fmaxf(fabsf(v[jq].x), fabsf(v[jq].y)), fmaxf(fabsf(v[jq].z), fabsf(v[jq].w))));
    return wave_max(am); }
__device__ __forceinline__ void quant_rows4(const float* down, const float* up, const float* gain, unsigned char* dstd, unsigned char* dstu, int e0, int e1, int lane, float* dscale, float* uscale) {
    f32x4 vd0[4], vu0[4], vd1[4], vu1[4];
#pragma unroll
    for (int jq = 0; jq < 4; ++jq) { vd0[jq] = ((const f32x4*)(down + (size_t)e0 * 1024))[64 * jq + lane]; vu0[jq] = ((const f32x4*)(up + (size_t)e0 * 1024))[64 * jq + lane];
        vd1[jq] = ((const f32x4*)(down + (size_t)e1 * 1024))[64 * jq + lane]; vu1[jq] = ((const f32x4*)(up + (size_t)e1 * 1024))[64 * jq + lane]; }
#pragma unroll
    for (int jq = 0; jq < 4; ++jq) { const f32x4 g = ((const f32x4*)gain)[64 * jq + lane]; vd0[jq] = vd0[jq] * g; vd1[jq] = vd1[jq] * g; }
    const float ad0 = row_amax(vd0), au0 = row_amax(vu0), ad1 = row_amax(vd1), au1 = row_amax(vu1);
    quant_store_row(vd0, ad0 > 0.f ? 127.0f / ad0 : 0.f, dstd, NEXP, e0, lane); quant_store_row<true>(vu0, au0 > 0.f ? 127.0f / au0 : 0.f, dstu, NEXP, e0, lane);
    if (lane == 0) { dscale[e0] = ad0 * (1.0f / 127.0f); uscale[e0] = au0 * (1.0f / 127.0f); }
    if (e1 != e0) { quant_store_row(vd1, ad1 > 0.f ? 127.0f / ad1 : 0.f, dstd, NEXP, e1, lane); quant_store_row<true>(vu1, au1 > 0.f ? 127.0f / au1 : 0.f, dstu, NEXP, e1, lane);
        if (lane == 0) { dscale[e1] = ad1 * (1.0f / 127.0f); uscale[e1] = au1 * (1.0f / 127.0f); } }
}
__device__ __forceinline__ void quant_x2_rows4(const bf16* x2S, unsigned char* dst, float* xscale, int m, int stride, int lane) {
    f32x4 v[4][4]; int mr[4];
#pragma unroll
    for (int r = 0; r < 4; ++r) { mr[r] = m + r * stride < M ? m + r * stride : m;
#pragma unroll
        for (int jq = 0; jq < 4; ++jq) { const v2u w = *(const v2u*)(x2S + ((size_t)(4 * jq + (lane >> 4)) * M + mr[r]) * 64 + 4 * (lane & 15)); v[r][jq] = (f32x4){bflo(w.x), bfhi(w.x), bflo(w.y), bfhi(w.y)}; } }
#pragma unroll
    for (int r = 0; r < 4; ++r) { const float am = row_amax(v[r]);
        if (r == 0 || mr[r] != m) { quant_store_row(v[r], am > 0.f ? 127.0f / am : 0.f, dst, M, mr[r], lane); if (lane == 0) xscale[mr[r]] = am * (1.0f / 127.0f); } }
}
__device__ __forceinline__ float swap_add32(float a, float b) { const auto r = __builtin_amdgcn_permlane32_swap(__float_as_uint(a), __float_as_uint(b), false, false); return __uint_as_float(r[0]) + __uint_as_float(r[1]); }
__device__ __forceinline__ float swap_add16(float a, float b) { const auto r = __builtin_amdgcn_permlane16_swap(__float_as_uint(a), __float_as_uint(b), false, false); return __uint_as_float(r[0]) + __uint_as_float(r[1]); }
template <int CTRL> __device__ __forceinline__ float dpp_f(float v) { return __uint_as_float((unsigned)__builtin_amdgcn_update_dpp(0, (int)__float_as_uint(v), CTRL, 0xF, 0xF, false)); }
__device__ __forceinline__ float dpp_xor4(float v) {
    int r = __builtin_amdgcn_update_dpp(0, (int)__float_as_uint(v), 0x12C, 0xF, 0x5, false);
    r = __builtin_amdgcn_update_dpp(r, (int)__float_as_uint(v), 0x124, 0xF, 0xA, false);
    return __uint_as_float((unsigned)r);
}
__device__ __forceinline__ float bfly8_low(const float (&p)[8], int lane) {
    float q4[4], q2[2];
    { const bool u = (lane & 4) != 0;
#pragma unroll
      for (int i = 0; i < 4; ++i) { const float keep = u ? p[4 + i] : p[i], send = u ? p[i] : p[4 + i]; q4[i] = keep + dpp_xor4(send); } }
    { const bool u = (lane & 2) != 0;
#pragma unroll
      for (int i = 0; i < 2; ++i) { const float keep = u ? q4[2 + i] : q4[i], send = u ? q4[i] : q4[2 + i]; q2[i] = keep + dpp_f<0x4E>(send); } }
    { const bool u = (lane & 1) != 0; const float keep = u ? q2[1] : q2[0], send = u ? q2[0] : q2[1]; return keep + dpp_f<0xB1>(send); }
}
__device__ __forceinline__ f32x2 bfly16_high(const float (&p)[16], int lane) {
    float q8[8], q4[4];
#pragma unroll
    for (int i = 0; i < 8; ++i) q8[i] = swap_add32(p[i], p[8 + i]);
#pragma unroll
    for (int i = 0; i < 4; ++i) q4[i] = swap_add16(q8[i], q8[4 + i]);
    { const bool u = (lane & 8) != 0; f32x2 r;
      { const float keep = u ? q4[2] : q4[0], send = u ? q4[0] : q4[2]; r.x = keep + dpp_f<0x128>(send); }
      { const float keep = u ? q4[3] : q4[1], send = u ? q4[1] : q4[3]; r.y = keep + dpp_f<0x128>(send); }
      return r; }
}
#define PEER_ISSUE(dst, iwa, iwb, base) do { _Pragma("unroll") for (int i = 0; i < 16; ++i) { const unsigned wvv_ = i < 8 ? (iwa)[i >> 1] : (iwb)[(i - 8) >> 1]; \
        const unsigned e_ = (i & 1) ? (wvv_ >> 16) : (wvv_ & 0xffffu); dst[i] = *(const v4u*)((base) + (size_t)e_ * 128); } } while (0)
#define PEER_LOADIDX(da, db, k) do { const v4u* ip_ = (const v4u*)(idxp + (size_t)TOKC(k) * 128 + 16 * j); da = ip_[0]; db = ip_[1]; } while (0)
#define TOKC(k) (wv + ((k) < ntok ? (k) : ntok - 1) * nwv)
__device__ __forceinline__ void peer_down_phase(const unsigned char* xq, const unsigned char* downQ, const unsigned short* idxp, unsigned* part, int sl, int wv, int nwv, int lane) {
    const int j = lane >> 3, sub = lane & 7;
    const int ntok = wv < M ? (M - wv + nwv - 1) / nwv : 0;
    const unsigned char* xs = xq + (size_t)sl * M * 128 + 16 * sub; const unsigned char* ds = downQ + (size_t)sl * NEXP * 128 + 16 * sub;
    unsigned* ps = part + (size_t)sl * M * 64 + ((j & 1) ? 32 + 4 * sub + (j >> 1) : 4 * sub + (j >> 1));
    if (ntok == 0) return;
#define D_COMPUTE(dsrc, xvv, k) do { float p0[8], p1[8]; _Pragma("unroll") for (int i = 0; i < 8; ++i) { int s = 0, u = 0; \
        _Pragma("unroll") for (int q = 0; q < 4; ++q) { s = __builtin_amdgcn_sdot4((int)dsrc[i][q], (int)xvv[q], s, false); u = __builtin_amdgcn_sdot4((int)dsrc[8 + i][q], (int)xvv[q], u, false); } p0[i] = (float)s; p1[i] = (float)u; } \
        const float r0 = bfly8_low(p0, lane) * 0.015625f, r1 = bfly8_low(p1, lane) * 0.015625f;     \
        const float rc_ = dpp_f<0x128>((j & 1) ? r0 : r1);              \
        const pg8::f16x2 hv_ = (j & 1) ? (pg8::f16x2){(_Float16)rc_, (_Float16)r1} : (pg8::f16x2){(_Float16)r0, (_Float16)rc_}; \
        ps[(size_t)(wv + (k) * nwv) * 64] = __builtin_bit_cast(unsigned, hv_); } while (0)
    v4u dA[16], dB[16];
    v4u ia0, ib0, ia1, ib1; PEER_LOADIDX(ia0, ib0, 0); PEER_LOADIDX(ia1, ib1, 1);
    v4u xv0 = *(const v4u*)(xs + (size_t)TOKC(0) * 128), xv1 = *(const v4u*)(xs + (size_t)TOKC(1) * 128);
    PEER_ISSUE(dA, ia0, ib0, ds);
#pragma unroll 1
    for (int k = 0; k < ntok; k += 2) {
        v4u ia2, ib2; PEER_LOADIDX(ia2, ib2, k + 2); const v4u xv2 = *(const v4u*)(xs + (size_t)TOKC(k + 2) * 128);
        PEER_ISSUE(dB, ia1, ib1, ds);
        D_COMPUTE(dA, xv0, k);
        v4u ia3, ib3; PEER_LOADIDX(ia3, ib3, k + 3); const v4u xv3 = *(const v4u*)(xs + (size_t)TOKC(k + 3) * 128);
        PEER_ISSUE(dA, ia2, ib2, ds);
        if (k + 1 < ntok) D_COMPUTE(dB, xv1, k + 1);
        ia0 = ia2; ib0 = ib2; xv0 = xv2; ia1 = ia3; ib1 = ib3; xv1 = xv3;
    }
#undef D_COMPUTE
}
__device__ __forceinline__ void peer_combine_tokens4(const unsigned* part, const float* part2, const unsigned short* idxp, const float* dscale, const float* uscale, const float* xscale, const float* gate, unsigned* wpk, float* wscale, int t0, int stride, int lane) {
    int tk[4]; float pp[4], xs[4]; f32x2 s[4], gt[4]; unsigned ex[4];
#pragma unroll
    for (int r = 0; r < 4; ++r) { tk[r] = t0 + r * stride < M ? t0 + r * stride : t0; pp[r] = lane < 16 ? part2[(size_t)tk[r] * 16 + lane] : 0.f; xs[r] = xscale[tk[r]];
        const size_t o = (size_t)tk[r] * 64 + lane; { const unsigned short* ipp = idxp + (size_t)tk[r] * 128 + 32 * (lane & 3) + (lane >> 2); ex[r] = (unsigned)ipp[0] | ((unsigned)ipp[16] << 16); }
        gt[r] = *(const f32x2*)(gate + 2 * o); f32x2 a = {0.f, 0.f};
#pragma unroll
        for (int sl = 0; sl < 8; ++sl) { const pg8::f16x2 h = __builtin_bit_cast(pg8::f16x2, part[(size_t)sl * M * 64 + o]); a.x += (float)h[0]; a.y += (float)h[1]; }
        s[r] = a; }
    f32x2 ds[4], us[4];
#pragma unroll
    for (int r = 0; r < 4; ++r) { ds[r] = (f32x2){dscale[ex[r] & 0xffffu], dscale[ex[r] >> 16]}; us[r] = (f32x2){uscale[ex[r] & 0xffffu], uscale[ex[r] >> 16]}; }
#pragma unroll
    for (int r = 0; r < 4; ++r) { if (r > 0 && tk[r] == t0) continue;
        const float rx = rsqrtf(wave_sum(pp[r]) * (1.0f / 1024.0f) + EPS) * xs[r] * 64.0f;
        const float z0 = s[r].x * rx * ds[r].x, z1 = s[r].y * rx * ds[r].y;
        const float w0 = 0.5f * z0 * (1.0f + erff(z0 * 0.70710678118654752f)) * gt[r].x * us[r].x, w1 = 0.5f * z1 * (1.0f + erff(z1 * 0.70710678118654752f)) * gt[r].y * us[r].y;
        const float am = wave_max(fmaxf(fabsf(w0), fabsf(w1)));
        const float inv = am > 0.f ? 127.0f / am : 0.f;
        const int qq = ((int)rintf(w0 * inv) & 255) | (((int)rintf(w1 * inv) & 255) << 8);
        ((unsigned short*)wpk)[(size_t)tk[r] * 64 + lane] = (unsigned short)qq;
        if (lane == 0) wscale[tk[r]] = am * (1.0f / 127.0f); }
}
typedef int v2i_t __attribute__((ext_vector_type(2)));
#define U_COMPUTE(dsrc, wreg, k) do { const size_t tk_ = (size_t)(wv + (k) * nwv); const unsigned xx_ = *(const unsigned*)(xi0 + tk_ * 64); const float ws_ = wscale[tk_]; int acc0 = 0, acc1 = 0; \
        _Pragma("unroll") for (int h = 0; h < 2; ++h) { LAS unsigned char* buf_ = ubuf + h * 8192; \
            _Pragma("unroll") for (int i = 0; i < 8; ++i) *(LAS v4u*)(buf_ + i * 1024 + wr_off) = dsrc[8 * h + i]; \
            _Pragma("unroll") for (int i = 0; i < 8; ++i) { const int wlo_ = __builtin_amdgcn_readlane((int)(wreg), 2 * (8 * h + i)), whi_ = __builtin_amdgcn_readlane((int)(wreg), 2 * (8 * h + i) + 1); \
                const v2i_t t0_ = __builtin_amdgcn_ds_read_tr8_b64_v2i32((LAS v2i_t*)(buf_ + i * 1024 + rd_off0)), t1_ = __builtin_amdgcn_ds_read_tr8_b64_v2i32((LAS v2i_t*)(buf_ + i * 1024 + rd_off1)); \
                acc0 = __builtin_amdgcn_sdot4(t0_.x, wlo_, acc0, false); acc0 = __builtin_amdgcn_sdot4(t0_.y, whi_, acc0, false); \
                acc1 = __builtin_amdgcn_sdot4(t1_.x, wlo_, acc1, false); acc1 = __builtin_amdgcn_sdot4(t1_.y, whi_, acc1, false); } } \
        *(unsigned*)(xo0 + tk_ * 64) = pk2(__uint_as_float(xx_ << 16) + (float)acc0 * ws_, __uint_as_float(xx_ & 0xffff0000u) + (float)acc1 * ws_); } while (0)
#define U_LOADW(dst, k) do { dst = wpk[(size_t)TOKC(k) * 32 + (lane & 31)]; } while (0)
__device__ __forceinline__ void peer_up_phase(bf16* x2S, bf16* x3S, const unsigned char* upQ, const unsigned short* idxp, const unsigned* wpk, const float* wscale, int sl, int wv, int nwv, int lane, LAS unsigned char* ubuf) {
    const int j = lane >> 3, sub = lane & 7;
    const int ntok = wv < M ? (M - wv + nwv - 1) / nwv : 0;
    const unsigned char* us = upQ + (size_t)sl * NEXP * 128 + 16 * sub;
    const bf16* xi0 = x2S + (size_t)(2 * sl + (lane >> 5)) * M * 64 + 2 * (lane & 31);
    bf16* xo0 = x3S + (size_t)(2 * sl + (lane >> 5)) * M * 64 + 2 * (lane & 31);
    const int wr_off = j * 128 + ((sub ^ (j >> 1)) * 16);
    const int g_ = lane >> 4, p_ = lane & 15, r_ = p_ >> 1;
    const int rd_off0 = r_ * 128 + (((g_) ^ (r_ >> 1)) * 16) + 8 * (p_ & 1);
    const int rd_off1 = r_ * 128 + (((4 + g_) ^ (r_ >> 1)) * 16) + 8 * (p_ & 1);
    if (ntok == 0) return;
    v4u dA[16], dB[16];
    v4u ia0, ib0, ia1, ib1; PEER_LOADIDX(ia0, ib0, 0); PEER_LOADIDX(ia1, ib1, 1);
    unsigned wq0, wq1; U_LOADW(wq0, 0); U_LOADW(wq1, 1);
    PEER_ISSUE(dA, ia0, ib0, us);
#pragma unroll 1
    for (int k = 0; k < ntok; k += 2) {
        v4u ia2, ib2; PEER_LOADIDX(ia2, ib2, k + 2); unsigned wq2; U_LOADW(wq2, k + 2);
        PEER_ISSUE(dB, ia1, ib1, us);
        U_COMPUTE(dA, wq0, k);
        v4u ia3, ib3; PEER_LOADIDX(ia3, ib3, k + 3); unsigned wq3; U_LOADW(wq3, k + 3);
        PEER_ISSUE(dA, ia2, ib2, us);
        if (k + 1 < ntok) U_COMPUTE(dB, wq1, k + 1);
        ia0 = ia2; ib0 = ib2; ia1 = ia3; ib1 = ib3; wq0 = wq2; wq1 = wq3;
    }
}
#undef U_COMPUTE
#undef U_LOADW
#undef TOKC
#undef PEER_ISSUE
#undef PEER_LOADIDX
__device__ __forceinline__ void final_norm_tokens(const bf16* x3S, float* out, const float* fin_w, int t0, int t1, int lane) {
    v2u xa[4], xb[4]; float sa = 0.f, sb = 0.f;
#pragma unroll
    for (int jq = 0; jq < 4; ++jq) { const size_t o = (size_t)(4 * jq + (lane >> 4)) * M * 64 + 4 * (lane & 15); xa[jq] = *(const v2u*)(x3S + o + (size_t)t0 * 64); xb[jq] = *(const v2u*)(x3S + o + (size_t)t1 * 64); }
#pragma unroll
    for (int jq = 0; jq < 4; ++jq) { sa += (bflo(xa[jq].x) * bflo(xa[jq].x) + bfhi(xa[jq].x) * bfhi(xa[jq].x)) + (bflo(xa[jq].y) * bflo(xa[jq].y) + bfhi(xa[jq].y) * bfhi(xa[jq].y));
        sb += (bflo(xb[jq].x) * bflo(xb[jq].x) + bfhi(xb[jq].x) * bfhi(xb[jq].x)) + (bflo(xb[jq].y) * bflo(xb[jq].y) + bfhi(xb[jq].y) * bfhi(xb[jq].y)); }
    sa = wave_sum(sa); sb = wave_sum(sb);
    const float ra = rsqrtf(sa * (1.0f / 1024.0f) + EPS), rb = rsqrtf(sb * (1.0f / 1024.0f) + EPS);
    f32x4* oa = (f32x4*)(out + (size_t)t0 * 1024) + lane; f32x4* ob = (f32x4*)(out + (size_t)t1 * 1024) + lane; const f32x4* wr = (const f32x4*)fin_w + lane;
#pragma unroll
    for (int jq = 0; jq < 4; ++jq) { const f32x4 w = wr[64 * jq];
        oa[64 * jq] = (f32x4){bflo(xa[jq].x) * ra * w.x, bfhi(xa[jq].x) * ra * w.y, bflo(xa[jq].y) * ra * w.z, bfhi(xa[jq].y) * ra * w.w};
        if (t1 != t0) ob[64 * jq] = (f32x4){bflo(xb[jq].x) * rb * w.x, bfhi(xb[jq].x) * rb * w.y, bflo(xb[jq].y) * rb * w.z, bfhi(xb[jq].y) * rb * w.w}; }
}

#define XB_TMO      128
#define XB_XCNT(j)  (256  + 64 * (j))
#define XB_XSUB(j)  (1280 + 64 * (j))
#define XB_XGEN(j)  (2304 + 64 * (j))
#define XB_TOP      3328
#define XB_TOPGEN   3392
#define XCD_BAR_WORDS 3456
#define XB_SPIN_CAP (1u << 22)
__device__ __forceinline__ unsigned xb_ld(unsigned* p)              { return __hip_atomic_load(p, __ATOMIC_RELAXED, __HIP_MEMORY_SCOPE_AGENT); }
__device__ __forceinline__ unsigned xb_add(unsigned* p, unsigned v) { return __hip_atomic_fetch_add(p, v, __ATOMIC_RELAXED, __HIP_MEMORY_SCOPE_AGENT); }
__device__ __forceinline__ unsigned xb_xcc_id() { return (unsigned)__builtin_amdgcn_s_getreg((3 << 11) | 20) & 0xFu; }
#define XB_SPIN(cond, bar) do { unsigned _sp = 0; while (cond) { __builtin_amdgcn_s_sleep(1); \
    if ((++_sp & 255u) == 0u) { if (xb_ld(&(bar)[XB_TMO])) break; if (_sp > XB_SPIN_CAP) { atomicAdd(&(bar)[XB_TMO], 1u); break; } } } } while (0)
__device__ __forceinline__ unsigned xcd_barrier_post(unsigned* bar, volatile LAS unsigned* st) {
    const unsigned x = xb_xcc_id();
    if (threadIdx.x == 0) { st[2] = xb_add(&bar[XB_XCNT(x)], 1u); st[3] = x; }
    return x;
}
__device__ __forceinline__ void xcd_barrier_complete(unsigned* bar, unsigned x, unsigned& nloc, unsigned& nx) {
    const unsigned G = gridDim.x * gridDim.y * gridDim.z;
    unsigned sum, cnt, mine, sp = 0u;
    for (;;) {
        sum = 0u; cnt = 0u; mine = 0u;
#pragma unroll
        for (unsigned jx = 0; jx < 16; ++jx) { const unsigned c = xb_ld(&bar[XB_XCNT(jx)]); sum += c; cnt += (c > 0u) ? 1u : 0u; mine = (jx == x) ? c : mine; }
        if (sum == G) break;
        __builtin_amdgcn_s_sleep(1);
        if ((++sp & 255u) == 0u) { if (xb_ld(&bar[XB_TMO])) break; if (sp > XB_SPIN_CAP) { atomicAdd(&bar[XB_TMO], 1u); break; } }
    }
    nloc = mine > 0u ? mine : 1u; nx = cnt > 0u ? cnt : 1u;
}
__device__ __forceinline__ void xcd_barrier(unsigned* bar, unsigned x, volatile LAS unsigned* st) {
    asm volatile("s_waitcnt vmcnt(0)" ::: "memory");
    __syncthreads();
    if (threadIdx.x == 0) {
        __builtin_amdgcn_s_waitcnt(0);
        unsigned nloc = st[0], nx = st[1];
        if (nloc == 0u) { xcd_barrier_complete(bar, x, nloc, nx); st[0] = nloc; st[1] = nx; }
        const unsigned old = xb_add(&bar[XB_XSUB(x)], 1u);
        const unsigned gen = old / nloc;
        if (old + 1u == (gen + 1u) * nloc) {
            __builtin_amdgcn_fence(__ATOMIC_RELEASE, "agent");
            asm volatile("s_waitcnt vmcnt(0)" ::: "memory");
            const unsigned og = xb_add(&bar[XB_TOP], 1u);
            const unsigned tg = og / nx;
            if (og + 1u == (tg + 1u) * nx) xb_add(&bar[XB_TOPGEN], 1u);
            else XB_SPIN(xb_ld(&bar[XB_TOPGEN]) == tg, bar);
            __builtin_amdgcn_fence(__ATOMIC_ACQUIRE, "agent");
            xb_add(&bar[XB_XGEN(x)], 1u);
            asm volatile("s_waitcnt vmcnt(0)" ::: "memory");
        } else {
            XB_SPIN(xb_ld(&bar[XB_XGEN(x)]) == gen, bar);
            __builtin_amdgcn_fence(__ATOMIC_ACQUIRE, "agent");
            asm volatile("s_waitcnt vmcnt(0)" ::: "memory");
        }
    }
    __syncthreads();
}

struct Args { const float* in[20]; float* out; unsigned char* ws; int ph_lo, ph_hi; };
constexpr int N_PHASES = 16;
constexpr int LDS_MISC = RING_BYTES + 4096;
#define REPS(k) for (int rep_ = 0; rep_ < (((PROBE_MASK >> (k)) & 1) ? PROBE_REP : 1); ++rep_)

__global__ void __launch_bounds__(NT, 2) fwd(Args args) {
    extern __shared__ __attribute__((aligned(16))) unsigned char lds_raw[];
    LAS unsigned char* lds = (LAS unsigned char*)lds_raw;
    const int G = gridDim.x, bx = blockIdx.x;
    const int vcu = (G % 8 == 0) ? (bx % 8) * (G / 8) + bx / 8 : bx;
    const int NGW = G * NWAVES;
    unsigned char* ws = args.ws;
    const int lo = args.ph_lo, hi = args.ph_hi;
    volatile LAS unsigned* bst = (volatile LAS unsigned*)(lds + LDS_MISC);
#if MK_N_LAUNCHES == 1
    cg::grid_group grid = cg::this_grid();
    unsigned* const barw = (unsigned*)(ws + WS_CTL);
    if (threadIdx.x < 8) bst[threadIdx.x] = 0u;
    __syncthreads();
    const unsigned bxcc = xcd_barrier_post(barw, bst);
#define SEAM(k) do { if (lo <= (k) && (k) + 1 < hi) { if (hi > 1000) grid.sync(); else REPS(15) xcd_barrier(barw, bxcc, bst); } } while (0)
#else
#define SEAM(k) do { } while (0)
#endif
#ifndef PH_MASK
#define PH_MASK 0xFFFFF
#endif
#define IN(k) (((PH_MASK >> (k)) & 1) && lo <= (k) && (k) < hi)
#define PH_IDS int tid = threadIdx.x; asm volatile("" : "+v"(tid)); const int lane = tid & 63; const int wave = __builtin_amdgcn_readfirstlane(tid >> 6); const int gw = vcu * NWAVES + wave; (void)lane; (void)gw;
#if MK_N_LAUNCHES == 1
#define PEER_GROUP int grp, mem, nmem; { const unsigned nl_ = bst[0], nx_ = bst[1]; if (nx_ == 8u && nl_ > 0u) { grp = (int)bst[3]; mem = (int)bst[2]; nmem = (int)nl_; } else { grp = bx & 7; mem = bx >> 3; nmem = G >> 3; } } \
    grp = __builtin_amdgcn_readfirstlane(grp); mem = __builtin_amdgcn_readfirstlane(mem); nmem = __builtin_amdgcn_readfirstlane(nmem);
#else
#define PEER_GROUP const int grp = bx & 7, mem = bx >> 3, nmem = G >> 3;
#endif
#define ABUF ((bf16*)(ws + WS_A))
#define PROJ ((bf16*)(ws + WS_PROJ))
#define UST ((bf16*)(ws + WS_US))
#define DECAY ((float*)(ws + WS_DECAY))

    if (IN(0)) REPS(0) { PH_IDS p0_prologue(args.in, ws, lds, vcu, G, tid, rep_ == 0 ? 7 : PROBE_SUB); }
    SEAM(0);
    if (IN(1)) {
        { pg8::Gemm g{ABUF, (const bf16*)(ws + WS_WIN), M, IN_COLS, 512}; pg8::StaticOrder S; S.init(M, IN_COLS, G, bx, ((PROBE_MASK >> 1) & 1) ? PROBE_REP : 1);
          pg8::EpiBf16I8 E{PROJ, IN_COLS, (const float*)(ws + WS_PART1), (const float*)(ws + WS_WIN + 4 * MiB)};
          pg8::gemm_phase_i8<pg8::EpiBf16I8, pg8::StaticOrder, PG8_ALIGN, PG8_SP2>(lds, g, S, E); }
        { pg8::Gemm g{(const bf16*)(ws + WS_MEMN), (const bf16*)(ws + WS_WKV), MROWS, 1024, 1024}; pg8::StaticOrder S; S.init(MROWS, 1024, G, bx); pg8::EpiTile E{(bf16*)(ws + WS_KB), 4, 1};
          pg8::gemm_phase<pg8::EpiTile, pg8::StaticOrder, PG8_ALIGN, PG8_SP2>(lds, g, S, E); }
        { pg8::Gemm g{(const bf16*)(ws + WS_WKV) + (size_t)1024 * 1024, (const bf16*)(ws + WS_MEMN), 1024, MROWS, 1024}; pg8::StaticOrder S; S.init(1024, MROWS, G, (bx + 128) % G); pg8::EpiTile E{(bf16*)(ws + WS_VT), 1, 4};
          pg8::gemm_phase<pg8::EpiTile, pg8::StaticOrder, PG8_ALIGN, PG8_SP2>(lds, g, S, E); }
    }
    SEAM(1);
    if (IN(2)) REPS(2) { PH_IDS
        for (int m = 4 * gw; m < M; m += 4 * NGW) conv_tokens4(PROJ, args.in[4], args.in[5], ABUF, m, lane);
        for (int u = vcu; u < BATCH * 128; u += G) h1_unit(u >> 7, u & 127, PROJ, args.in[6], UST, DECAY, lds, tid);
    }
    SEAM(2);
    if (IN(3)) REPS(3) { PH_IDS const bool dry = rep_ + 1 < ((((PROBE_MASK >> 3) & 1) ? PROBE_REP : 1)); h2_scan(UST, DECAY, gw, NGW, lane, dry ? (long)((WS_X + 288 * MiB - WS_US) / 4) : 0L); }
    SEAM(3);
    if (IN(4)) REPS(4) { PH_IDS for (int u = vcu; u < BATCH * 128 * 4; u += G) h3_unit(u >> 9, (u >> 2) & 127, u & 3, PROJ, args.in[6], UST, args.in[7], ABUF, lds, tid); }
    SEAM(4);
    if (IN(5)) {
        pg8::Gemm g{ABUF, (const bf16*)(ws + WS_WOUT), M, 1024, 1024}; pg8::StaticOrder S; S.init(M, 1024, G, bx, ((PROBE_MASK >> 5) & 1) ? PROBE_REP : 1);
        pg8::EpiResid E{args.in[0], nullptr, (bf16*)(ws + WS_B1), (float*)(ws + WS_PART1), 0};
        pg8::gemm_phase<pg8::EpiResid, pg8::StaticOrder, PG8_ALIGN, PG8_SP2>(lds, g, S, E);
    }
    SEAM(5);
    if (IN(6)) {
        pg8::Gemm g{(const bf16*)(ws + WS_B1), (const bf16*)(ws + WS_WQ), M, 1024, 1024}; pg8::StaticOrder S; S.init(M, 1024, G, bx, ((PROBE_MASK >> 6) & 1) ? PROBE_REP : 1);
        pg8::EpiScaleBf16 E{(bf16*)(ws + WS_Q), 1024, (const float*)(ws + WS_PART1), QSCALE};
        pg8::gemm_phase<pg8::EpiScaleBf16, pg8::StaticOrder, PG8_ALIGN, PG8_SP2>(lds, g, S, E);
    }
    SEAM(6);
    if (IN(7)) REPS(7) { PH_IDS for (int u = vcu; u < 1024; u += G) attn_unit(u >> 8, (u >> 6) & 3, u & 63, (const bf16*)(ws + WS_Q), (const bf16*)(ws + WS_KB), (const bf16*)(ws + WS_VT), ABUF, lds, tid); }
    SEAM(7);
    if (IN(8)) {
        pg8::Gemm g{ABUF, (const bf16*)(ws + WS_WO), M, 1024, 1024}; pg8::StaticOrder S; S.init(M, 1024, G, bx, ((PROBE_MASK >> 8) & 1) ? PROBE_REP : 1);
        pg8::EpiResid E{nullptr, (const bf16*)(ws + WS_B1), (bf16*)(ws + WS_X2S), (float*)(ws + WS_PART2), M};
        pg8::gemm_phase<pg8::EpiResid, pg8::StaticOrder, PG8_ALIGN, PG8_SP2>(lds, g, S, E);
    }
    SEAM(8);
    if (IN(9)) REPS(9) { PH_IDS
        const int sel = rep_ == 0 ? 7 : PROBE_SUB;
        if (sel & 4) for (int m = gw; m < M; m += 4 * NGW) quant_x2_rows4((const bf16*)(ws + WS_X2S), ws + WS_XQ, (float*)(ws + WS_XSCALE), m, NGW, lane);
        if (sel & 2) for (int e = gw; e < NEXP; e += 2 * NGW) {
            const int e2 = e + NGW < NEXP ? e + NGW : e;
            quant_rows4(args.in[17], args.in[18], args.in[14], ws + WS_PDOWN, ws + WS_PUP, e, e2, lane, (float*)(ws + WS_DSCALE), (float*)(ws + WS_USCALE)); }
    }
    SEAM(9);
    if (IN(10)) {
        pg8::Gemm g{(const bf16*)(ws + WS_XQ), (const bf16*)(ws + WS_WEFF), M, 2048, 512, 64}; pg8::StaticOrder S; S.init(M, 2048, G, bx, ((PROBE_MASK >> 10) & 1) ? PROBE_REP : 1);
        pg8::EpiScoresI8 E{(unsigned short*)(ws + WS_SCT), M, (const float*)(ws + WS_PART2), (const float*)(ws + WS_XSCALE), (const float*)(ws + WS_WEFF + 2 * MiB)};
        pg8::gemm_phase_i8<pg8::EpiScoresI8, pg8::StaticOrder, PG8_ALIGN, PG8_SP2>(lds, g, S, E);
    }
    SEAM(10);
    if (IN(11)) REPS(11) { PH_IDS
        for (int task = gw; task < 8 * (M / 64); task += NGW) { const int head = task & 7, token = (task >> 3) * 64 + lane;
            peer_topk_task((const unsigned short*)(ws + WS_SCT), head, token, (unsigned short*)(ws + WS_IDX), (float*)(ws + WS_GATE), lds + tid * 32); }
    }
    SEAM(11);
    if (IN(12)) REPS(12) { PH_IDS PEER_GROUP
        peer_down_phase(ws + WS_XQ, ws + WS_PDOWN, (const unsigned short*)(ws + WS_IDX), (unsigned*)(ws + WS_SCT), grp, mem * NWAVES + wave, nmem * NWAVES, lane);
    }
    SEAM(12);
    if (IN(13)) REPS(13) { PH_IDS
        for (int t = gw; t < M; t += 4 * NGW) peer_combine_tokens4((const unsigned*)(ws + WS_SCT), (const float*)(ws + WS_PART2), (const unsigned short*)(ws + WS_IDX), (const float*)(ws + WS_DSCALE), (const float*)(ws + WS_USCALE),
                                                                          (const float*)(ws + WS_XSCALE), (const float*)(ws + WS_GATE), (unsigned*)(ws + WS_WPK), (float*)(ws + WS_CORR), t, NGW, lane); }
    SEAM(13);
    if (IN(14)) REPS(14) { PH_IDS PEER_GROUP
        const bool dry = rep_ + 1 < ((((PROBE_MASK >> 14) & 1) ? PROBE_REP : 1));
        peer_up_phase((bf16*)(ws + WS_X2S), (bf16*)(ws + (dry ? WS_PROBE_DUMMY : WS_X2S)), ws + WS_PUP, (const unsigned short*)(ws + WS_IDX), (const unsigned*)(ws + WS_WPK), (const float*)(ws + WS_CORR), grp, mem * NWAVES + wave, nmem * NWAVES, lane, lds + wave * 16384); }
    SEAM(14);
    if (IN(15)) REPS(15) { PH_IDS for (int t = gw; t < M; t += 2 * NGW) final_norm_tokens((const bf16*)(ws + WS_X2S), args.out, args.in[19], t, t + NGW < M ? t + NGW : t, lane); }
#undef IN
#undef SEAM
}

extern "C" void kernel_launch(void* const* d_in, const int* in_sizes, int n_in, void* d_out, int out_size, void* d_ws, size_t ws_size, hipStream_t stream) {
    static int grid = 0;
    if (grid == 0) {
        if (n_in != 20 || in_sizes[0] != M * D || out_size != M * D || ws_size < WS_END) { fprintf(stderr, "kernel_launch: unexpected shapes: n_in %d in0 %d out %d ws %zu (need %zu)\n", n_in, n_in > 0 ? in_sizes[0] : -1, out_size, ws_size, (size_t)WS_END); grid = -1; return; }
        int dev = 0, cus = 0, per_cu = 0;
        if (hipGetDevice(&dev) != hipSuccess || hipDeviceGetAttribute(&cus, hipDeviceAttributeMultiprocessorCount, dev) != hipSuccess) { grid = -1; return; }
        if (hipFuncSetAttribute((const void*)fwd, hipFuncAttributeMaxDynamicSharedMemorySize, LDS_BYTES) != hipSuccess) { fprintf(stderr, "kernel_launch: hipFuncSetAttribute failed\n"); grid = -1; return; }
        if (hipOccupancyMaxActiveBlocksPerMultiprocessor(&per_cu, (const void*)fwd, NT, LDS_BYTES) != hipSuccess || per_cu < 1) { fprintf(stderr, "kernel_launch: occupancy query says %d blocks per CU\n", per_cu); (void)hipGetLastError(); grid = -1; return; }
        grid = cus;
    }
    if (grid < 0) return;
    Args a{};
    for (int i = 0; i < 20; ++i) a.in[i] = (const float*)d_in[i];
    a.out = (float*)d_out; a.ws = (unsigned char*)d_ws;
#if MK_N_LAUNCHES == 1
    if (hipMemsetAsync((char*)d_ws + WS_CTL, 0, CTL_ZERO_BYTES, stream) != hipSuccess) { fprintf(stderr, "kernel_launch: hipMemsetAsync failed\n"); return; }
    a.ph_lo = 0; a.ph_hi = N_PHASES;
    void* kargs[] = {&a};
    hipError_t e = hipLaunchCooperativeKernel((const void*)fwd, dim3(grid), dim3(NT), kargs, LDS_BYTES, stream);
    if (e != hipSuccess) fprintf(stderr, "kernel_launch: cooperative launch failed: %s (grid %d)\n", hipGetErrorString(e), grid);
#else
    for (int ph = 0; ph < N_PHASES; ++ph) { a.ph_lo = ph; a.ph_hi = ph + 1; hipLaunchKernelGGL(fwd, dim3(grid), dim3(NT), LDS_BYTES, stream, a); }
#endif
}
```

```cpp
#include <hip/hip_runtime.h>
#include <hip/hip_cooperative_groups.h>
#include <cstdio>
#include <cstdint>
namespace cg = cooperative_groups;

#ifndef MK_N_LAUNCHES
#define MK_N_LAUNCHES 1
#endif

#ifndef PROBE_REP
#define PROBE_REP 1
#endif
#ifndef PROBE_MASK
#define PROBE_MASK 0
#endif

#ifndef PROBE_T_MUL
#define PROBE_T_MUL 1
#endif
#ifndef PROBE_SUB
#define PROBE_SUB 7
#endif

namespace pg8 {
#define PG8_LAS __attribute__((address_space(3)))
typedef unsigned short bf16_t;
typedef short bf16x8 __attribute__((ext_vector_type(8)));
typedef float f32x4 __attribute__((ext_vector_type(4)));
typedef unsigned u32x4 __attribute__((ext_vector_type(4)));
constexpr int BM = 256, BK = 64, HALF = 128, HTB = HALF * BK * 2  , STAGE_BYTES = 8 * HTB, NXCD = 8, WGM = 8;

__host__ __device__ __forceinline__ int lds_byte(int r, int c) { const int st = (r >> 4) * 2 + (c >> 5), rr = r & 15, cc = c & 31, ob = rr * 64 + cc * 2; return st * 1024 + (ob ^ (((ob >> 9) & 1) << 5)); }
__host__ __device__ __forceinline__ void stage_rc(int b, int& R, int& C) { const int st = b / 1024, sb = b % 1024, swz = sb ^ (((sb >> 9) & 1) << 5); R = (st >> 1) * 16 + swz / 64; C = (st & 1) * 32 + (swz % 64) / 2; }
__host__ __device__ __forceinline__ int perm32(int rho) { const int n = rho >> 4, i = rho & 15; return 8 * (i >> 2) + 4 * n + (i & 3); }

struct Unit { int pm, pn; };
struct Gemm { const bf16_t* A; const bf16_t* Bt; int M, N, K; int lda; };

struct StaticOrder {
    int nM, nN, nwg, G, c, rep;
    __host__ __device__ void init(int M, int N, int G_, int c_, int rep_ = 1) { nM = M / BM; nN = N / BM; nwg = nM * nN; G = G_; c = c_; rep = rep_; }
    __host__ __device__ bool next(int i, Unit& u) const {
        long L = (long)i * G + c; if (L >= (long)nwg * rep) return false; L %= nwg;
        int wgid = (int)L; { const int q = nwg / NXCD, r = nwg % NXCD, xcd = wgid % NXCD, off = wgid / NXCD; wgid = (xcd < r ? xcd * (q + 1) : r * (q + 1) + (xcd - r) * q) + off; }
        const int nig = WGM * nN, gid = wgid / nig, fm = gid * WGM, gsz = (nM - fm) < WGM ? (nM - fm) : WGM;
        u.pm = fm + ((wgid % nig) % gsz); u.pn = (wgid % nig) / gsz; return true;
    }
    __device__ __forceinline__ void a_ready(const Unit&) const {}
    __device__ __forceinline__ void done(const Unit&) const {}
};


__device__ __forceinline__ float sum_x16_x32(float v) {
    { const auto r = __builtin_amdgcn_permlane16_swap(__float_as_uint(v), __float_as_uint(v), false, false); v = __uint_as_float(r[0]) + __uint_as_float(r[1]); }
    { const auto r = __builtin_amdgcn_permlane32_swap(__float_as_uint(v), __float_as_uint(v), false, false); v = __uint_as_float(r[0]) + __uint_as_float(r[1]); }
    return v;
}
__device__ __forceinline__ unsigned cvt_pk_bf16(float lo, float hi) { unsigned r; asm volatile("v_cvt_pk_bf16_f32 %0, %1, %2" : "=v"(r) : "v"(lo), "v"(hi)); return r; }

struct EpiBf16 {
    static constexpr bool PERM = true, AFTER_DRAIN = false;
    bf16_t* O; int ldc;
    __device__ __forceinline__ void operator()(const f32x4 (&acc)[2][2][4][2], const Unit& u, int wr, int wc, int fr, int fq) const {
        const int row0 = u.pm * BM + wr * 64 + fr, col0 = u.pn * BM + wc * 32 + 8 * fq;
#pragma unroll
        for (int ai = 0; ai < 2; ++ai)
#pragma unroll
            for (int m = 0; m < 4; ++m) { bf16_t* rowp = O + (size_t)(row0 + ai * HALF + m * 16) * ldc + col0;
#pragma unroll
                for (int bj = 0; bj < 2; ++bj) { const f32x4 v0 = acc[ai][bj][m][0], v1 = acc[ai][bj][m][1];
                    u32x4 w; w.x = cvt_pk_bf16(v0[0], v0[1]); w.y = cvt_pk_bf16(v0[2], v0[3]); w.z = cvt_pk_bf16(v1[0], v1[1]); w.w = cvt_pk_bf16(v1[2], v1[3]);
                    *(u32x4*)(rowp + bj * HALF) = w; } }
    }
};
struct EpiTile {
    static constexpr bool PERM = true, AFTER_DRAIN = false;
    bf16_t* O; int sm, sn;
    __device__ __forceinline__ void operator()(const f32x4 (&acc)[2][2][4][2], const Unit& u, int wr, int wc, int fr, int fq) const {
        bf16_t* base = O + (size_t)(u.pm * sm + u.pn * sn) * 65536 + (size_t)(wr * 64 + fr) * 256 + wc * 32 + 8 * fq;
#pragma unroll
        for (int ai = 0; ai < 2; ++ai)
#pragma unroll
            for (int m = 0; m < 4; ++m) { bf16_t* rowp = base + (size_t)(ai * HALF + m * 16) * 256;
#pragma unroll
                for (int bj = 0; bj < 2; ++bj) { const f32x4 v0 = acc[ai][bj][m][0], v1 = acc[ai][bj][m][1];
                    u32x4 w; w.x = cvt_pk_bf16(v0[0], v0[1]); w.y = cvt_pk_bf16(v0[2], v0[3]); w.z = cvt_pk_bf16(v1[0], v1[1]); w.w = cvt_pk_bf16(v1[2], v1[3]);
                    *(u32x4*)(rowp + bj * HALF) = w; } }
    }
};
struct EpiResid {
    static constexpr bool PERM = true, AFTER_DRAIN = false;
    const float* basef; const bf16_t* baseb; bf16_t* xb; float* part; int sliced;
    __device__ __forceinline__ void operator()(const f32x4 (&acc)[2][2][4][2], const Unit& u, int wr, int wc, int fr, int fq) const {
        const int row0 = u.pm * BM + wr * 64 + fr, col0 = u.pn * BM + wc * 32 + 8 * fq;
#pragma unroll
        for (int ai = 0; ai < 2; ++ai)
#pragma unroll
            for (int m = 0; m < 4; ++m) { const int row = row0 + ai * HALF + m * 16; const size_t off = (size_t)row * 1024 + col0; float s = 0.f;
#pragma unroll
                for (int bj = 0; bj < 2; ++bj) {
                    f32x4 b0, b1;
                    if (basef) { b0 = *(const f32x4*)(basef + off + bj * HALF); b1 = *(const f32x4*)(basef + off + bj * HALF + 4); }
                    else { const u32x4 bw = *(const u32x4*)(baseb + off + bj * HALF);
                        b0 = (f32x4){__uint_as_float(bw.x << 16), __uint_as_float(bw.x & 0xffff0000u), __uint_as_float(bw.y << 16), __uint_as_float(bw.y & 0xffff0000u)};
                        b1 = (f32x4){__uint_as_float(bw.z << 16), __uint_as_float(bw.z & 0xffff0000u), __uint_as_float(bw.w << 16), __uint_as_float(bw.w & 0xffff0000u)}; }
                    const f32x4 v0 = acc[ai][bj][m][0] + b0, v1 = acc[ai][bj][m][1] + b1;
                    u32x4 w; w.x = cvt_pk_bf16(v0[0], v0[1]); w.y = cvt_pk_bf16(v0[2], v0[3]); w.z = cvt_pk_bf16(v1[0], v1[1]); w.w = cvt_pk_bf16(v1[2], v1[3]);
                    if (sliced) { const int col = col0 + bj * HALF; *(u32x4*)(xb + ((size_t)(col >> 6) * sliced + row) * 64 + (col & 63)) = w; }
                    else *(u32x4*)(xb + off + bj * HALF) = w;
                    s += (v0[0] * v0[0] + v0[1] * v0[1]) + (v0[2] * v0[2] + v0[3] * v0[3]) + (v1[0] * v1[0] + v1[1] * v1[1]) + (v1[2] * v1[2] + v1[3] * v1[3]); }
                s = sum_x16_x32(s);
                if (fq == 0) part[(size_t)row * 16 + u.pn * 4 + wc] = s; }
    }
};
__device__ __forceinline__ float row_rstd(const float* part, int row, int fq) {
    const f32x4 p = *(const f32x4*)(part + (size_t)row * 16 + 4 * fq); float t = (p[0] + p[1]) + (p[2] + p[3]);
    t = sum_x16_x32(t);
    return rsqrtf(t * (1.0f / 1024.0f) + 1e-6f);
}
struct EpiScaleBf16 {
    static constexpr bool PERM = true, AFTER_DRAIN = false;
    bf16_t* O; int ldc; const float* part; float scale;
    __device__ __forceinline__ void operator()(const f32x4 (&acc)[2][2][4][2], const Unit& u, int wr, int wc, int fr, int fq) const {
        const int row0 = u.pm * BM + wr * 64 + fr, col0 = u.pn * BM + wc * 32 + 8 * fq;
#pragma unroll
        for (int ai = 0; ai < 2; ++ai)
#pragma unroll
            for (int m = 0; m < 4; ++m) { const int row = row0 + ai * HALF + m * 16; const float sc = row_rstd(part, row, fq) * scale; bf16_t* rowp = O + (size_t)row * ldc + col0;
#pragma unroll
                for (int bj = 0; bj < 2; ++bj) { const f32x4 v0 = acc[ai][bj][m][0] * sc, v1 = acc[ai][bj][m][1] * sc;
                    u32x4 w; w.x = cvt_pk_bf16(v0[0], v0[1]); w.y = cvt_pk_bf16(v0[2], v0[3]); w.z = cvt_pk_bf16(v1[0], v1[1]); w.w = cvt_pk_bf16(v1[2], v1[3]);
                    *(u32x4*)(rowp + bj * HALF) = w; } }
    }
};
typedef int i32x4e __attribute__((ext_vector_type(4)));
typedef _Float16 f16x4 __attribute__((ext_vector_type(4)));
typedef _Float16 f16x2 __attribute__((ext_vector_type(2)));
struct EpiScoresT {
    static constexpr bool PERM = false, AFTER_DRAIN = false;
    unsigned short* scT; int Mtok; const float* part;
    __device__ __forceinline__ void operator()(const f32x4 (&acc)[2][2][4][2], const Unit& u, int wr, int wc, int fr, int fq) const {
        const int row0 = u.pm * BM + wr * 64 + fr;
#pragma unroll
        for (int ai = 0; ai < 2; ++ai)
#pragma unroll
            for (int m = 0; m < 4; ++m) { const int row = row0 + ai * HALF + m * 16; const float sc = row_rstd(part, row, fq);
#pragma unroll
                for (int bj = 0; bj < 2; ++bj)
#pragma unroll
                    for (int n = 0; n < 2; ++n) { const int hp = 2 * u.pn + bj, kq = 8 * wc + 4 * n + fq; const f32x4 v = acc[ai][bj][m][n] * sc;
                        *(f16x4*)(scT + ((size_t)(hp * 32 + kq) * Mtok + row) * 4) = (f16x4){(_Float16)v[0], (_Float16)v[1], (_Float16)v[2], (_Float16)v[3]}; } }
    }
};
struct EpiBf16I8 {
    static constexpr bool PERM = true, AFTER_DRAIN = false;
    bf16_t* O; int ldc; const float* rowscale; const float* colscale;
    __device__ __forceinline__ void operator()(const i32x4e (&acc)[2][2][4][2], const Unit& u, int wr, int wc, int fr, int fq) const {
        const int row0 = u.pm * BM + wr * 64 + fr, col0 = u.pn * BM + wc * 32 + 8 * fq;
        f32x4 cs[2][2];
#pragma unroll
        for (int bj = 0; bj < 2; ++bj) { cs[bj][0] = *(const f32x4*)(colscale + col0 + bj * HALF); cs[bj][1] = *(const f32x4*)(colscale + col0 + bj * HALF + 4); }
        float rs[2][4];
#pragma unroll
        for (int ai = 0; ai < 2; ++ai)
#pragma unroll
            for (int m = 0; m < 4; ++m) rs[ai][m] = rowscale[row0 + ai * HALF + m * 16];
#pragma unroll
        for (int ai = 0; ai < 2; ++ai)
#pragma unroll
            for (int m = 0; m < 4; ++m) { bf16_t* rowp = O + (size_t)(row0 + ai * HALF + m * 16) * ldc + col0; const float r_ = rs[ai][m];
#pragma unroll
                for (int bj = 0; bj < 2; ++bj) { const i32x4e a0 = acc[ai][bj][m][0], a1 = acc[ai][bj][m][1]; const f32x4 c0 = cs[bj][0] * r_, c1 = cs[bj][1] * r_;
                    u32x4 w; w.x = cvt_pk_bf16((float)a0[0] * c0[0], (float)a0[1] * c0[1]); w.y = cvt_pk_bf16((float)a0[2] * c0[2], (float)a0[3] * c0[3]);
                    w.z = cvt_pk_bf16((float)a1[0] * c1[0], (float)a1[1] * c1[1]); w.w = cvt_pk_bf16((float)a1[2] * c1[2], (float)a1[3] * c1[3]);
                    *(u32x4*)(rowp + bj * HALF) = w; } }
    }
};
struct EpiScoresI8 {
    static constexpr bool PERM = false, AFTER_DRAIN = false;
    unsigned short* scT; int Mtok; const float* part; const float* xscale; const float* wscale;
    __device__ __forceinline__ void operator()(const i32x4e (&acc)[2][2][4][2], const Unit& u, int wr, int wc, int fr, int fq) const {
        const int row0 = u.pm * BM + wr * 64 + fr, colb = u.pn * BM + wc * 32 + 4 * fq;
        f32x4 ws[2][2];
#pragma unroll
        for (int bj = 0; bj < 2; ++bj)
#pragma unroll
            for (int n = 0; n < 2; ++n) ws[bj][n] = *(const f32x4*)(wscale + colb + bj * HALF + 16 * n);
#pragma unroll
        for (int ai = 0; ai < 2; ++ai)
#pragma unroll
            for (int m = 0; m < 4; ++m) { const int row = row0 + ai * HALF + m * 16; const float sc = row_rstd(part, row, fq) * xscale[row];
#pragma unroll
                for (int bj = 0; bj < 2; ++bj)
#pragma unroll
                    for (int n = 0; n < 2; ++n) { const int hp = 2 * u.pn + bj, kq = 8 * wc + 4 * n + fq; const i32x4e a = acc[ai][bj][m][n]; const f32x4 w = ws[bj][n];
                        *(f16x4*)(scT + ((size_t)(hp * 32 + kq) * Mtok + row) * 4) = (f16x4){(_Float16)((float)a[0] * sc * w[0]), (_Float16)((float)a[1] * sc * w[1]), (_Float16)((float)a[2] * sc * w[2]), (_Float16)((float)a[3] * sc * w[3])}; } }
    }
};

template <class Epi, class Sched, bool ALIGN_EPI = false, bool SP2 = false>
__device__ __forceinline__ void gemm_phase(PG8_LAS unsigned char* lds, const Gemm g, const Sched& S, const Epi& E) {
    const int tid = threadIdx.x, wid = __builtin_amdgcn_readfirstlane(tid >> 6), lane = tid & 63, wr = wid >> 2, wc = wid & 3, fr = lane & 15, fq = lane >> 4;
    const int K = g.K, nt = K / BK;
    const int ldA = g.lda ? g.lda : K;
    unsigned voffA[2], voffB[2];
#pragma unroll
    for (int i = 0; i < 2; ++i) { int R, C; stage_rc(tid * 16 + i * 8192, R, C); const int Rb = Epi::PERM ? ((R & ~31) + perm32(R & 31)) : R;
        voffA[i] = (unsigned)(R * ldA + C) * 2u; voffB[i] = (unsigned)(Rb * K + C) * 2u; }
    const size_t kstepA = g.lda ? (size_t)g.M * 64 * 2 : (size_t)(BK * 2);
    const size_t hstepA = (size_t)HALF * ldA * 2, tstepA = 2 * hstepA;
    const size_t kstep = (size_t)(BK * 2);
    const size_t hstep = (size_t)HALF * K * 2;
    const size_t tstep = 2 * hstep;
    const unsigned ldsw = (unsigned)wid * 1024u;
    const int aoff = lds_byte(wr * 64 + fr, fq * 8), boff = lds_byte(wc * 32 + fr, fq * 8);
#define PG8_SA(b, h) (((b) * 2 + (h)) * HTB)
#define PG8_SB(b, h) ((4 + (b) * 2 + (h)) * HTB)
#define PG8_STAGE(bufoff, gbase, voff) do { _Pragma("unroll") for (int _i = 0; _i < 2; ++_i) \
        __builtin_amdgcn_global_load_lds((const unsigned*)((const char*)(gbase) + (voff)[_i]), (PG8_LAS unsigned*)(lds + (bufoff) + ldsw + _i * 8192), 16, 0, 0); } while (0)
#define PG8_LDA(dst, b, h) do { _Pragma("unroll") for (int m = 0; m < 4; ++m) _Pragma("unroll") for (int k = 0; k < 2; ++k) dst[m][k] = *(const PG8_LAS bf16x8*)(lds + PG8_SA(b, h) + aoff + m * 2048 + k * 1024); } while (0)
#define PG8_LDB(dst, b, h) do { _Pragma("unroll") for (int n = 0; n < 2; ++n) _Pragma("unroll") for (int k = 0; k < 2; ++k) dst[n][k] = *(const PG8_LAS bf16x8*)(lds + PG8_SB(b, h) + boff + n * 2048 + k * 1024); } while (0)
#define PG8_MMA(ai, bj, At, Bt) do { __builtin_amdgcn_s_setprio(1); _Pragma("unroll") for (int m = 0; m < 4; ++m) _Pragma("unroll") for (int n = 0; n < 2; ++n) _Pragma("unroll") for (int k = 0; k < 2; ++k) \
        acc[ai][bj][m][n] = __builtin_amdgcn_mfma_f32_16x16x32_bf16(Bt[n][k], At[m][k], acc[ai][bj][m][n], 0, 0, 0); __builtin_amdgcn_s_setprio(0); } while (0)
#define PG8_WAIT_V(n) asm volatile("s_waitcnt vmcnt(" #n ")" ::: "memory")
#define PG8_WAIT_L(n) asm volatile("s_waitcnt lgkmcnt(" #n ")" ::: "memory")
#define PG8_BAR __builtin_amdgcn_s_barrier()
#define PG8_SCHED __builtin_amdgcn_sched_barrier(0)
    Unit cur, nxt; int ui = 0;
    if (!S.next(0, cur)) return;
    f32x4 acc[2][2][4][2];
#pragma unroll
    for (int a = 0; a < 2; ++a)
#pragma unroll
        for (int b = 0; b < 2; ++b)
#pragma unroll
            for (int m = 0; m < 4; ++m)
#pragma unroll
                for (int n = 0; n < 2; ++n) acc[a][b][m][n] = (f32x4){0.f, 0.f, 0.f, 0.f};
    bf16x8 At[4][2], B0[2][2], B1[2][2];
    const char* cA = (const char*)g.A + (size_t)cur.pm * tstepA; const char* cB = (const char*)g.Bt + (size_t)cur.pn * tstep;
    S.a_ready(cur);
    if constexpr (SP2) {
        PG8_STAGE(PG8_SB(0, 0), cB, voffB); PG8_STAGE(PG8_SB(0, 1), cB + hstep, voffB); PG8_STAGE(PG8_SA(0, 0), cA, voffA); PG8_STAGE(PG8_SA(0, 1), cA + hstepA, voffA);
        if (wr == 1) PG8_BAR;
        PG8_WAIT_V(2); PG8_BAR;
        PG8_STAGE(PG8_SB(1, 0), cB + kstep, voffB); PG8_STAGE(PG8_SA(1, 0), cA + kstepA, voffA); PG8_STAGE(PG8_SB(1, 1), cB + hstep + kstep, voffB);
        PG8_WAIT_V(6); PG8_BAR;
    } else {
        PG8_STAGE(PG8_SB(0, 0), cB, voffB); PG8_STAGE(PG8_SA(0, 0), cA, voffA); PG8_STAGE(PG8_SB(0, 1), cB + hstep, voffB); PG8_STAGE(PG8_SA(0, 1), cA + hstepA, voffA);
        if (wr == 1) PG8_BAR;
        PG8_WAIT_V(4); PG8_BAR;
        PG8_STAGE(PG8_SB(1, 0), cB + kstep, voffB); PG8_STAGE(PG8_SA(1, 0), cA + kstepA, voffA); PG8_STAGE(PG8_SB(1, 1), cB + hstep + kstep, voffB);
        PG8_WAIT_V(6); PG8_BAR;
    }
    for (;;) {
        const bool has_next = S.next(ui + 1, nxt);
        const char* nA = has_next ? (const char*)g.A + (size_t)nxt.pm * tstepA : cA; const char* nB = has_next ? (const char*)g.Bt + (size_t)nxt.pn * tstep : cB;
        for (int t = 0; t < nt; t += 2) {
            const bool last = (t == nt - 2);
            const char* a1 = cA + (size_t)(t + 1) * kstepA;
            const char* a2 = last ? nA : cA + (size_t)(t + 2) * kstepA; const char* b2 = last ? nB : cB + (size_t)(t + 2) * kstep;
            const char* a3 = a2 + kstepA; const char* b3 = b2 + kstep;
            if (last && has_next) S.a_ready(nxt);
            if constexpr (SP2) {
            PG8_LDB(B0, 0, 0); PG8_LDB(B1, 0, 1); PG8_SCHED; PG8_LDA(At, 0, 0); PG8_STAGE(PG8_SA(1, 1), a1 + hstepA, voffA);
            PG8_WAIT_V(8); PG8_WAIT_L(0); PG8_BAR; PG8_MMA(0, 0, At, B0); PG8_MMA(0, 1, At, B1); PG8_BAR; PG8_SCHED;
            PG8_LDA(At, 0, 1); PG8_STAGE(PG8_SB(0, 0), b2, voffB); PG8_STAGE(PG8_SB(0, 1), b2 + hstep, voffB); PG8_STAGE(PG8_SA(0, 0), a2, voffA);
            PG8_WAIT_V(8); PG8_WAIT_L(0); PG8_BAR; PG8_MMA(1, 0, At, B0); PG8_MMA(1, 1, At, B1); PG8_BAR; PG8_SCHED;
            PG8_LDB(B0, 1, 0); PG8_LDB(B1, 1, 1); PG8_SCHED; PG8_LDA(At, 1, 0); PG8_STAGE(PG8_SA(0, 1), a2 + hstepA, voffA);
            PG8_WAIT_V(8); PG8_WAIT_L(0); PG8_BAR; PG8_MMA(0, 0, At, B0); PG8_MMA(0, 1, At, B1); PG8_BAR; PG8_SCHED;
            PG8_LDA(At, 1, 1); PG8_STAGE(PG8_SB(1, 0), b3, voffB); PG8_STAGE(PG8_SB(1, 1), b3 + hstep, voffB); PG8_STAGE(PG8_SA(1, 0), a3, voffA);
            PG8_WAIT_V(8); PG8_WAIT_L(0); PG8_BAR; PG8_MMA(1, 0, At, B0); PG8_MMA(1, 1, At, B1); PG8_BAR; PG8_SCHED;
            } else {
            PG8_LDB(B0, 0, 0); PG8_SCHED; PG8_LDA(At, 0, 0); PG8_STAGE(PG8_SA(1, 1), a1 + hstepA, voffA);
            PG8_WAIT_L(8); PG8_BAR; PG8_WAIT_L(0); PG8_MMA(0, 0, At, B0); PG8_BAR; PG8_SCHED;
            PG8_LDB(B1, 0, 1); PG8_STAGE(PG8_SB(0, 0), b2, voffB);
            PG8_BAR; PG8_WAIT_L(0); PG8_MMA(0, 1, At, B1); PG8_BAR;
            PG8_LDA(At, 0, 1); PG8_STAGE(PG8_SA(0, 0), a2, voffA);
            PG8_BAR; PG8_WAIT_L(0); PG8_MMA(1, 0, At, B0); PG8_BAR; PG8_SCHED;
            PG8_STAGE(PG8_SB(0, 1), b2 + hstep, voffB);
            PG8_WAIT_V(6); PG8_BAR; PG8_MMA(1, 1, At, B1); PG8_BAR;
            PG8_LDB(B0, 1, 0); PG8_SCHED; PG8_LDA(At, 1, 0); PG8_STAGE(PG8_SA(0, 1), a2 + hstepA, voffA);
            PG8_WAIT_L(8); PG8_BAR; PG8_WAIT_L(0); PG8_MMA(0, 0, At, B0); PG8_BAR; PG8_SCHED;
            PG8_LDB(B1, 1, 1); PG8_STAGE(PG8_SB(1, 0), b3, voffB);
            PG8_BAR; PG8_WAIT_L(0); PG8_MMA(0, 1, At, B1); PG8_BAR;
            PG8_LDA(At, 1, 1); PG8_STAGE(PG8_SA(1, 0), a3, voffA);
            PG8_BAR; PG8_WAIT_L(0); PG8_MMA(1, 0, At, B0); PG8_BAR; PG8_SCHED;
            PG8_STAGE(PG8_SB(1, 1), b3 + hstep, voffB);
            PG8_WAIT_V(6); PG8_BAR; PG8_MMA(1, 1, At, B1); PG8_BAR;
            }
        }
        if constexpr (ALIGN_EPI) { if (wr == 0) PG8_BAR; }
        if constexpr (!Epi::AFTER_DRAIN) { E(acc, cur, wr, wc, fr, fq); S.done(cur); }
        if (!has_next) break;
#pragma unroll
        for (int a = 0; a < 2; ++a)
#pragma unroll
            for (int b = 0; b < 2; ++b)
#pragma unroll
                for (int m = 0; m < 4; ++m)
#pragma unroll
                    for (int n = 0; n < 2; ++n) acc[a][b][m][n] = (f32x4){0.f, 0.f, 0.f, 0.f};
        cur = nxt; cA = nA; cB = nB; ++ui;
        if constexpr (ALIGN_EPI) { if (wr == 1) PG8_BAR; }
    }
    PG8_WAIT_V(0);
    if constexpr (!ALIGN_EPI) { if (wr == 0) PG8_BAR; }
    PG8_BAR;
    if constexpr (Epi::AFTER_DRAIN) { E.fused(acc, cur, wr, wc, fr, fq, lds, wid, lane); S.done(cur); }
#undef PG8_SA
#undef PG8_SB
#undef PG8_STAGE
#undef PG8_LDA
#undef PG8_LDB
#undef PG8_MMA
#undef PG8_WAIT_V
#undef PG8_WAIT_L
#undef PG8_BAR
#undef PG8_SCHED
}
typedef int i32x4 __attribute__((ext_vector_type(4)));
template <class Epi, class Sched, bool ALIGN_EPI = false, bool SP2 = false>
__device__ __forceinline__ void gemm_phase_i8(PG8_LAS unsigned char* lds, const Gemm g, const Sched& S, const Epi& E) {
    const int tid = threadIdx.x, wid = __builtin_amdgcn_readfirstlane(tid >> 6), lane = tid & 63, wr = wid >> 2, wc = wid & 3, fr = lane & 15, fq = lane >> 4;
    const int K = g.K, nt = K / BK;
    const int ldA = g.lda ? g.lda : K;
    unsigned voffA[2], voffB[2];
#pragma unroll
    for (int i = 0; i < 2; ++i) { int R, C; stage_rc(tid * 16 + i * 8192, R, C); const int Rb = Epi::PERM ? ((R & ~31) + perm32(R & 31)) : R;
        voffA[i] = (unsigned)(R * ldA + C) * 2u; voffB[i] = (unsigned)(Rb * K + C) * 2u; }
    const size_t kstepA = g.lda ? (size_t)g.M * 64 * 2 : (size_t)(BK * 2);
    const size_t hstepA = (size_t)HALF * ldA * 2, tstepA = 2 * hstepA;
    const size_t kstep = (size_t)(BK * 2);
    const size_t hstep = (size_t)HALF * K * 2;
    const size_t tstep = 2 * hstep;
    const unsigned ldsw = (unsigned)wid * 1024u;
    const int aoff = lds_byte(wr * 64 + fr, fq * 8), boff = lds_byte(wc * 32 + fr, fq * 8);
#define PG8_SA(b, h) (((b) * 2 + (h)) * HTB)
#define PG8_SB(b, h) ((4 + (b) * 2 + (h)) * HTB)
#define PG8_STAGE(bufoff, gbase, voff) do { _Pragma("unroll") for (int _i = 0; _i < 2; ++_i) \
        __builtin_amdgcn_global_load_lds((const unsigned*)((const char*)(gbase) + (voff)[_i]), (PG8_LAS unsigned*)(lds + (bufoff) + ldsw + _i * 8192), 16, 0, 0); } while (0)
#define PG8_LDA(dst, b, h) do { _Pragma("unroll") for (int m = 0; m < 4; ++m) _Pragma("unroll") for (int k = 0; k < 2; ++k) dst[m][k] = *(const PG8_LAS bf16x8*)(lds + PG8_SA(b, h) + aoff + m * 2048 + k * 1024); } while (0)
#define PG8_LDB(dst, b, h) do { _Pragma("unroll") for (int n = 0; n < 2; ++n) _Pragma("unroll") for (int k = 0; k < 2; ++k) dst[n][k] = *(const PG8_LAS bf16x8*)(lds + PG8_SB(b, h) + boff + n * 2048 + k * 1024); } while (0)
#define PG8_MMA(ai, bj, At, Bt) do { __builtin_amdgcn_s_setprio(1); _Pragma("unroll") for (int m = 0; m < 4; ++m) _Pragma("unroll") for (int n = 0; n < 2; ++n) _Pragma("unroll") for (int k = 0; k < 2; ++k) \
        acc[ai][bj][m][n] = __builtin_amdgcn_mfma_i32_16x16x64_i8(__builtin_bit_cast(i32x4, Bt[n][k]), __builtin_bit_cast(i32x4, At[m][k]), acc[ai][bj][m][n], 0, 0, 0); __builtin_amdgcn_s_setprio(0); } while (0)
#define PG8_WAIT_V(n) asm volatile("s_waitcnt vmcnt(" #n ")" ::: "memory")
#define PG8_WAIT_L(n) asm volatile("s_waitcnt lgkmcnt(" #n ")" ::: "memory")
#define PG8_BAR __builtin_amdgcn_s_barrier()
#define PG8_SCHED __builtin_amdgcn_sched_barrier(0)
    Unit cur, nxt; int ui = 0;
    if (!S.next(0, cur)) return;
    i32x4 acc[2][2][4][2];
#pragma unroll
    for (int a = 0; a < 2; ++a)
#pragma unroll
        for (int b = 0; b < 2; ++b)
#pragma unroll
            for (int m = 0; m < 4; ++m)
#pragma unroll
                for (int n = 0; n < 2; ++n) acc[a][b][m][n] = (i32x4){0, 0, 0, 0};
    bf16x8 At[4][2], B0[2][2], B1[2][2];
    const char* cA = (const char*)g.A + (size_t)cur.pm * tstepA; const char* cB = (const char*)g.Bt + (size_t)cur.pn * tstep;
    S.a_ready(cur);
    if constexpr (SP2) {
        PG8_STAGE(PG8_SB(0, 0), cB, voffB); PG8_STAGE(PG8_SB(0, 1), cB + hstep, voffB); PG8_STAGE(PG8_SA(0, 0), cA, voffA); PG8_STAGE(PG8_SA(0, 1), cA + hstepA, voffA);
        if (wr == 1) PG8_BAR;
        PG8_WAIT_V(2); PG8_BAR;
        PG8_STAGE(PG8_SB(1, 0), cB + kstep, voffB); PG8_STAGE(PG8_SA(1, 0), cA + kstepA, voffA); PG8_STAGE(PG8_SB(1, 1), cB + hstep + kstep, voffB);
        PG8_WAIT_V(6); PG8_BAR;
    } else {
        PG8_STAGE(PG8_SB(0, 0), cB, voffB); PG8_STAGE(PG8_SA(0, 0), cA, voffA); PG8_STAGE(PG8_SB(0, 1), cB + hstep, voffB); PG8_STAGE(PG8_SA(0, 1), cA + hstepA, voffA);
        if (wr == 1) PG8_BAR;
        PG8_WAIT_V(4); PG8_BAR;
        PG8_STAGE(PG8_SB(1, 0), cB + kstep, voffB); PG8_STAGE(PG8_SA(1, 0), cA + kstepA, voffA); PG8_STAGE(PG8_SB(1, 1), cB + hstep + kstep, voffB);
        PG8_WAIT_V(6); PG8_BAR;
    }
    for (;;) {
        const bool has_next = S.next(ui + 1, nxt);
        const char* nA = has_next ? (const char*)g.A + (size_t)nxt.pm * tstepA : cA; const char* nB = has_next ? (const char*)g.Bt + (size_t)nxt.pn * tstep : cB;
        for (int t = 0; t < nt; t += 2) {
            const bool last = (t == nt - 2);
            const char* a1 = cA + (size_t)(t + 1) * kstepA;
            const char* a2 = last ? nA : cA + (size_t)(t + 2) * kstepA; const char* b2 = last ? nB : cB + (size_t)(t + 2) * kstep;
            const char* a3 = a2 + kstepA; const char* b3 = b2 + kstep;
            if (last && has_next) S.a_ready(nxt);
            if constexpr (SP2) {
            PG8_LDB(B0, 0, 0); PG8_LDB(B1, 0, 1); PG8_SCHED; PG8_LDA(At, 0, 0); PG8_STAGE(PG8_SA(1, 1), a1 + hstepA, voffA);
            PG8_WAIT_V(8); PG8_WAIT_L(0); PG8_BAR; PG8_MMA(0, 0, At, B0); PG8_MMA(0, 1, At, B1); PG8_BAR; PG8_SCHED;
            PG8_LDA(At, 0, 1); PG8_STAGE(PG8_SB(0, 0), b2, voffB); PG8_STAGE(PG8_SB(0, 1), b2 + hstep, voffB); PG8_STAGE(PG8_SA(0, 0), a2, voffA);
            PG8_WAIT_V(8); PG8_WAIT_L(0); PG8_BAR; PG8_MMA(1, 0, At, B0); PG8_MMA(1, 1, At, B1); PG8_BAR; PG8_SCHED;
            PG8_LDB(B0, 1, 0); PG8_LDB(B1, 1, 1); PG8_SCHED; PG8_LDA(At, 1, 0); PG8_STAGE(PG8_SA(0, 1), a2 + hstepA, voffA);
            PG8_WAIT_V(8); PG8_WAIT_L(0); PG8_BAR; PG8_MMA(0, 0, At, B0); PG8_MMA(0, 1, At, B1); PG8_BAR; PG8_SCHED;
            PG8_LDA(At, 1, 1); PG8_STAGE(PG8_SB(1, 0), b3, voffB); PG8_STAGE(PG8_SB(1, 1), b3 + hstep, voffB); PG8_STAGE(PG8_SA(1, 0), a3, voffA);
            PG8_WAIT_V(8); PG8_WAIT_L(0); PG8_BAR; PG8_MMA(1, 0, At, B0); PG8_MMA(1, 1, At, B1); PG8_BAR; PG8_SCHED;
            } else {
            PG8_LDB(B0, 0, 0); PG8_SCHED; PG8_LDA(At, 0, 0); PG8_STAGE(PG8_SA(1, 1), a1 + hstepA, voffA);
            PG8_WAIT_L(8); PG8_BAR; PG8_WAIT_L(0); PG8_MMA(0, 0, At, B0); PG8_BAR; PG8_SCHED;
            PG8_LDB(B1, 0, 1); PG8_STAGE(PG8_SB(0, 0), b2, voffB);
            PG8_BAR; PG8_WAIT_L(0); PG8_MMA(0, 1, At, B1); PG8_BAR;
            PG8_LDA(At, 0, 1); PG8_STAGE(PG8_SA(0, 0), a2, voffA);
            PG8_BAR; PG8_WAIT_L(0); PG8_MMA(1, 0, At, B0); PG8_BAR; PG8_SCHED;
            PG8_STAGE(PG8_SB(0, 1), b2 + hstep, voffB);
            PG8_WAIT_V(6); PG8_BAR; PG8_MMA(1, 1, At, B1); PG8_BAR;
            PG8_LDB(B0, 1, 0); PG8_SCHED; PG8_LDA(At, 1, 0); PG8_STAGE(PG8_SA(0, 1), a2 + hstepA, voffA);
            PG8_WAIT_L(8); PG8_BAR; PG8_WAIT_L(0); PG8_MMA(0, 0, At, B0); PG8_BAR; PG8_SCHED;
            PG8_LDB(B1, 1, 1); PG8_STAGE(PG8_SB(1, 0), b3, voffB);
            PG8_BAR; PG8_WAIT_L(0); PG8_MMA(0, 1, At, B1); PG8_BAR;
            PG8_LDA(At, 1, 1); PG8_STAGE(PG8_SA(1, 0), a3, voffA);
            PG8_BAR; PG8_WAIT_L(0); PG8_MMA(1, 0, At, B0); PG8_BAR; PG8_SCHED;
            PG8_STAGE(PG8_SB(1, 1), b3 + hstep, voffB);
            PG8_WAIT_V(6); PG8_BAR; PG8_MMA(1, 1, At, B1); PG8_BAR;
            }
        }
        if constexpr (ALIGN_EPI) { if (wr == 0) PG8_BAR; }
        if constexpr (!Epi::AFTER_DRAIN) { E(acc, cur, wr, wc, fr, fq); S.done(cur); }
        if (!has_next) break;
#pragma unroll
        for (int a = 0; a < 2; ++a)
#pragma unroll
            for (int b = 0; b < 2; ++b)
#pragma unroll
                for (int m = 0; m < 4; ++m)
#pragma unroll
                    for (int n = 0; n < 2; ++n) acc[a][b][m][n] = (i32x4){0, 0, 0, 0};
        cur = nxt; cA = nA; cB = nB; ++ui;
        if constexpr (ALIGN_EPI) { if (wr == 1) PG8_BAR; }
    }
    PG8_WAIT_V(0);
    if constexpr (!ALIGN_EPI) { if (wr == 0) PG8_BAR; }
    PG8_BAR;
    if constexpr (Epi::AFTER_DRAIN) { E.fused(acc, cur, wr, wc, fr, fq, lds, wid, lane); S.done(cur); }
#undef PG8_SA
#undef PG8_SB
#undef PG8_STAGE
#undef PG8_LDA
#undef PG8_LDB
#undef PG8_MMA
#undef PG8_WAIT_V
#undef PG8_WAIT_L
#undef PG8_BAR
#undef PG8_SCHED
}
}

#ifndef PG8_SP2
#define PG8_SP2 true
#endif
#ifndef PG8_ALIGN
#define PG8_ALIGN true
#endif

constexpr int NWAVES = 8, NT = NWAVES * 64;
constexpr int BATCH = 4, SEQ = 8192, D = 1024, M = BATCH * SEQ;
constexpr int IN_COLS = 3584;
constexpr int NMEM = 256, MROWS = BATCH * NMEM;
constexpr int NEXP = 16384;
constexpr float EPS = 1e-6f;
constexpr float QSCALE = 0.0625f * 1.4426950408889634f;

constexpr size_t MiB = 1u << 20;
constexpr size_t WS_CTL = 0, CTL_ZERO_BYTES = 64 * 1024;
constexpr size_t WS_PART1 = 1 * MiB;
constexpr size_t WS_DECAY = 5 * MiB;
constexpr size_t WS_WIN = 6 * MiB, WS_WOUT = 13 * MiB, WS_WQ = 15 * MiB, WS_WKV = 17 * MiB, WS_WO = 21 * MiB, WS_WEFF = 23 * MiB;
constexpr size_t WS_MEMN = 27 * MiB, WS_KB = 29 * MiB, WS_VT = 31 * MiB;
constexpr size_t WS_PUP = 1 * MiB;
constexpr size_t WS_A = 33 * MiB;
constexpr size_t WS_X = 97 * MiB;
constexpr size_t WS_PROJ = WS_X, WS_US = WS_X + 224 * MiB;
constexpr size_t WS_B1 = WS_X, WS_Q = WS_X + 64 * MiB;
constexpr size_t WS_X2S = WS_X + 64 * MiB;
constexpr size_t WS_SCT = WS_X + 128 * MiB;
constexpr size_t WS_PDOWN = WS_X;
constexpr size_t WS_IDX = WS_A, WS_GATE = WS_A + 8 * MiB;
constexpr size_t WS_PART2 = WS_X + 384 * MiB;
constexpr size_t WS_SSQ = WS_PART2 + 2 * MiB;
constexpr size_t WS_DSCALE = WS_SSQ + 2 * MiB, WS_USCALE = WS_DSCALE + 65536;
constexpr size_t WS_XSCALE = WS_USCALE + 65536, WS_CORR = WS_XSCALE + 131072;
constexpr size_t WS_WPK = WS_A + 56 * MiB;
constexpr size_t WS_XQ = WS_A + 24 * MiB;
constexpr size_t WS_END = WS_CORR + 131072;

constexpr size_t WS_PROBE_DUMMY = WS_X + 256 * MiB;
constexpr int RING_BYTES = 131072, LDS_BYTES = 147456;

#define LAS __attribute__((address_space(3)))
typedef unsigned short bf16;
typedef float f32x2 __attribute__((ext_vector_type(2)));
typedef float f32x4 __attribute__((ext_vector_type(4)));
typedef float f32x16 __attribute__((ext_vector_type(16)));
typedef short bf16x8 __attribute__((ext_vector_type(8)));
typedef unsigned v4u __attribute__((ext_vector_type(4)));
typedef unsigned v2u __attribute__((ext_vector_type(2)));
typedef __bf16 bf16x2_t __attribute__((ext_vector_type(2)));
#define LDS_WAIT() asm volatile("s_waitcnt lgkmcnt(0)" ::: "memory")
__device__ __forceinline__ float bf2f(unsigned short b) { return __uint_as_float(((unsigned)b) << 16); }
__device__ __forceinline__ float bflo(unsigned u) { return __uint_as_float(u << 16); }
__device__ __forceinline__ float bfhi(unsigned u) { return __uint_as_float(u & 0xffff0000u); }
__device__ __forceinline__ unsigned pk2(float lo, float hi) { f32x2 v = {lo, hi}; bf16x2_t b = __builtin_convertvector(v, bf16x2_t); return __builtin_bit_cast(unsigned, b); }
__device__ __forceinline__ float xlane_dpp_b1(float v) { return __uint_as_float((unsigned)__builtin_amdgcn_update_dpp(0, (int)__float_as_uint(v), 0xB1, 0xF, 0xF, false)); }
__device__ __forceinline__ float xlane_dpp_4e(float v) { return __uint_as_float((unsigned)__builtin_amdgcn_update_dpp(0, (int)__float_as_uint(v), 0x4E, 0xF, 0xF, false)); }
__device__ __forceinline__ float xlane_dpp_x4(float v) { int r = __builtin_amdgcn_update_dpp(0, (int)__float_as_uint(v), 0x12C, 0xF, 0x5, false); r = __builtin_amdgcn_update_dpp(r, (int)__float_as_uint(v), 0x124, 0xF, 0xA, false); return __uint_as_float((unsigned)r); }
__device__ __forceinline__ float xlane_dpp_x8(float v) { return __uint_as_float((unsigned)__builtin_amdgcn_update_dpp(0, (int)__float_as_uint(v), 0x128, 0xF, 0xF, false)); }
__device__ __forceinline__ float xlane_x16(float v) { const auto r = __builtin_amdgcn_permlane16_swap(__float_as_uint(v), __float_as_uint(v), false, false); return __uint_as_float((__builtin_amdgcn_mbcnt_lo(~0u, 0u) + __builtin_amdgcn_mbcnt_hi(~0u, 0u)) & 16 ? r[0] : r[1]); }
__device__ __forceinline__ float xlane_x32(float v) { const auto r = __builtin_amdgcn_permlane32_swap(__float_as_uint(v), __float_as_uint(v), false, false); return __uint_as_float((__builtin_amdgcn_mbcnt_lo(~0u, 0u) + __builtin_amdgcn_mbcnt_hi(~0u, 0u)) & 32 ? r[0] : r[1]); }
__device__ __forceinline__ float wave_sum(float v) {
    v += xlane_dpp_b1(v); v += xlane_dpp_4e(v); v += xlane_dpp_x4(v); v += xlane_dpp_x8(v);
    { const auto r = __builtin_amdgcn_permlane16_swap(__float_as_uint(v), __float_as_uint(v), false, false); v = __uint_as_float(r[0]) + __uint_as_float(r[1]); }
    { const auto r = __builtin_amdgcn_permlane32_swap(__float_as_uint(v), __float_as_uint(v), false, false); v = __uint_as_float(r[0]) + __uint_as_float(r[1]); }
    return v;
}
__device__ __forceinline__ float wave_max(float v) {
    v = fmaxf(v, xlane_dpp_b1(v)); v = fmaxf(v, xlane_dpp_4e(v)); v = fmaxf(v, xlane_dpp_x4(v)); v = fmaxf(v, xlane_dpp_x8(v));
    { const auto r = __builtin_amdgcn_permlane16_swap(__float_as_uint(v), __float_as_uint(v), false, false); v = fmaxf(__uint_as_float(r[0]), __uint_as_float(r[1])); }
    { const auto r = __builtin_amdgcn_permlane32_swap(__float_as_uint(v), __float_as_uint(v), false, false); v = fmaxf(__uint_as_float(r[0]), __uint_as_float(r[1])); }
    return v;
}
__device__ __forceinline__ float sigmoidf_(float x) { return __builtin_amdgcn_rcpf(1.0f + __expf(-x)); }
__device__ __forceinline__ int kappa(int rho) { return (rho & 0x13) | ((rho & 4) << 1) | ((rho & 8) >> 1); }
__device__ __forceinline__ bf16x8 as_bf16x8(v4u v) { return __builtin_bit_cast(bf16x8, v); }

__device__ __forceinline__ void p0_transpose_item(const float* W, int K, int N, bf16* WT, const float* gain, LAS float* scr, int item, int lane) {
    const int nblk = N / 32, kb = item / nblk, nb = item % nblk, k0 = 64 * kb, n0 = 32 * nb;
    float wv[32];
#pragma unroll
    for (int i = 0; i < 32; ++i) { const int kk = 2 * i + (lane >> 5); wv[i] = W[(size_t)(k0 + kk) * N + n0 + (lane & 31)]; }
#pragma unroll
    for (int i = 0; i < 32; ++i) { const int kk = 2 * i + (lane >> 5); const float g = gain ? gain[k0 + kk] : 1.0f; scr[kk * 33 + (lane & 31)] = wv[i] * g; }
    LDS_WAIT();
    const int c = lane & 7;
#pragma unroll
    for (int j = 0; j < 4; ++j) { const int n = (lane >> 3) + 8 * j; const LAS float* s = scr + (8 * c) * 33 + n;
        v4u o; o.x = pk2(s[0 * 33], s[1 * 33]); o.y = pk2(s[2 * 33], s[3 * 33]); o.z = pk2(s[4 * 33], s[5 * 33]); o.w = pk2(s[6 * 33], s[7 * 33]);
        *(v4u*)(WT + (size_t)(n0 + n) * K + k0 + 8 * c) = o; }
    LDS_WAIT();
}
__device__ __forceinline__ void rms_row_to_bf16(const float* xrow, const float* gain, bf16* orow, int lane) {
    const f32x4* xr = (const f32x4*)xrow + lane; f32x4 v[4]; float s = 0.f;
#pragma unroll
    for (int j = 0; j < 4; ++j) { v[j] = xr[64 * j]; s += (v[j].x * v[j].x + v[j].y * v[j].y) + (v[j].z * v[j].z + v[j].w * v[j].w); }
    const float r = rsqrtf(wave_sum(s) * (1.0f / 1024.0f) + EPS);
    const f32x4* gr = (const f32x4*)gain + lane; unsigned long long* o8 = (unsigned long long*)orow + lane;
#pragma unroll
    for (int j = 0; j < 4; ++j) { const f32x4 g = gr[64 * j]; o8[64 * j] = (unsigned long long)pk2(v[j].x * r * g.x, v[j].y * r * g.y) | ((unsigned long long)pk2(v[j].z * r * g.z, v[j].w * r * g.w) << 32); }
}
__device__ __forceinline__ void p0_weffq_wg(const float* wquery, const float* subkeys, const float* gain, signed char* WQ, float* wscale, int item, LAS unsigned char* lds, int tid) {
    const int hp = item >> 4, kg = item & 15, lane = tid & 63, wave = tid >> 6;
    LAS f32x4* sk = (LAS f32x4*)lds;
    LAS float* am_s = (LAS float*)(lds + 8192);
    if (tid < 256) sk[tid] = ((const f32x4*)(subkeys + (size_t)(hp * 128 + kg * 8) * 128))[tid];
    __syncthreads();
    float acc[2][8];
#pragma unroll
    for (int ph = 0; ph < 2; ++ph) { const int k = (ph * 8 + wave) * 64 + lane; const f32x4* wrow = (const f32x4*)(wquery + (size_t)k * 2048 + hp * 128);
#pragma unroll
        for (int i = 0; i < 8; ++i) acc[ph][i] = 0.f;
#pragma unroll 4
        for (int d4 = 0; d4 < 32; ++d4) { const f32x4 w = wrow[d4];
#pragma unroll
            for (int key = 0; key < 8; ++key) { const f32x4 sv = sk[key * 32 + d4]; acc[ph][key] += (w.x * sv.x + w.y * sv.y) + (w.z * sv.z + w.w * sv.w); } }
        const float g = gain[k];
#pragma unroll
        for (int i = 0; i < 8; ++i) acc[ph][i] *= g; }
#pragma unroll
    for (int key = 0; key < 8; ++key) { const float m = wave_max(fmaxf(fabsf(acc[0][key]), fabsf(acc[1][key]))); if (lane == 0) am_s[wave * 8 + key] = m; }
    __syncthreads();
    if (tid < 8) { float m = 0.f;
#pragma unroll
        for (int w8 = 0; w8 < 8; ++w8) m = fmaxf(m, am_s[w8 * 8 + tid]);
        am_s[256 + tid] = m; wscale[hp * 128 + kg * 8 + tid] = m * (1.0f / 127.0f); }
    __syncthreads();
#pragma unroll
    for (int key = 0; key < 8; ++key) { const float am = am_s[256 + key]; const float inv = am > 0.f ? 127.0f / am : 0.f;
#pragma unroll
        for (int ph = 0; ph < 2; ++ph) WQ[(size_t)(hp * 128 + kg * 8 + key) * 1024 + (ph * 8 + wave) * 64 + lane] = (signed char)(int)rintf(acc[ph][key] * inv); }
    __syncthreads();
}
__device__ __forceinline__ void p0_win_wg(const float* W, signed char* WQ, float* wscale, int item, LAS unsigned char* lds, int tid) {
    const int n0 = 14 * item, nl = tid & 15, kr = tid >> 4; const bool act = nl < 14;
    LAS float* am_s = (LAS float*)lds;
    LAS unsigned char* tile = lds + 4096;
    float wv[32]; float am = 0.f;
#pragma unroll
    for (int i = 0; i < 32; ++i) wv[i] = act ? W[(size_t)(kr + 32 * i) * IN_COLS + n0 + nl] : 0.f;
#pragma unroll
    for (int i = 0; i < 32; ++i) am = fmaxf(am, fabsf(wv[i]));
    am_s[kr * 16 + nl] = am;
    __syncthreads();
    if (tid < 16) { float m = 0.f;
#pragma unroll
        for (int r = 0; r < 32; ++r) m = fmaxf(m, am_s[r * 16 + tid]);
        am_s[512 + tid] = m; if (tid < 14) wscale[n0 + tid] = m * (1.0f / 127.0f); }
    __syncthreads();
    { const float amx = am_s[512 + nl]; const float inv = amx > 0.f ? 127.0f / amx : 0.f;
      if (act) {
#pragma unroll
          for (int i = 0; i < 32; ++i) tile[nl * 1028 + kr + 32 * i] = (unsigned char)((int)rintf(wv[i] * inv) & 255); } }
    __syncthreads();
    for (int p = tid; p < 14 * 64; p += NT) { const int n = p >> 6, c = p & 63; const LAS unsigned* src = (const LAS unsigned*)(tile + n * 1028 + 16 * c);
        *(v4u*)(WQ + (size_t)(n0 + n) * 1024 + 16 * c) = (v4u){src[0], src[1], src[2], src[3]}; }
    __syncthreads();
}
__device__ __forceinline__ void p0_prologue(const float* const* in, unsigned char* ws, LAS unsigned char* lds, int vcu, int G, int tid, int sel) {
    const int lane = tid & 63, wave = __builtin_amdgcn_readfirstlane(tid >> 6), gw = vcu * NWAVES + wave, NGW = G * NWAVES;
    LAS float* scr = (LAS float*)(lds + wave * 16384);
    const float *x = in[0], *mem = in[1], *mix_norm_w = in[2], *w_in = in[3], *w_out = in[8], *xattn_norm_w = in[9], *mem_norm_w = in[10], *wq = in[11], *wkv = in[12], *wo = in[13],
                *ffn_norm_w = in[14], *w_query = in[15], *sub_keys = in[16];
    if (sel & 1) for (int it = vcu; it < 256; it += G) { p0_weffq_wg(w_query, sub_keys, ffn_norm_w, (signed char*)(ws + WS_WEFF), (float*)(ws + WS_WEFF + 2 * MiB), it, lds, tid);
                                                          p0_win_wg(w_in, (signed char*)(ws + WS_WIN), (float*)(ws + WS_WIN + 4 * MiB), it, lds, tid); }
    constexpr int I_SQ = 16 * 32, I_KV = 16 * 64;
    constexpr int NITEMS = 3 * I_SQ + I_KV;
    if (sel & 2) for (int it = gw; it < NITEMS; it += NGW) {
        int r = it;
        if (r < I_SQ) { p0_transpose_item(w_out, 1024, 1024, (bf16*)(ws + WS_WOUT), nullptr, scr, r, lane); continue; } r -= I_SQ;
        if (r < I_SQ) { p0_transpose_item(wq, 1024, 1024, (bf16*)(ws + WS_WQ), xattn_norm_w, scr, r, lane); continue; } r -= I_SQ;
        if (r < I_KV) { p0_transpose_item(wkv, 1024, 2048, (bf16*)(ws + WS_WKV), nullptr, scr, r, lane); continue; } r -= I_KV;
        p0_transpose_item(wo, 1024, 1024, (bf16*)(ws + WS_WO), nullptr, scr, r, lane);
    }
    if (!(sel & 4)) return;
    for (int m = gw; m < MROWS; m += NGW) rms_row_to_bf16(mem + (size_t)m * D, mem_norm_w, (bf16*)(ws + WS_MEMN) + (size_t)m * D, lane);
    for (int m = gw; m < M; m += 4 * NGW) {
        f32x4 v[4][4]; float ss[4], am[4];
#pragma unroll
        for (int r = 0; r < 4; ++r) { const int mr = m + r * NGW < M ? m + r * NGW : m; const f32x4* xr = (const f32x4*)(x + (size_t)mr * D) + lane;
#pragma unroll
            for (int j = 0; j < 4; ++j) v[r][j] = xr[64 * j]; }
        const f32x4* gr = (const f32x4*)mix_norm_w + lane;
#pragma unroll
        for (int r = 0; r < 4; ++r) { float s = 0.f, a_ = 0.f;
#pragma unroll
            for (int j = 0; j < 4; ++j) { s += (v[r][j].x * v[r][j].x + v[r][j].y * v[r][j].y) + (v[r][j].z * v[r][j].z + v[r][j].w * v[r][j].w); v[r][j] = v[r][j] * gr[64 * j];
                a_ = fmaxf(a_, fmaxf(fmaxf(fabsf(v[r][j].x), fabsf(v[r][j].y)), fmaxf(fabsf(v[r][j].z), fabsf(v[r][j].w)))); }
            ss[r] = s; am[r] = a_; }
#pragma unroll
        for (int r = 0; r < 4; ++r) { ss[r] = wave_sum(ss[r]); am[r] = wave_max(am[r]); }
#pragma unroll
        for (int r = 0; r < 4; ++r) { if (m + r * NGW < M) { const int mr = m + r * NGW; const float rr = rsqrtf(ss[r] * (1.0f / 1024.0f) + EPS), inv = am[r] > 0.f ? 127.0f / am[r] : 0.f;
            unsigned* o4 = (unsigned*)(ws + WS_A + (size_t)mr * D) + lane;
#pragma unroll
            for (int j = 0; j < 4; ++j) { const int q0 = (int)rintf(v[r][j].x * inv), q1 = (int)rintf(v[r][j].y * inv), q2 = (int)rintf(v[r][j].z * inv), q3 = (int)rintf(v[r][j].w * inv);
                o4[64 * j] = (unsigned)(q0 & 255) | ((unsigned)(q1 & 255) << 8) | ((unsigned)(q2 & 255) << 16) | ((unsigned)(q3 & 255) << 24); }
            if (lane == 0) ((float*)(ws + WS_PART1))[mr] = rr * am[r] * (1.0f / 127.0f); } }
    }
}

struct ConvIn { v4u bg, cg0, vv0, cg1, vv1, cg2, vv2; };
__device__ __forceinline__ ConvIn conv_load(const bf16* P, int m, int lane) {
    const int t = m & (SEQ - 1), c0 = 8 * lane; const bf16* row = P + (size_t)m * IN_COLS; ConvIn in;
    in.bg = *(const v4u*)(row + c0); in.cg0 = *(const v4u*)(row + 512 + c0); in.vv0 = *(const v4u*)(row + 1024 + c0);
    in.cg1 = (v4u){0, 0, 0, 0}; in.vv1 = (v4u){0, 0, 0, 0}; in.cg2 = (v4u){0, 0, 0, 0}; in.vv2 = (v4u){0, 0, 0, 0};
    if (t >= 1) { in.cg1 = *(const v4u*)(row - IN_COLS + 512 + c0); in.vv1 = *(const v4u*)(row - IN_COLS + 1024 + c0); }
    if (t >= 2) { in.cg2 = *(const v4u*)(row - 2 * IN_COLS + 512 + c0); in.vv2 = *(const v4u*)(row - 2 * IN_COLS + 1024 + c0); }
    return in;
}
__device__ __forceinline__ void conv_finish(const ConvIn& in, const float* conv_w, const float* conv_norm_w, bf16* Y, int m, int lane) {
    const int c0 = 8 * lane;
    const f32x4 w0a = *(const f32x4*)(conv_w + c0), w0b = *(const f32x4*)(conv_w + c0 + 4);
    const f32x4 w1a = *(const f32x4*)(conv_w + 512 + c0), w1b = *(const f32x4*)(conv_w + 512 + c0 + 4);
    const f32x4 w2a = *(const f32x4*)(conv_w + 1024 + c0), w2b = *(const f32x4*)(conv_w + 1024 + c0 + 4);
    float y[8]; float ss = 0.f;
#pragma unroll
    for (int q = 0; q < 4; ++q) {
#pragma unroll
        for (int hl = 0; hl < 2; ++hl) { const int e = 2 * q + hl;
            const float b = hl ? bfhi(in.bg[q]) : bflo(in.bg[q]);
            const float u0 = (hl ? bfhi(in.cg0[q]) : bflo(in.cg0[q])) * (hl ? bfhi(in.vv0[q]) : bflo(in.vv0[q]));
            const float u1 = (hl ? bfhi(in.cg1[q]) : bflo(in.cg1[q])) * (hl ? bfhi(in.vv1[q]) : bflo(in.vv1[q]));
            const float u2 = (hl ? bfhi(in.cg2[q]) : bflo(in.cg2[q])) * (hl ? bfhi(in.vv2[q]) : bflo(in.vv2[q]));
            const float wt0 = e < 4 ? w0a[e & 3] : w0b[e & 3], wt1 = e < 4 ? w1a[e & 3] : w1b[e & 3], wt2 = e < 4 ? w2a[e & 3] : w2b[e & 3];
            y[e] = b * (wt0 * u2 + wt1 * u1 + wt2 * u0); ss += y[e] * y[e]; } }
    const float r = rsqrtf(wave_sum(ss) * (1.0f / 512.0f) + EPS);
    const f32x4 ga = *(const f32x4*)(conv_norm_w + c0), gb = *(const f32x4*)(conv_norm_w + c0 + 4);
    v4u o; o.x = pk2(y[0] * r * ga[0], y[1] * r * ga[1]); o.y = pk2(y[2] * r * ga[2], y[3] * r * ga[3]); o.z = pk2(y[4] * r * gb[0], y[5] * r * gb[1]); o.w = pk2(y[6] * r * gb[2], y[7] * r * gb[3]);
    *(v4u*)(Y + (size_t)m * 1024 + c0) = o;
}
__device__ __forceinline__ void conv_tokens4(const bf16* P, const float* conv_w, const float* conv_norm_w, bf16* Y, int m0, int lane) {
    const int t0 = m0 & (SEQ - 1), c0 = 8 * lane; const bf16* row = P + (size_t)m0 * IN_COLS;
    v4u bg[4], cg[6], vv[6];
#pragma unroll
    for (int r = 0; r < 4; ++r) bg[r] = *(const v4u*)(row + (size_t)r * IN_COLS + c0);
#pragma unroll
    for (int r = 0; r < 6; ++r) { if (t0 + r - 2 >= 0) { cg[r] = *(const v4u*)(row + (ptrdiff_t)(r - 2) * IN_COLS + 512 + c0); vv[r] = *(const v4u*)(row + (ptrdiff_t)(r - 2) * IN_COLS + 1024 + c0); } else { cg[r] = (v4u){0, 0, 0, 0}; vv[r] = (v4u){0, 0, 0, 0}; } }
    const f32x4 w0a = *(const f32x4*)(conv_w + c0), w0b = *(const f32x4*)(conv_w + c0 + 4);
    const f32x4 w1a = *(const f32x4*)(conv_w + 512 + c0), w1b = *(const f32x4*)(conv_w + 512 + c0 + 4);
    const f32x4 w2a = *(const f32x4*)(conv_w + 1024 + c0), w2b = *(const f32x4*)(conv_w + 1024 + c0 + 4);
    const f32x4 ga = *(const f32x4*)(conv_norm_w + c0), gb = *(const f32x4*)(conv_norm_w + c0 + 4);
    float u[6][8];
#pragma unroll
    for (int r = 0; r < 6; ++r)
#pragma unroll
        for (int q = 0; q < 4; ++q) { u[r][2 * q] = bflo(cg[r][q]) * bflo(vv[r][q]); u[r][2 * q + 1] = bfhi(cg[r][q]) * bfhi(vv[r][q]); }
    float y[4][8], ss[4];
#pragma unroll
    for (int r = 0; r < 4; ++r) { float s = 0.f;
#pragma unroll
        for (int e = 0; e < 8; ++e) { const float b = (e & 1) ? bfhi(bg[r][e >> 1]) : bflo(bg[r][e >> 1]);
            const float wt0 = e < 4 ? w0a[e & 3] : w0b[e & 3], wt1 = e < 4 ? w1a[e & 3] : w1b[e & 3], wt2 = e < 4 ? w2a[e & 3] : w2b[e & 3];
            y[r][e] = b * (wt0 * u[r][e] + wt1 * u[r + 1][e] + wt2 * u[r + 2][e]); s += y[r][e] * y[r][e]; }
        ss[r] = s; }
#pragma unroll
    for (int r = 0; r < 4; ++r) { const float rr = rsqrtf(wave_sum(ss[r]) * (1.0f / 512.0f) + EPS);
        v4u o; o.x = pk2(y[r][0] * rr * ga[0], y[r][1] * rr * ga[1]); o.y = pk2(y[r][2] * rr * ga[2], y[r][3] * rr * ga[3]); o.z = pk2(y[r][4] * rr * gb[0], y[r][5] * rr * gb[1]); o.w = pk2(y[r][6] * rr * gb[2], y[r][7] * rr * gb[3]);
        *(v4u*)(Y + (size_t)(m0 + r) * 1024 + c0) = o; }
}

__device__ __forceinline__ void h1_unit(int b, int n, const bf16* P, const float* lbl, bf16* UsT, float* decay, LAS unsigned char* lds, int tid) {
    const int c = tid, h = c >> 7, kch = c & 127, lane = tid & 63, w = tid >> 6;
    const size_t tok0 = (size_t)b * SEQ + (size_t)n * 64;
    const float lb = sigmoidf_(lbl[c] - lbl[512 + c]), oml = 1.0f - lb;
    LAS unsigned char* KT = lds; LAS unsigned char* IT = lds + 65536; LAS float* DEC = (LAS float*)(lds + 131072);
    {
        const bf16* pf = P + tok0 * IN_COLS + 2048 + c;
        float Pf = 1.f;
#pragma unroll 1
        for (int seg = 0; seg < 2; ++seg) {
            float fv[32]; unsigned iv[16];
#pragma unroll
            for (int j = 0; j < 32; ++j) fv[j] = bf2f(pf[(size_t)j * IN_COLS]);
#pragma unroll
            for (int j = 0; j < 16; ++j) iv[j] = (unsigned)pf[(size_t)(2 * j) * IN_COLS + 512] | ((unsigned)pf[(size_t)(2 * j + 1) * IN_COLS + 512] << 16);
            pf += (size_t)32 * IN_COLS;
#pragma unroll
            for (int q = 0; q < 4; ++q) { unsigned pk[4];
#pragma unroll
                for (int e = 0; e < 4; ++e) { float kt2[2];
#pragma unroll
                    for (int hl = 0; hl < 2; ++hl) { const float sg = sigmoidf_(fv[8 * q + 2 * e + hl]); Pf *= lb + oml * sg; kt2[hl] = oml * (1.0f - sg) * __builtin_amdgcn_rcpf(Pf); }
                    pk[e] = pk2(kt2[0], kt2[1]); }
                *(LAS v4u*)(KT + c * 128 + (((4 * seg + q) ^ (c & 7)) * 16)) = (v4u){pk[0], pk[1], pk[2], pk[3]}; }
#pragma unroll
            for (int q = 0; q < 4; ++q) *(LAS v4u*)(IT + c * 128 + (((4 * seg + q) ^ (c & 7)) * 16)) = (v4u){iv[4 * q], iv[4 * q + 1], iv[4 * q + 2], iv[4 * q + 3]};
        }
        const float dcy = Pf;
        DEC[c] = dcy;
        decay[((size_t)(b * 4 + h) * 128 + n) * 128 + kch] = dcy;
    }
    __syncthreads();
    {
        const int hd = w >> 1, half = w & 1, l31 = lane & 31, hh = lane >> 5;
        bf16* ub = UsT + ((size_t)(b * 4 + hd) * 128 + n) * 16384;
#pragma unroll 1
        for (int vb = 0; vb < 2; ++vb) {
            f32x16 acc[4];
#pragma unroll
            for (int bq = 0; bq < 4; ++bq)
#pragma unroll
                for (int r = 0; r < 16; ++r) acc[bq][r] = 0.f;
            const int v = hd * 128 + (half * 2 + vb) * 32 + l31;
#pragma unroll
            for (int s = 0; s < 4; ++s) { const int chunk = 2 * s + hh; bf16x8 bfr[4];
                const bf16x8 af = *(const LAS bf16x8*)(IT + v * 128 + ((chunk ^ (v & 7)) * 16));
#pragma unroll
                for (int kb = 0; kb < 4; ++kb) { const int k = hd * 128 + kb * 32 + l31; bfr[kb] = *(const LAS bf16x8*)(KT + k * 128 + ((chunk ^ (k & 7)) * 16)); }
#pragma unroll
                for (int kb = 0; kb < 4; ++kb) acc[kb] = __builtin_amdgcn_mfma_f32_32x32x16_bf16(af, bfr[kb], acc[kb], 0, 0, 0); }
#pragma unroll
            for (int kb = 0; kb < 4; ++kb) { const float dk = DEC[hd * 128 + kb * 32 + l31];
#pragma unroll
                for (int r = 0; r < 16; ++r) { const int vr = (half * 2 + vb) * 32 + (r & 3) + 8 * (r >> 2) + 4 * hh; ub[(size_t)vr * 128 + kb * 32 + l31] = (bf16)(pk2(acc[kb][r] * dk, 0.f) & 0xffffu); } }
        }
    }
    __syncthreads();
}

__device__ __forceinline__ void h2_scan(bf16* UsT, const float* decay, int gw, int NGW, int lane, long dry_off) {
    for (int task = gw; task < 16 * 128; task += NGW) {
        const int bh = task >> 7, v = task & 127;
        unsigned* p = (unsigned*)(UsT + (size_t)bh * 128 * 16384 + (size_t)v * 128) + lane;
        const f32x2* dp = (const f32x2*)(decay + (size_t)bh * 128 * 128) + lane;
        f32x2 S = {0.f, 0.f};
        for (int n0 = 0; n0 < 128; n0 += 16) { unsigned u[16]; f32x2 d[16];
#pragma unroll
            for (int j = 0; j < 16; ++j) { u[j] = p[(size_t)(n0 + j) * 8192]; d[j] = dp[(size_t)(n0 + j) * 64]; }
#pragma unroll
            for (int j = 0; j < 16; ++j) { p[(size_t)(n0 + j) * 8192 + dry_off] = pk2(S.x, S.y); S = d[j] * S + (f32x2){bflo(u[j]), bfhi(u[j])}; } }
    }
}

__device__ __forceinline__ void h3_unit(int b, int n, int h, const bf16* P, const float* lbl, const bf16* UsT, const float* hnw, bf16* Y, LAS unsigned char* lds, int tid) {
    const int lane = tid & 63, w = tid >> 6, bh = b * 4 + h;
    const size_t tok0 = (size_t)b * SEQ + (size_t)n * 64;
    LAS unsigned char* RAW = lds; LAS unsigned char* QD = lds + 49152; LAS unsigned char* KI = lds + 65536; LAS unsigned char* IT = lds + 81920; LAS unsigned char* ST = lds + 98304;
    LAS float* OS = (LAS float*)lds; LAS float* TOT = (LAS float*)(lds + 131072);
    {
        { v4u raw[3][2];
#pragma unroll
          for (int tl = 0; tl < 3; ++tl)
#pragma unroll
              for (int i = 0; i < 2; ++i) { const int idx = tid + 512 * i, row = idx >> 4, ch = idx & 15; raw[tl][i] = *(const v4u*)(P + (tok0 + row) * IN_COLS + 1536 + 512 * tl + h * 128 + 8 * ch); }
          const int v = tid >> 2, kq = tid & 3; const v4u* src = (const v4u*)(UsT + ((size_t)bh * 128 + n) * 16384 + (size_t)v * 128 + 32 * kq); v4u stv[4];
#pragma unroll
          for (int i = 0; i < 4; ++i) stv[i] = src[i];
#pragma unroll
          for (int tl = 0; tl < 3; ++tl)
#pragma unroll
              for (int i = 0; i < 2; ++i) *(LAS v4u*)(RAW + tl * 16384 + (tid + 512 * i) * 16) = raw[tl][i];
#pragma unroll
          for (int i = 0; i < 4; ++i) *(LAS v4u*)(ST + v * 256 + (((4 * kq + i) ^ (v & 15)) * 16)) = stv[i]; }
        __syncthreads();
        const int k = tid & 127, tq = tid >> 7;
        const float lb = sigmoidf_(lbl[h * 128 + k] - lbl[512 + h * 128 + k]), oml = 1.0f - lb;
        const LAS bf16* rq = (const LAS bf16*)RAW + (16 * tq) * 128 + k; const LAS bf16* rf = rq + 8192; const LAS bf16* ri = rq + 16384;
        float sg[16], cs[16], qv[16]; float c = 1.f;
#pragma unroll
        for (int j = 0; j < 16; ++j) { const float f = bf2f(rf[j * 128]); qv[j] = bf2f(rq[j * 128]); sg[j] = sigmoidf_(f); c *= lb + oml * sg[j]; cs[j] = c; }
        TOT[tq * 128 + k] = c;
        { unsigned iv[8];
#pragma unroll
          for (int j = 0; j < 8; ++j) iv[j] = (unsigned)ri[(2 * j) * 128] | ((unsigned)ri[(2 * j + 1) * 128] << 16);
          const int sw = (k >> 1) & 7;
          *(LAS v4u*)(IT + k * 128 + (((2 * tq) ^ sw) * 16)) = (v4u){iv[0], iv[1], iv[2], iv[3]};
          *(LAS v4u*)(IT + k * 128 + (((2 * tq + 1) ^ sw) * 16)) = (v4u){iv[4], iv[5], iv[6], iv[7]}; }
        __syncthreads();
        float off = 1.f;
#pragma unroll
        for (int q = 0; q < 4; ++q) off *= (q < tq) ? TOT[q * 128 + k] : 1.f;
#pragma unroll
        for (int j = 0; j < 16; ++j) { const int t = 16 * tq + j; const float eg = off * cs[j];
            const float qd = qv[j] * sigmoidf_(qv[j]) * eg, ki = oml * (1.0f - sg[j]) * __builtin_amdgcn_rcpf(eg);
            const int o = t * 256 + (((k >> 3) ^ (t & 15)) * 16) + (k & 7) * 2;
            *(LAS bf16*)(QD + o) = (bf16)(pk2(qd, 0.f) & 0xffffu); *(LAS bf16*)(KI + o) = (bf16)(pk2(ki, 0.f) & 0xffffu); }
    }
    __syncthreads();
    {
        const int tb = w & 1, vb = w >> 1, l31 = lane & 31, hh = lane >> 5, t = 32 * tb + l31;
        bf16x8 qf[8];
#pragma unroll
        for (int ks = 0; ks < 8; ++ks) qf[ks] = *(const LAS bf16x8*)(QD + t * 256 + (((2 * ks + hh) ^ (t & 15)) * 16));
        f32x16 o;
#pragma unroll
        for (int r = 0; r < 16; ++r) o[r] = 0.f;
        const int v = 32 * vb + l31;
#pragma unroll
        for (int sb = 0; sb < 2; ++sb) {
            if (sb <= tb) {
                f32x16 x;
#pragma unroll
                for (int r = 0; r < 16; ++r) x[r] = 0.f;
                const int srow = 32 * sb + kappa(l31);
#pragma unroll
                for (int ks = 0; ks < 8; ++ks) { const bf16x8 a = *(const LAS bf16x8*)(KI + srow * 256 + (((2 * ks + hh) ^ (srow & 15)) * 16)); x = __builtin_amdgcn_mfma_f32_32x32x16_bf16(a, qf[ks], x, 0, 0, 0); }
                if (sb == tb) {
#pragma unroll
                    for (int r = 0; r < 16; ++r) { const int sp = 16 * ((r >> 3) & 1) + 8 * hh + 4 * ((r >> 2) & 1) + (r & 3); if (sp > l31) x[r] = 0.f; } }
#pragma unroll
                for (int st = 0; st < 2; ++st) {
                    const v4u pb = {pk2(x[8 * st + 0], x[8 * st + 1]), pk2(x[8 * st + 2], x[8 * st + 3]), pk2(x[8 * st + 4], x[8 * st + 5]), pk2(x[8 * st + 6], x[8 * st + 7])};
                    const bf16x8 a = *(const LAS bf16x8*)(IT + v * 128 + (((4 * sb + 2 * st + hh) ^ ((v >> 1) & 7)) * 16));
                    o = __builtin_amdgcn_mfma_f32_32x32x16_bf16(a, as_bf16x8(pb), o, 0, 0, 0); }
            }
        }
#pragma unroll
        for (int ks = 0; ks < 8; ++ks) { const bf16x8 a = *(const LAS bf16x8*)(ST + v * 256 + (((2 * ks + hh) ^ (v & 15)) * 16)); o = __builtin_amdgcn_mfma_f32_32x32x16_bf16(a, qf[ks], o, 0, 0, 0); }
#pragma unroll
        for (int r = 0; r < 16; ++r) OS[t * 129 + 32 * vb + (r & 3) + 8 * (r >> 2) + 4 * hh] = o[r];
    }
    __syncthreads();
    {
        const int t = tid >> 3, vc = tid & 7; float ov[16]; float ss = 0.f;
#pragma unroll
        for (int j = 0; j < 16; ++j) { ov[j] = OS[t * 129 + 16 * vc + j]; ss += ov[j] * ov[j]; }
        ss += xlane_dpp_b1(ss); ss += xlane_dpp_4e(ss); ss += xlane_dpp_x4(ss);
        const float r = rsqrtf(ss * (1.0f / 128.0f) + EPS);
        const bf16* gp = P + (tok0 + t) * IN_COLS + 3072 + h * 128 + 16 * vc;
        const v4u g0 = *(const v4u*)gp, g1 = *(const v4u*)(gp + 8);
        const float* nw = hnw + h * 128 + 16 * vc;
        unsigned ow[8];
#pragma unroll
        for (int j = 0; j < 8; ++j) { const unsigned gw_ = j < 4 ? g0[j] : g1[j - 4]; const float ga = bflo(gw_), gb = bfhi(gw_);
            ow[j] = pk2(ov[2 * j] * r * nw[2 * j] * (ga * sigmoidf_(ga)), ov[2 * j + 1] * r * nw[2 * j + 1] * (gb * sigmoidf_(gb))); }
        bf16* yp = Y + (tok0 + t) * 1024 + 512 + h * 128 + 16 * vc;
        *(v4u*)yp = (v4u){ow[0], ow[1], ow[2], ow[3]}; *(v4u*)(yp + 8) = (v4u){ow[4], ow[5], ow[6], ow[7]};
    }
    __syncthreads();
}

typedef float f32x4a __attribute__((ext_vector_type(4)));
__device__ __forceinline__ int kswz(int row) { return (row & 3) | (((row >> 3) & 3) << 2); }
__device__ __forceinline__ void attn_unit(int b, int hd, int qb, const bf16* Q, const bf16* Kb, const bf16* VT, bf16* O, LAS unsigned char* lds, int tid) {
    const int lane = tid & 63, w = __builtin_amdgcn_readfirstlane(tid >> 6), l15 = lane & 15, kq = lane >> 4, bh = b * 4 + hd;
    const size_t tok = (size_t)b * SEQ + (size_t)qb * 128 + 16 * w + l15;
    const bf16* kbase = Kb + (size_t)bh * 65536; const bf16* vbase = VT + (size_t)bh * 65536;
#define ATT_LOAD(j) do { _Pragma("unroll") for (int i = 0; i < 4; ++i) { const int idx = tid + 512 * i; const bf16* src_; \
        if ((j) < 4) { const int row = idx >> 5, ch = idx & 31; src_ = kbase + (size_t)(j) * 16384 + row * 256 + ((ch ^ kswz(row)) * 8); } \
        else { const int row = idx >> 3, ch = idx & 7; src_ = vbase + (size_t)row * 256 + 64 * ((j) - 4) + ((ch ^ ((row >> 1) & 7)) * 8); } \
        __builtin_amdgcn_global_load_lds((const unsigned*)src_, (LAS unsigned*)(lds + ((j) & 1) * 32768 + i * 8192 + w * 1024), 16, 0, 0); } } while (0)
#define ATT_LANDED() do { asm volatile("s_waitcnt vmcnt(0)" ::: "memory"); __syncthreads(); } while (0)
    bf16x8 qf[8];
    { const bf16* qp = Q + tok * 1024 + hd * 256 + 8 * kq;
#pragma unroll
      for (int ks = 0; ks < 8; ++ks) qf[ks] = *(const bf16x8*)(qp + 32 * ks); }
    ATT_LOAD(0);
    ATT_LANDED();
    f32x4a p[16];
#pragma unroll
    for (int j = 0; j < 4; ++j) {
        ATT_LOAD(j + 1);
        const LAS unsigned char* buf = lds + (j & 1) * 32768;
#pragma unroll
        for (int blk = 0; blk < 4; ++blk) { f32x4a x = {0.f, 0.f, 0.f, 0.f};
            const int row = 32 * (blk >> 1) + 8 * (l15 >> 2) + 4 * (blk & 1) + (l15 & 3);
#pragma unroll
            for (int ks = 0; ks < 8; ++ks) { const bf16x8 a = *(const LAS bf16x8*)(buf + row * 512 + (((4 * ks + kq) ^ kswz(row)) * 16)); x = __builtin_amdgcn_mfma_f32_16x16x32_bf16(a, qf[ks], x, 0, 0, 0); }
            p[4 * j + blk] = x; }
        ATT_LANDED();
    }
    float mx = p[0][0];
#pragma unroll
    for (int i = 0; i < 16; ++i)
#pragma unroll
        for (int r = 0; r < 4; ++r) mx = fmaxf(mx, p[i][r]);
    mx = fmaxf(mx, __shfl_xor(mx, 16)); mx = fmaxf(mx, __shfl_xor(mx, 32));
    float lsum = 0.f;
#pragma unroll
    for (int i = 0; i < 16; ++i)
#pragma unroll
        for (int r = 0; r < 4; ++r) { p[i][r] = __builtin_amdgcn_exp2f(p[i][r] - mx); lsum += p[i][r]; }
    lsum += __shfl_xor(lsum, 16); lsum += __shfl_xor(lsum, 32);
    const float inv = 1.0f / lsum;
    v4u pb[8];
#pragma unroll
    for (int s = 0; s < 8; ++s) pb[s] = (v4u){pk2(p[2 * s][0], p[2 * s][1]), pk2(p[2 * s][2], p[2 * s][3]), pk2(p[2 * s + 1][0], p[2 * s + 1][1]), pk2(p[2 * s + 1][2], p[2 * s + 1][3])};
    f32x4a ot[16];
#pragma unroll
    for (int i = 0; i < 16; ++i) ot[i] = (f32x4a){0.f, 0.f, 0.f, 0.f};
#pragma unroll
    for (int j = 4; j < 8; ++j) {
        if (j + 1 < 8) ATT_LOAD(j + 1);
        const LAS unsigned char* buf = lds + (j & 1) * 32768;
#pragma unroll
        for (int db = 0; db < 16; ++db) { const int row = 16 * db + l15;
#pragma unroll
            for (int s = 0; s < 2; ++s) { const bf16x8 a = *(const LAS bf16x8*)(buf + row * 128 + (((4 * s + kq) ^ ((row >> 1) & 7)) * 16));
                ot[db] = __builtin_amdgcn_mfma_f32_16x16x32_bf16(a, as_bf16x8(pb[2 * (j - 4) + s]), ot[db], 0, 0, 0); } }
        ATT_LANDED();
    }
    bf16* op = O + tok * 1024 + hd * 256 + 4 * kq;
#pragma unroll
    for (int db = 0; db < 16; ++db) { v2u o2 = {pk2(ot[db][0] * inv, ot[db][1] * inv), pk2(ot[db][2] * inv, ot[db][3] * inv)}; *(v2u*)(op + 16 * db) = o2; }
#undef ATT_LOAD
#undef ATT_LANDED
}

__device__ __forceinline__ unsigned ord_f32(float f) { const unsigned u = __float_as_uint(f); return u ^ ((unsigned)((int)u >> 31) | 0x80000000u); }
__device__ __forceinline__ float unord_f32(unsigned o) { return __uint_as_float(o ^ (~(unsigned)((int)o >> 31) | 0x80000000u)); }
__device__ __forceinline__ void ce_desc(unsigned& a, unsigned& b) { const unsigned hi = a > b ? a : b, lo = a > b ? b : a; a = hi; b = lo; }
__device__ __forceinline__ void sort16_desc(unsigned (&a)[16]) {
    ce_desc(a[0], a[1]); ce_desc(a[2], a[3]); ce_desc(a[0], a[2]); ce_desc(a[1], a[3]); ce_desc(a[1], a[2]); ce_desc(a[4], a[5]); ce_desc(a[6], a[7]); ce_desc(a[4], a[6]); ce_desc(a[5], a[7]); ce_desc(a[5], a[6]);
    ce_desc(a[0], a[4]); ce_desc(a[2], a[6]); ce_desc(a[2], a[4]); ce_desc(a[1], a[5]); ce_desc(a[3], a[7]); ce_desc(a[3], a[5]); ce_desc(a[1], a[2]); ce_desc(a[3], a[4]); ce_desc(a[5], a[6]); ce_desc(a[8], a[9]);
    ce_desc(a[10], a[11]); ce_desc(a[8], a[10]); ce_desc(a[9], a[11]); ce_desc(a[9], a[10]); ce_desc(a[12], a[13]); ce_desc(a[14], a[15]); ce_desc(a[12], a[14]); ce_desc(a[13], a[15]); ce_desc(a[13], a[14]);
    ce_desc(a[8], a[12]); ce_desc(a[10], a[14]); ce_desc(a[10], a[12]); ce_desc(a[9], a[13]); ce_desc(a[11], a[15]); ce_desc(a[11], a[13]); ce_desc(a[9], a[10]); ce_desc(a[11], a[12]); ce_desc(a[13], a[14]);
    ce_desc(a[0], a[8]); ce_desc(a[4], a[12]); ce_desc(a[4], a[8]); ce_desc(a[2], a[10]); ce_desc(a[6], a[14]); ce_desc(a[6], a[10]); ce_desc(a[2], a[4]); ce_desc(a[6], a[8]); ce_desc(a[10], a[12]); ce_desc(a[1], a[9]);
    ce_desc(a[5], a[13]); ce_desc(a[5], a[9]); ce_desc(a[3], a[11]); ce_desc(a[7], a[15]); ce_desc(a[7], a[11]); ce_desc(a[3], a[5]); ce_desc(a[7], a[9]); ce_desc(a[11], a[13]); ce_desc(a[1], a[2]); ce_desc(a[3], a[4]);
    ce_desc(a[5], a[6]); ce_desc(a[7], a[8]); ce_desc(a[9], a[10]); ce_desc(a[11], a[12]); ce_desc(a[13], a[14]);
}
__device__ __forceinline__ void merge_prune16(unsigned (&top)[16], const unsigned (&nw)[16]) {
#pragma unroll
    for (int i = 0; i < 16; ++i) top[i] = top[i] > nw[15 - i] ? top[i] : nw[15 - i];
#pragma unroll
    for (int j = 8; j > 0; j >>= 1)
#pragma unroll
        for (int i = 0; i < 16; ++i) { const int l = i ^ j; if (l > i) ce_desc(top[i], top[l]); }
}
__device__ __forceinline__ void topk_load(const unsigned short* scT, int hp, int token, v2u (&raw)[32]) {
#pragma unroll
    for (int kq = 0; kq < 32; ++kq) raw[kq] = *(const v2u*)(scT + ((size_t)(hp * 32 + kq) * M + token) * 4);
}
typedef short s16x2v __attribute__((ext_vector_type(2)));
__device__ __forceinline__ unsigned ord_f16x2(unsigned w) { const s16x2v m = __builtin_bit_cast(s16x2v, w) >> 15; return w ^ (__builtin_bit_cast(unsigned, m) | 0x80008000u); }
__device__ __forceinline__ float unord_f16_hi(unsigned key) { const unsigned o = key >> 16; const unsigned h = o ^ ((o & 0x8000u) ? 0x8000u : 0xffffu); return (float)__builtin_bit_cast(_Float16, (unsigned short)h); }
__device__ __forceinline__ void topk_half(const v2u (&raw)[32], unsigned (&top)[16]) {
#pragma unroll
    for (int c = 0; c < 8; ++c) { unsigned nw[16];
#pragma unroll
        for (int q = 0; q < 4; ++q) { const unsigned x0 = ord_f16x2(raw[4 * c + q].x), x1 = ord_f16x2(raw[4 * c + q].y); const int b0 = 127 - (16 * c + 4 * q);
            nw[4 * q + 0] = (x0 << 16) | (unsigned)b0;         nw[4 * q + 1] = (x0 & 0xffff0000u) | (unsigned)(b0 - 1);
            nw[4 * q + 2] = (x1 << 16) | (unsigned)(b0 - 2);   nw[4 * q + 3] = (x1 & 0xffff0000u) | (unsigned)(b0 - 3); }
        sort16_desc(nw);
        if (c == 0) {
#pragma unroll
            for (int i = 0; i < 16; ++i) top[i] = nw[i]; }
        else merge_prune16(top, nw); }
}
__device__ __forceinline__ void peer_topk_task(const unsigned short* scT, int head, int token, unsigned short* idx_out, float* gate_out, LAS unsigned char* slot) {
    unsigned ta[16], tb[16];
    { v2u ra[32], rb[32]; topk_load(scT, 2 * head, token, ra); topk_load(scT, 2 * head + 1, token, rb); topk_half(ra, ta); topk_half(rb, tb); }
    float av[16], bv[16];
#pragma unroll
    for (int i = 0; i < 16; ++i) { av[i] = unord_f16_hi(ta[i]); bv[i] = unord_f16_hi(tb[i]); }
#pragma unroll
    for (int q = 0; q < 4; ++q) {
        unsigned wa = 0, wb = 0;
#pragma unroll
        for (int e = 0; e < 4; ++e) { wa |= (127u - (ta[4 * q + e] & 127u)) << (8 * e); wb |= (127u - (tb[4 * q + e] & 127u)) << (8 * e); }
        *(LAS unsigned*)(slot + 4 * q) = wa; *(LAS unsigned*)(slot + 16 + 4 * q) = wb; }
    unsigned cd[4][16];
#pragma unroll
    for (int q = 0; q < 4; ++q)
#pragma unroll
        for (int e = 0; e < 16; ++e) cd[q][e] = 0u;
    {
        constexpr int cnt[16] = {16, 8, 5, 4, 3, 2, 2, 2, 1, 1, 1, 1, 1, 1, 1, 1};
        constexpr int stt[16] = {0, 16, 24, 29, 33, 36, 38, 40, 42, 43, 44, 45, 46, 47, 48, 49};
#pragma unroll
        for (int i = 0; i < 16; ++i)
#pragma unroll
            for (int j = 0; j < 16; ++j) if (j < cnt[i]) { const int t = stt[i] + j; const int ch = t < 16 ? 0 : t < 24 ? 1 : t < 40 ? 2 : 3, ps = t < 16 ? t : t < 24 ? t - 16 : t < 40 ? t - 24 : t - 40;
                cd[ch][ps] = (ord_f32(av[i] + bv[j]) & ~63u) | (unsigned)(63 - t); }
    }
    sort16_desc(cd[2]); sort16_desc(cd[3]);
    merge_prune16(cd[0], cd[1]); merge_prune16(cd[2], cd[3]); merge_prune16(cd[0], cd[2]);
    LDS_WAIT();
    float gv[16]; float gs = 0.f; const float vmax = unord_f32(cd[0][0] & ~63u);
    unsigned ex[16];
#pragma unroll
    for (int r = 0; r < 16; ++r) {
        const int t = 63 - (int)(cd[0][r] & 63u);
        int i = (t >= 16) + (t >= 24) + (t >= 29) + (t >= 33) + (t >= 36) + (t >= 38) + (t >= 40);
        int st = t >= 40 ? 40 : t >= 38 ? 38 : t >= 36 ? 36 : t >= 33 ? 33 : t >= 29 ? 29 : t >= 24 ? 24 : t >= 16 ? 16 : 0;
        int j = t - st;
        if (t >= 42) { i = 8 + (t - 42); j = 0; }
        const unsigned ia = *(LAS unsigned char*)(slot + i), ib = *(LAS unsigned char*)(slot + 16 + j);
        ex[r] = ia * 128u + ib;
        gv[r] = __expf(unord_f32(cd[0][r] & ~63u) - vmax); gs += gv[r]; }
    const float ginv = 1.0f / gs;
    float* gp = gate_out + (size_t)token * 128 + head * 16;
#pragma unroll
    for (int jj = 0; jj < 8; ++jj) *(unsigned*)(idx_out + (size_t)token * 128 + jj * 16 + 2 * head) = ex[jj] | (ex[jj + 8] << 16);
#pragma unroll
    for (int q = 0; q < 4; ++q) *(f32x4*)(gp + 4 * q) = (f32x4){gv[4 * q] * ginv, gv[4 * q + 1] * ginv, gv[4 * q + 2] * ginv, gv[4 * q + 3] * ginv};
}

__device__ __forceinline__ float quant_row_sliced(const float* src, const float* gain, unsigned char* dst, int rows, int r, int offset, int lane) {
    f32x4 v[4]; float am = 0.f;
#pragma unroll
    for (int jq = 0; jq < 4; ++jq) { v[jq] = ((const f32x4*)src)[64 * jq + lane]; if (gain) v[jq] = v[jq] * ((const f32x4*)gain)[64 * jq + lane];
        am = fmaxf(am, fmaxf(fmaxf(fabsf(v[jq].x), fabsf(v[jq].y)), fmaxf(fabsf(v[jq].z), fabsf(v[jq].w)))); }
    am = wave_max(am);
    const float inv = am > 0.f ? 127.0f / am : 0.f;
#pragma unroll
    for (int jq = 0; jq < 4; ++jq) { const int sl = 2 * jq + (lane >> 5);
        const int q0 = (int)rintf(v[jq].x * inv) + offset, q1 = (int)rintf(v[jq].y * inv) + offset, q2 = (int)rintf(v[jq].z * inv) + offset, q3 = (int)rintf(v[jq].w * inv) + offset;
        *(unsigned*)(dst + ((size_t)sl * rows + r) * 128 + 4 * (lane & 31)) = (unsigned)(q0 & 255) | ((unsigned)(q1 & 255) << 8) | ((unsigned)(q2 & 255) << 16) | ((unsigned)(q3 & 255) << 24); }
    return am * (1.0f / 127.0f);
}
template <bool EO = false>
__device__ __forceinline__ void quant_store_row(const f32x4 (&v)[4], float inv, unsigned char* dst, int rows, int r, int lane) {
#pragma unroll
    for (int jq = 0; jq < 4; ++jq) { const int sl = 2 * jq + (lane >> 5);
        const int q0 = (int)rintf(v[jq].x * inv), q1 = (int)rintf(v[jq].y * inv), q2 = (int)rintf(v[jq].z * inv), q3 = (int)rintf(v[jq].w * inv);
        unsigned char* d_ = dst + ((size_t)sl * rows + r) * 128;
        if (EO) { *(unsigned short*)(d_ + 2 * (lane & 31)) = (unsigned short)((q0 & 255) | ((q2 & 255) << 8)); *(unsigned short*)(d_ + 64 + 2 * (lane & 31)) = (unsigned short)((q1 & 255) | ((q3 & 255) << 8)); }
        else *(unsigned*)(d_ + 4 * (lane & 31)) = (unsigned)(q0 & 255) | ((unsigned)(q1 & 255) << 8) | ((unsigned)(q2 & 255) << 16) | ((unsigned)(q3 & 255) << 24); }
}
__device__ __forceinline__ float row_amax(const f32x4 (&v)[4]) { float am = 0.f;
#pragma unroll
    for (int jq = 0; jq < 4; ++jq) am = fmaxf(am, fmaxf(fmaxf(fabsf(v[jq].x), fabsf(v[jq].y)), fmaxf(fabsf(v[jq].z), fabsf(v[jq].w))));
    return wave_max(am); }
__device__ __forceinline__ void quant_rows4(const float* down, const float* up, const float* gain, unsigned char* dstd, unsigned char* dstu, int e0, int e1, int lane, float* dscale, float* uscale) {
    f32x4 vd0[4], vu0[4], vd1[4], vu1[4];
#pragma unroll
    for (int jq = 0; jq < 4; ++jq) { vd0[jq] = ((const f32x4*)(down + (size_t)e0 * 1024))[64 * jq + lane]; vu0[jq] = ((const f32x4*)(up + (size_t)e0 * 1024))[64 * jq + lane];
        vd1[jq] = ((const f32x4*)(down + (size_t)e1 * 1024))[64 * jq + lane]; vu1[jq] = ((const f32x4*)(up + (size_t)e1 * 1024))[64 * jq + lane]; }
#pragma unroll
    for (int jq = 0; jq < 4; ++jq) { const f32x4 g = ((const f32x4*)gain)[64 * jq + lane]; vd0[jq] = vd0[jq] * g; vd1[jq] = vd1[jq] * g; }
    const float ad0 = row_amax(vd0), au0 = row_amax(vu0), ad1 = row_amax(vd1), au1 = row_amax(vu1);
    quant_store_row(vd0, ad0 > 0.f ? 127.0f / ad0 : 0.f, dstd, NEXP, e0, lane); quant_store_row<true>(vu0, au0 > 0.f ? 127.0f / au0 : 0.f, dstu, NEXP, e0, lane);
    if (lane == 0) { dscale[e0] = ad0 * (1.0f / 127.0f); uscale[e0] = au0 * (1.0f / 127.0f); }
    if (e1 != e0) { quant_store_row(vd1, ad1 > 0.f ? 127.0f / ad1 : 0.f, dstd, NEXP, e1, lane); quant_store_row<true>(vu1, au1 > 0.f ? 127.0f / au1 : 0.f, dstu, NEXP, e1, lane);
        if (lane == 0) { dscale[e1] = ad1 * (1.0f / 127.0f); uscale[e1] = au1 * (1.0f / 127.0f); } }
}
__device__ __forceinline__ void quant_x2_rows4(const bf16* x2S, unsigned char* dst, float* xscale, int m, int stride, int lane) {
    f32x4 v[4][4]; int mr[4];
#pragma unroll
    for (int r = 0; r < 4; ++r) { mr[r] = m + r * stride < M ? m + r * stride : m;
#pragma unroll
        for (int jq = 0; jq < 4; ++jq) { const v2u w = *(const v2u*)(x2S + ((size_t)(4 * jq + (lane >> 4)) * M + mr[r]) * 64 + 4 * (lane & 15)); v[r][jq] = (f32x4){bflo(w.x), bfhi(w.x), bflo(w.y), bfhi(w.y)}; } }
#pragma unroll
    for (int r = 0; r < 4; ++r) { const float am = row_amax(v[r]);
        if (r == 0 || mr[r] != m) { quant_store_row(v[r], am > 0.f ? 127.0f / am : 0.f, dst, M, mr[r], lane); if (lane == 0) xscale[mr[r]] = am * (1.0f / 127.0f); } }
}
__device__ __forceinline__ float swap_add32(float a, float b) { const auto r = __builtin_amdgcn_permlane32_swap(__float_as_uint(a), __float_as_uint(b), false, false); return __uint_as_float(r[0]) + __uint_as_float(r[1]); }
__device__ __forceinline__ float swap_add16(float a, float b) { const auto r = __builtin_amdgcn_permlane16_swap(__float_as_uint(a), __float_as_uint(b), false, false); return __uint_as_float(r[0]) + __uint_as_float(r[1]); }
template <int CTRL> __device__ __forceinline__ float dpp_f(float v) { return __uint_as_float((unsigned)__builtin_amdgcn_update_dpp(0, (int)__float_as_uint(v), CTRL, 0xF, 0xF, false)); }
__device__ __forceinline__ float dpp_xor4(float v) {
    int r = __builtin_amdgcn_update_dpp(0, (int)__float_as_uint(v), 0x12C, 0xF, 0x5, false);
    r = __builtin_amdgcn_update_dpp(r, (int)__float_as_uint(v), 0x124, 0xF, 0xA, false);
    return __uint_as_float((unsigned)r);
}
__device__ __forceinline__ float bfly8_low(const float (&p)[8], int lane) {
    float q4[4], q2[2];
    { const bool u = (lane & 4) != 0;
#pragma unroll
      for (int i = 0; i < 4; ++i) { const float keep = u ? p[4 + i] : p[i], send = u ? p[i] : p[4 + i]; q4[i] = keep + dpp_xor4(send); } }
    { const bool u = (lane & 2) != 0;
#pragma unroll
      for (int i = 0; i < 2; ++i) { const float keep = u ? q4[2 + i] : q4[i], send = u ? q4[i] : q4[2 + i]; q2[i] = keep + dpp_f<0x4E>(send); } }
    { const bool u = (lane & 1) != 0; const float keep = u ? q2[1] : q2[0], send = u ? q2[0] : q2[1]; return keep + dpp_f<0xB1>(send); }
}
__device__ __forceinline__ f32x2 bfly16_high(const float (&p)[16], int lane) {
    float q8[8], q4[4];
#pragma unroll
    for (int i = 0; i < 8; ++i) q8[i] = swap_add32(p[i], p[8 + i]);
#pragma unroll
    for (int i = 0; i < 4; ++i) q4[i] = swap_add16(q8[i], q8[4 + i]);
    { const bool u = (lane & 8) != 0; f32x2 r;
      { const float keep = u ? q4[2] : q4[0], send = u ? q4[0] : q4[2]; r.x = keep + dpp_f<0x128>(send); }
      { const float keep = u ? q4[3] : q4[1], send = u ? q4[1] : q4[3]; r.y = keep + dpp_f<0x128>(send); }
      return r; }
}
#define PEER_ISSUE(dst, iwa, iwb, base) do { _Pragma("unroll") for (int i = 0; i < 16; ++i) { const unsigned wvv_ = i < 8 ? (iwa)[i >> 1] : (iwb)[(i - 8) >> 1]; \
        const unsigned e_ = (i & 1) ? (wvv_ >> 16) : (wvv_ & 0xffffu); dst[i] = *(const v4u*)((base) + (size_t)e_ * 128); } } while (0)
#define PEER_LOADIDX(da, db, k) do { const v4u* ip_ = (const v4u*)(idxp + (size_t)TOKC(k) * 128 + 16 * j); da = ip_[0]; db = ip_[1]; } while (0)
#define TOKC(k) (wv + ((k) < ntok ? (k) : ntok - 1) * nwv)
__device__ __forceinline__ void peer_down_phase(const unsigned char* xq, const unsigned char* downQ, const unsigned short* idxp, unsigned* part, int sl, int wv, int nwv, int lane) {
    const int j = lane >> 3, sub = lane & 7;
    const int ntok = wv < M ? (M - wv + nwv - 1) / nwv : 0;
    const unsigned char* xs = xq + (size_t)sl * M * 128 + 16 * sub; const unsigned char* ds = downQ + (size_t)sl * NEXP * 128 + 16 * sub;
    unsigned* ps = part + (size_t)sl * M * 64 + ((j & 1) ? 32 + 4 * sub + (j >> 1) : 4 * sub + (j >> 1));
    if (ntok == 0) return;
#define D_COMPUTE(dsrc, xvv, k) do { float p0[8], p1[8]; _Pragma("unroll") for (int i = 0; i < 8; ++i) { int s = 0, u = 0; \
        _Pragma("unroll") for (int q = 0; q < 4; ++q) { s = __builtin_amdgcn_sdot4((int)dsrc[i][q], (int)xvv[q], s, false); u = __builtin_amdgcn_sdot4((int)dsrc[8 + i][q], (int)xvv[q], u, false); } p0[i] = (float)s; p1[i] = (float)u; } \
        const float r0 = bfly8_low(p0, lane) * 0.015625f, r1 = bfly8_low(p1, lane) * 0.015625f;     \
        const float rc_ = dpp_f<0x128>((j & 1) ? r0 : r1);              \
        const pg8::f16x2 hv_ = (j & 1) ? (pg8::f16x2){(_Float16)rc_, (_Float16)r1} : (pg8::f16x2){(_Float16)r0, (_Float16)rc_}; \
        ps[(size_t)(wv + (k) * nwv) * 64] = __builtin_bit_cast(unsigned, hv_); } while (0)
    v4u dA[16], dB[16];
    v4u ia0, ib0, ia1, ib1; PEER_LOADIDX(ia0, ib0, 0); PEER_LOADIDX(ia1, ib1, 1);
    v4u xv0 = *(const v4u*)(xs + (size_t)TOKC(0) * 128), xv1 = *(const v4u*)(xs + (size_t)TOKC(1) * 128);
    PEER_ISSUE(dA, ia0, ib0, ds);
#pragma unroll 1
    for (int k = 0; k < ntok; k += 2) {
        v4u ia2, ib2; PEER_LOADIDX(ia2, ib2, k + 2); const v4u xv2 = *(const v4u*)(xs + (size_t)TOKC(k + 2) * 128);
        PEER_ISSUE(dB, ia1, ib1, ds);
        D_COMPUTE(dA, xv0, k);
        v4u ia3, ib3; PEER_LOADIDX(ia3, ib3, k + 3); const v4u xv3 = *(const v4u*)(xs + (size_t)TOKC(k + 3) * 128);
        PEER_ISSUE(dA, ia2, ib2, ds);
        if (k + 1 < ntok) D_COMPUTE(dB, xv1, k + 1);
        ia0 = ia2; ib0 = ib2; xv0 = xv2; ia1 = ia3; ib1 = ib3; xv1 = xv3;
    }
#undef D_COMPUTE
}
__device__ __forceinline__ void peer_combine_tokens4(const unsigned* part, const float* part2, const unsigned short* idxp, const float* dscale, const float* uscale, const float* xscale, const float* gate, unsigned* wpk, float* wscale, int t0, int stride, int lane) {
    int tk[4]; float pp[4], xs[4]; f32x2 s[4], gt[4]; unsigned ex[4];
#pragma unroll
    for (int r = 0; r < 4; ++r) { tk[r] = t0 + r * stride < M ? t0 + r * stride : t0; pp[r] = lane < 16 ? part2[(size_t)tk[r] * 16 + lane] : 0.f; xs[r] = xscale[tk[r]];
        const size_t o = (size_t)tk[r] * 64 + lane; { const unsigned short* ipp = idxp + (size_t)tk[r] * 128 + 32 * (lane & 3) + (lane >> 2); ex[r] = (unsigned)ipp[0] | ((unsigned)ipp[16] << 16); }
        gt[r] = *(const f32x2*)(gate + 2 * o); f32x2 a = {0.f, 0.f};
#pragma unroll
        for (int sl = 0; sl < 8; ++sl) { const pg8::f16x2 h = __builtin_bit_cast(pg8::f16x2, part[(size_t)sl * M * 64 + o]); a.x += (float)h[0]; a.y += (float)h[1]; }
        s[r] = a; }
    f32x2 ds[4], us[4];
#pragma unroll
    for (int r = 0; r < 4; ++r) { ds[r] = (f32x2){dscale[ex[r] & 0xffffu], dscale[ex[r] >> 16]}; us[r] = (f32x2){uscale[ex[r] & 0xffffu], uscale[ex[r] >> 16]}; }
#pragma unroll
    for (int r = 0; r < 4; ++r) { if (r > 0 && tk[r] == t0) continue;
        const float rx = rsqrtf(wave_sum(pp[r]) * (1.0f / 1024.0f) + EPS) * xs[r] * 64.0f;
        const float z0 = s[r].x * rx * ds[r].x, z1 = s[r].y * rx * ds[r].y;
        const float w0 = 0.5f * z0 * (1.0f + erff(z0 * 0.70710678118654752f)) * gt[r].x * us[r].x, w1 = 0.5f * z1 * (1.0f + erff(z1 * 0.70710678118654752f)) * gt[r].y * us[r].y;
        const float am = wave_max(fmaxf(fabsf(w0), fabsf(w1)));
        const float inv = am > 0.f ? 127.0f / am : 0.f;
        const int qq = ((int)rintf(w0 * inv) & 255) | (((int)rintf(w1 * inv) & 255) << 8);
        ((unsigned short*)wpk)[(size_t)tk[r] * 64 + lane] = (unsigned short)qq;
        if (lane == 0) wscale[tk[r]] = am * (1.0f / 127.0f); }
}
typedef int v2i_t __attribute__((ext_vector_type(2)));
#define U_COMPUTE(dsrc, wreg, k) do { const size_t tk_ = (size_t)(wv + (k) * nwv); const unsigned xx_ = *(const unsigned*)(xi0 + tk_ * 64); const float ws_ = wscale[tk_]; int acc0 = 0, acc1 = 0; \
        _Pragma("unroll") for (int h = 0; h < 2; ++h) { LAS unsigned char* buf_ = ubuf + h * 8192; \
            _Pragma("unroll") for (int i = 0; i < 8; ++i) *(LAS v4u*)(buf_ + i * 1024 + wr_off) = dsrc[8 * h + i]; \
            _Pragma("unroll") for (int i = 0; i < 8; ++i) { const int wlo_ = __builtin_amdgcn_readlane((int)(wreg), 2 * (8 * h + i)), whi_ = __builtin_amdgcn_readlane((int)(wreg), 2 * (8 * h + i) + 1); \
                const v2i_t t0_ = __builtin_amdgcn_ds_read_tr8_b64_v2i32((LAS v2i_t*)(buf_ + i * 1024 + rd_off0)), t1_ = __builtin_amdgcn_ds_read_tr8_b64_v2i32((LAS v2i_t*)(buf_ + i * 1024 + rd_off1)); \
                acc0 = __builtin_amdgcn_sdot4(t0_.x, wlo_, acc0, false); acc0 = __builtin_amdgcn_sdot4(t0_.y, whi_, acc0, false); \
                acc1 = __builtin_amdgcn_sdot4(t1_.x, wlo_, acc1, false); acc1 = __builtin_amdgcn_sdot4(t1_.y, whi_, acc1, false); } } \
        *(unsigned*)(xo0 + tk_ * 64) = pk2(__uint_as_float(xx_ << 16) + (float)acc0 * ws_, __uint_as_float(xx_ & 0xffff0000u) + (float)acc1 * ws_); } while (0)
#define U_LOADW(dst, k) do { dst = wpk[(size_t)TOKC(k) * 32 + (lane & 31)]; } while (0)
__device__ __forceinline__ void peer_up_phase(bf16* x2S, bf16* x3S, const unsigned char* upQ, const unsigned short* idxp, const unsigned* wpk, const float* wscale, int sl, int wv, int nwv, int lane, LAS unsigned char* ubuf) {
    const int j = lane >> 3, sub = lane & 7;
    const int ntok = wv < M ? (M - wv + nwv - 1) / nwv : 0;
    const unsigned char* us = upQ + (size_t)sl * NEXP * 128 + 16 * sub;
    const bf16* xi0 = x2S + (size_t)(2 * sl + (lane >> 5)) * M * 64 + 2 * (lane & 31);
    bf16* xo0 = x3S + (size_t)(2 * sl + (lane >> 5)) * M * 64 + 2 * (lane & 31);
    const int wr_off = j * 128 + ((sub ^ (j >> 1)) * 16);
    const int g_ = lane >> 4, p_ = lane & 15, r_ = p_ >> 1;
    const int rd_off0 = r_ * 128 + (((g_) ^ (r_ >> 1)) * 16) + 8 * (p_ & 1);
    const int rd_off1 = r_ * 128 + (((4 + g_) ^ (r_ >> 1)) * 16) + 8 * (p_ & 1);
    if (ntok == 0) return;
    v4u dA[16], dB[16];
    v4u ia0, ib0, ia1, ib1; PEER_LOADIDX(ia0, ib0, 0); PEER_LOADIDX(ia1, ib1, 1);
    unsigned wq0, wq1; U_LOADW(wq0, 0); U_LOADW(wq1, 1);
    PEER_ISSUE(dA, ia0, ib0, us);
#pragma unroll 1
    for (int k = 0; k < ntok; k += 2) {
        v4u ia2, ib2; PEER_LOADIDX(ia2, ib2, k + 2); unsigned wq2; U_LOADW(wq2, k + 2);
        PEER_ISSUE(dB, ia1, ib1, us);
        U_COMPUTE(dA, wq0, k);
        v4u ia3, ib3; PEER_LOADIDX(ia3, ib3, k + 3); unsigned wq3; U_LOADW(wq3, k + 3);
        PEER_ISSUE(dA, ia2, ib2, us);
        if (k + 1 < ntok) U_COMPUTE(dB, wq1, k + 1);
        ia0 = ia2; ib0 = ib2; ia1 = ia3; ib1 = ib3; wq0 = wq2; wq1 = wq3;
    }
}
#undef U_COMPUTE
#undef U_LOADW
#undef TOKC
#undef PEER_ISSUE
#undef PEER_LOADIDX
#define FN_LOAD(dst, tb) do { _Pragma("unroll") for (int r = 0; r < 4; ++r) { const int t_ = (tb) + r * NGW < M ? (tb) + r * NGW : (tb); \
        _Pragma("unroll") for (int jq = 0; jq < 4; ++jq) dst[r][jq] = *(const v2u*)(xs_ + (size_t)jq * 4 * M * 64 + (size_t)t_ * 64); } } while (0)
__device__ __forceinline__ void final_norm_phase(const bf16* x3S, float* out, const float* fin_w, int gw, int NGW, int lane) {
    if (gw >= M) return;
    const bf16* xs_ = x3S + (size_t)(lane >> 4) * M * 64 + 4 * (lane & 15);
    f32x4 w[4];
#pragma unroll
    for (int jq = 0; jq < 4; ++jq) w[jq] = ((const f32x4*)fin_w + lane)[64 * jq];
    v2u cur[4][4], nxt[4][4];
    FN_LOAD(cur, gw);
#pragma unroll 1
    for (int t = gw; t < M; t += 4 * NGW) {
        if (t + 4 * NGW < M) FN_LOAD(nxt, t + 4 * NGW);
#pragma unroll
        for (int r = 0; r < 4; ++r) { if (t + r * NGW >= M) break;
            float sa = 0.f;
#pragma unroll
            for (int jq = 0; jq < 4; ++jq) sa += (bflo(cur[r][jq].x) * bflo(cur[r][jq].x) + bfhi(cur[r][jq].x) * bfhi(cur[r][jq].x)) + (bflo(cur[r][jq].y) * bflo(cur[r][jq].y) + bfhi(cur[r][jq].y) * bfhi(cur[r][jq].y));
            const float ra = rsqrtf(wave_sum(sa) * (1.0f / 1024.0f) + EPS);
            f32x4* oa = (f32x4*)(out + (size_t)(t + r * NGW) * 1024) + lane;
#pragma unroll
            for (int jq = 0; jq < 4; ++jq) oa[64 * jq] = (f32x4){bflo(cur[r][jq].x) * ra * w[jq].x, bfhi(cur[r][jq].x) * ra * w[jq].y, bflo(cur[r][jq].y) * ra * w[jq].z, bfhi(cur[r][jq].y) * ra * w[jq].w}; }
#pragma unroll
        for (int r = 0; r < 4; ++r)
#pragma unroll
            for (int jq = 0; jq < 4; ++jq) cur[r][jq] = nxt[r][jq];
    }
}

#define XB_TMO      128
#define XB_XCNT(j)  (256  + 64 * (j))
#define XB_XSUB(j)  (1280 + 64 * (j))
#define XB_XGEN(j)  (2304 + 64 * (j))
#define XB_TOP      3328
#define XB_TOPGEN   3392
#define XCD_BAR_WORDS 3456
#define XB_SPIN_CAP (1u << 22)
__device__ __forceinline__ unsigned xb_ld(unsigned* p)              { return __hip_atomic_load(p, __ATOMIC_RELAXED, __HIP_MEMORY_SCOPE_AGENT); }
__device__ __forceinline__ unsigned xb_add(unsigned* p, unsigned v) { return __hip_atomic_fetch_add(p, v, __ATOMIC_RELAXED, __HIP_MEMORY_SCOPE_AGENT); }
__device__ __forceinline__ unsigned xb_xcc_id() { return (unsigned)__builtin_amdgcn_s_getreg((3 << 11) | 20) & 0xFu; }
#define XB_SPIN(cond, bar) do { unsigned _sp = 0; while (cond) { __builtin_amdgcn_s_sleep(1); \
    if ((++_sp & 255u) == 0u) { if (xb_ld(&(bar)[XB_TMO])) break; if (_sp > XB_SPIN_CAP) { atomicAdd(&(bar)[XB_TMO], 1u); break; } } } } while (0)
__device__ __forceinline__ unsigned xcd_barrier_post(unsigned* bar, volatile LAS unsigned* st) {
    const unsigned x = xb_xcc_id();
    if (threadIdx.x == 0) { st[2] = xb_add(&bar[XB_XCNT(x)], 1u); st[3] = x; }
    return x;
}
__device__ __forceinline__ void xcd_barrier_complete(unsigned* bar, unsigned x, unsigned& nloc, unsigned& nx) {
    const unsigned G = gridDim.x * gridDim.y * gridDim.z;
    unsigned sum, cnt, mine, sp = 0u;
    for (;;) {
        sum = 0u; cnt = 0u; mine = 0u;
#pragma unroll
        for (unsigned jx = 0; jx < 16; ++jx) { const unsigned c = xb_ld(&bar[XB_XCNT(jx)]); sum += c; cnt += (c > 0u) ? 1u : 0u; mine = (jx == x) ? c : mine; }
        if (sum == G) break;
        __builtin_amdgcn_s_sleep(1);
        if ((++sp & 255u) == 0u) { if (xb_ld(&bar[XB_TMO])) break; if (sp > XB_SPIN_CAP) { atomicAdd(&bar[XB_TMO], 1u); break; } }
    }
    nloc = mine > 0u ? mine : 1u; nx = cnt > 0u ? cnt : 1u;
}
__device__ __forceinline__ void xcd_barrier(unsigned* bar, unsigned x, volatile LAS unsigned* st) {
    asm volatile("s_waitcnt vmcnt(0)" ::: "memory");
    __syncthreads();
    if (threadIdx.x == 0) {
        __builtin_amdgcn_s_waitcnt(0);
        unsigned nloc = st[0], nx = st[1];
        if (nloc == 0u) { xcd_barrier_complete(bar, x, nloc, nx); st[0] = nloc; st[1] = nx; }
        const unsigned old = xb_add(&bar[XB_XSUB(x)], 1u);
        const unsigned gen = old / nloc;
        if (old + 1u == (gen + 1u) * nloc) {
            __builtin_amdgcn_fence(__ATOMIC_RELEASE, "agent");
            asm volatile("s_waitcnt vmcnt(0)" ::: "memory");
            const unsigned og = xb_add(&bar[XB_TOP], 1u);
            const unsigned tg = og / nx;
            if (og + 1u == (tg + 1u) * nx) xb_add(&bar[XB_TOPGEN], 1u);
            else XB_SPIN(xb_ld(&bar[XB_TOPGEN]) == tg, bar);
            __builtin_amdgcn_fence(__ATOMIC_ACQUIRE, "agent");
            xb_add(&bar[XB_XGEN(x)], 1u);
            asm volatile("s_waitcnt vmcnt(0)" ::: "memory");
        } else {
            XB_SPIN(xb_ld(&bar[XB_XGEN(x)]) == gen, bar);
            __builtin_amdgcn_fence(__ATOMIC_ACQUIRE, "agent");
            asm volatile("s_waitcnt vmcnt(0)" ::: "memory");
        }
    }
    __syncthreads();
}

struct Args { const float* in[20]; float* out; unsigned char* ws; int ph_lo, ph_hi; };
constexpr int N_PHASES = 16;
constexpr int LDS_MISC = RING_BYTES + 4096;
#define REPS(k) for (int rep_ = 0; rep_ < (((PROBE_MASK >> (k)) & 1) ? PROBE_REP : 1); ++rep_)

__global__ void __launch_bounds__(NT, 2) fwd(Args args) {
    extern __shared__ __attribute__((aligned(16))) unsigned char lds_raw[];
    LAS unsigned char* lds = (LAS unsigned char*)lds_raw;
    const int G = gridDim.x, bx = blockIdx.x;
    const int vcu = (G % 8 == 0) ? (bx % 8) * (G / 8) + bx / 8 : bx;
    const int NGW = G * NWAVES;
    unsigned char* ws = args.ws;
    const int lo = args.ph_lo, hi = args.ph_hi;
    volatile LAS unsigned* bst = (volatile LAS unsigned*)(lds + LDS_MISC);
#if MK_N_LAUNCHES == 1
    cg::grid_group grid = cg::this_grid();
    unsigned* const barw = (unsigned*)(ws + WS_CTL);
    if (threadIdx.x < 8) bst[threadIdx.x] = 0u;
    __syncthreads();
    const unsigned bxcc = xcd_barrier_post(barw, bst);
#ifdef PROBE_T
#define PROBE_T_MARK(k) do { if ((k) == PROBE_T && bx == 0 && threadIdx.x == 0) *(volatile LAS unsigned long long*)(lds + LDS_MISC + 136) = wall_clock64(); } while (0)
    if (bx == 0 && threadIdx.x == 0) { *(volatile LAS unsigned long long*)(lds + LDS_MISC + 128) = wall_clock64(); *(volatile LAS unsigned long long*)(lds + LDS_MISC + 136) = 0ull; }
#else
#define PROBE_T_MARK(k) do { } while (0)
#endif
#define SEAM(k) do { if (lo <= (k) && (k) + 1 < hi) { if (hi > 1000) grid.sync(); else REPS(15) xcd_barrier(barw, bxcc, bst); } PROBE_T_MARK(k); } while (0)
#else
#define SEAM(k) do { } while (0)
#endif
#ifndef PH_MASK
#define PH_MASK 0xFFFFF
#endif
#define IN(k) (((PH_MASK >> (k)) & 1) && lo <= (k) && (k) < hi)
#define PH_IDS int tid = threadIdx.x; asm volatile("" : "+v"(tid)); const int lane = tid & 63; const int wave = __builtin_amdgcn_readfirstlane(tid >> 6); const int gw = vcu * NWAVES + wave; (void)lane; (void)gw;
#if MK_N_LAUNCHES == 1
#define PEER_GROUP int grp, mem, nmem; { const unsigned nl_ = bst[0], nx_ = bst[1]; if (nx_ == 8u && nl_ > 0u) { grp = (int)bst[3]; mem = (int)bst[2]; nmem = (int)nl_; } else { grp = bx & 7; mem = bx >> 3; nmem = G >> 3; } } \
    grp = __builtin_amdgcn_readfirstlane(grp); mem = __builtin_amdgcn_readfirstlane(mem); nmem = __builtin_amdgcn_readfirstlane(nmem);
#else
#define PEER_GROUP const int grp = bx & 7, mem = bx >> 3, nmem = G >> 3;
#endif
#define ABUF ((bf16*)(ws + WS_A))
#define PROJ ((bf16*)(ws + WS_PROJ))
#define UST ((bf16*)(ws + WS_US))
#define DECAY ((float*)(ws + WS_DECAY))

    if (IN(0)) REPS(0) { PH_IDS p0_prologue(args.in, ws, lds, vcu, G, tid, rep_ == 0 ? 7 : PROBE_SUB); }
    SEAM(0);
    if (IN(1)) {
        { pg8::Gemm g{ABUF, (const bf16*)(ws + WS_WIN), M, IN_COLS, 512}; pg8::StaticOrder S; S.init(M, IN_COLS, G, bx, ((PROBE_MASK >> 1) & 1) ? PROBE_REP : 1);
          pg8::EpiBf16I8 E{PROJ, IN_COLS, (const float*)(ws + WS_PART1), (const float*)(ws + WS_WIN + 4 * MiB)};
          pg8::gemm_phase_i8<pg8::EpiBf16I8, pg8::StaticOrder, PG8_ALIGN, PG8_SP2>(lds, g, S, E); }
        { pg8::Gemm g{(const bf16*)(ws + WS_MEMN), (const bf16*)(ws + WS_WKV), MROWS, 1024, 1024}; pg8::StaticOrder S; S.init(MROWS, 1024, G, bx); pg8::EpiTile E{(bf16*)(ws + WS_KB), 4, 1};
          pg8::gemm_phase<pg8::EpiTile, pg8::StaticOrder, PG8_ALIGN, PG8_SP2>(lds, g, S, E); }
        { pg8::Gemm g{(const bf16*)(ws + WS_WKV) + (size_t)1024 * 1024, (const bf16*)(ws + WS_MEMN), 1024, MROWS, 1024}; pg8::StaticOrder S; S.init(1024, MROWS, G, (bx + 128) % G); pg8::EpiTile E{(bf16*)(ws + WS_VT), 1, 4};
          pg8::gemm_phase<pg8::EpiTile, pg8::StaticOrder, PG8_ALIGN, PG8_SP2>(lds, g, S, E); }
    }
    SEAM(1);
    if (IN(2)) REPS(2) { PH_IDS
        for (int m = 4 * gw; m < M; m += 4 * NGW) conv_tokens4(PROJ, args.in[4], args.in[5], ABUF, m, lane);
        for (int u = vcu; u < BATCH * 128; u += G) h1_unit(u >> 7, u & 127, PROJ, args.in[6], UST, DECAY, lds, tid);
    }
    SEAM(2);
    if (IN(3)) REPS(3) { PH_IDS const bool dry = rep_ + 1 < ((((PROBE_MASK >> 3) & 1) ? PROBE_REP : 1)); h2_scan(UST, DECAY, gw, NGW, lane, dry ? (long)((WS_X + 288 * MiB - WS_US) / 4) : 0L); }
    SEAM(3);
    if (IN(4)) REPS(4) { PH_IDS for (int u = vcu; u < BATCH * 128 * 4; u += G) h3_unit(u >> 9, (u >> 2) & 127, u & 3, PROJ, args.in[6], UST, args.in[7], ABUF, lds, tid); }
    SEAM(4);
    if (IN(5)) {
        pg8::Gemm g{ABUF, (const bf16*)(ws + WS_WOUT), M, 1024, 1024}; pg8::StaticOrder S; S.init(M, 1024, G, bx, ((PROBE_MASK >> 5) & 1) ? PROBE_REP : 1);
        pg8::EpiResid E{args.in[0], nullptr, (bf16*)(ws + WS_B1), (float*)(ws + WS_PART1), 0};
        pg8::gemm_phase<pg8::EpiResid, pg8::StaticOrder, PG8_ALIGN, PG8_SP2>(lds, g, S, E);
    }
    SEAM(5);
    if (IN(6)) {
        pg8::Gemm g{(const bf16*)(ws + WS_B1), (const bf16*)(ws + WS_WQ), M, 1024, 1024}; pg8::StaticOrder S; S.init(M, 1024, G, bx, ((PROBE_MASK >> 6) & 1) ? PROBE_REP : 1);
        pg8::EpiScaleBf16 E{(bf16*)(ws + WS_Q), 1024, (const float*)(ws + WS_PART1), QSCALE};
        pg8::gemm_phase<pg8::EpiScaleBf16, pg8::StaticOrder, PG8_ALIGN, PG8_SP2>(lds, g, S, E);
    }
    SEAM(6);
    if (IN(7)) REPS(7) { PH_IDS for (int u = vcu; u < 1024; u += G) attn_unit(u >> 8, (u >> 6) & 3, u & 63, (const bf16*)(ws + WS_Q), (const bf16*)(ws + WS_KB), (const bf16*)(ws + WS_VT), ABUF, lds, tid); }
    SEAM(7);
    if (IN(8)) {
        pg8::Gemm g{ABUF, (const bf16*)(ws + WS_WO), M, 1024, 1024}; pg8::StaticOrder S; S.init(M, 1024, G, bx, ((PROBE_MASK >> 8) & 1) ? PROBE_REP : 1);
        pg8::EpiResid E{nullptr, (const bf16*)(ws + WS_B1), (bf16*)(ws + WS_X2S), (float*)(ws + WS_PART2), M};
        pg8::gemm_phase<pg8::EpiResid, pg8::StaticOrder, PG8_ALIGN, PG8_SP2>(lds, g, S, E);
    }
    SEAM(8);
    if (IN(9)) REPS(9) { PH_IDS
        const int sel = rep_ == 0 ? 7 : PROBE_SUB;
        if (sel & 4) for (int m = gw; m < M; m += 4 * NGW) quant_x2_rows4((const bf16*)(ws + WS_X2S), ws + WS_XQ, (float*)(ws + WS_XSCALE), m, NGW, lane);
        if (sel & 2) for (int e = gw; e < NEXP; e += 2 * NGW) {
            const int e2 = e + NGW < NEXP ? e + NGW : e;
            quant_rows4(args.in[17], args.in[18], args.in[14], ws + WS_PDOWN, ws + WS_PUP, e, e2, lane, (float*)(ws + WS_DSCALE), (float*)(ws + WS_USCALE)); }
    }
    SEAM(9);
    if (IN(10)) {
        pg8::Gemm g{(const bf16*)(ws + WS_XQ), (const bf16*)(ws + WS_WEFF), M, 2048, 512, 64}; pg8::StaticOrder S; S.init(M, 2048, G, bx, ((PROBE_MASK >> 10) & 1) ? PROBE_REP : 1);
        pg8::EpiScoresI8 E{(unsigned short*)(ws + WS_SCT), M, (const float*)(ws + WS_PART2), (const float*)(ws + WS_XSCALE), (const float*)(ws + WS_WEFF + 2 * MiB)};
        pg8::gemm_phase_i8<pg8::EpiScoresI8, pg8::StaticOrder, PG8_ALIGN, PG8_SP2>(lds, g, S, E);
    }
    SEAM(10);
    if (IN(11)) REPS(11) { PH_IDS
        for (int task = gw; task < 8 * (M / 64); task += NGW) { const int head = task & 7, token = (task >> 3) * 64 + lane;
            peer_topk_task((const unsigned short*)(ws + WS_SCT), head, token, (unsigned short*)(ws + WS_IDX), (float*)(ws + WS_GATE), lds + tid * 32); }
    }
    SEAM(11);
    if (IN(12)) REPS(12) { PH_IDS PEER_GROUP
        peer_down_phase(ws + WS_XQ, ws + WS_PDOWN, (const unsigned short*)(ws + WS_IDX), (unsigned*)(ws + WS_SCT), grp, mem * NWAVES + wave, nmem * NWAVES, lane);
    }
    SEAM(12);
    if (IN(13)) REPS(13) { PH_IDS
        for (int t = gw; t < M; t += 4 * NGW) peer_combine_tokens4((const unsigned*)(ws + WS_SCT), (const float*)(ws + WS_PART2), (const unsigned short*)(ws + WS_IDX), (const float*)(ws + WS_DSCALE), (const float*)(ws + WS_USCALE),
                                                                          (const float*)(ws + WS_XSCALE), (const float*)(ws + WS_GATE), (unsigned*)(ws + WS_WPK), (float*)(ws + WS_CORR), t, NGW, lane); }
    SEAM(13);
    if (IN(14)) REPS(14) { PH_IDS PEER_GROUP
        const bool dry = rep_ + 1 < ((((PROBE_MASK >> 14) & 1) ? PROBE_REP : 1));
        peer_up_phase((bf16*)(ws + WS_X2S), (bf16*)(ws + (dry ? WS_PROBE_DUMMY : WS_X2S)), ws + WS_PUP, (const unsigned short*)(ws + WS_IDX), (const unsigned*)(ws + WS_WPK), (const float*)(ws + WS_CORR), grp, mem * NWAVES + wave, nmem * NWAVES, lane, lds + wave * 16384); }
    SEAM(14);
    if (IN(15)) REPS(15) { PH_IDS final_norm_phase((const bf16*)(ws + WS_X2S), args.out, args.in[19], gw, NGW, lane); }
#ifdef PROBE_T
    if (bx == 0 && threadIdx.x == 0) { const unsigned long long t0_ = *(volatile LAS unsigned long long*)(lds + LDS_MISC + 128), t1_ = *(volatile LAS unsigned long long*)(lds + LDS_MISC + 136);
        if (t1_ > t0_) { const unsigned long long te_ = wall_clock64(); while (wall_clock64() - te_ < (t1_ - t0_) * PROBE_T_MUL) __builtin_amdgcn_s_sleep(8); } }
#endif
#undef IN
#undef SEAM
}

extern "C" void kernel_launch(void* const* d_in, const int* in_sizes, int n_in, void* d_out, int out_size, void* d_ws, size_t ws_size, hipStream_t stream) {
    static int grid = 0;
    if (grid == 0) {
        if (n_in != 20 || in_sizes[0] != M * D || out_size != M * D || ws_size < WS_END) { fprintf(stderr, "kernel_launch: unexpected shapes: n_in %d in0 %d out %d ws %zu (need %zu)\n", n_in, n_in > 0 ? in_sizes[0] : -1, out_size, ws_size, (size_t)WS_END); grid = -1; return; }
        int dev = 0, cus = 0, per_cu = 0;
        if (hipGetDevice(&dev) != hipSuccess || hipDeviceGetAttribute(&cus, hipDeviceAttributeMultiprocessorCount, dev) != hipSuccess) { grid = -1; return; }
        if (hipFuncSetAttribute((const void*)fwd, hipFuncAttributeMaxDynamicSharedMemorySize, LDS_BYTES) != hipSuccess) { fprintf(stderr, "kernel_launch: hipFuncSetAttribute failed\n"); grid = -1; return; }
        if (hipOccupancyMaxActiveBlocksPerMultiprocessor(&per_cu, (const void*)fwd, NT, LDS_BYTES) != hipSuccess || per_cu < 1) { fprintf(stderr, "kernel_launch: occupancy query says %d blocks per CU\n", per_cu); (void)hipGetLastError(); grid = -1; return; }
        grid = cus;
    }
    if (grid < 0) return;
    Args a{};
    for (int i = 0; i < 20; ++i) a.in[i] = (const float*)d_in[i];
    a.out = (float*)d_out; a.ws = (unsigned char*)d_ws;
#if MK_N_LAUNCHES == 1
    if (hipMemsetAsync((char*)d_ws + WS_CTL, 0, CTL_ZERO_BYTES, stream) != hipSuccess) { fprintf(stderr, "kernel_launch: hipMemsetAsync failed\n"); return; }
    a.ph_lo = 0; a.ph_hi = N_PHASES;
    void* kargs[] = {&a};
    hipError_t e = hipLaunchCooperativeKernel((const void*)fwd, dim3(grid), dim3(NT), kargs, LDS_BYTES, stream);
    if (e != hipSuccess) fprintf(stderr, "kernel_launch: cooperative launch failed: %s (grid %d)\n", hipGetErrorString(e), grid);
#else
    for (int ph = 0; ph < N_PHASES; ++ph) { a.ph_lo = ph; a.ph_hi = ph + 1; hipLaunchKernelGGL(fwd, dim3(grid), dim3(NT), LDS_BYTES, stream, a); }
#endif
}
```

```cpp
#include <hip/hip_runtime.h>
#include <hip/hip_cooperative_groups.h>
#include <cstdio>
#include <cstdint>
namespace cg = cooperative_groups;

#ifndef MK_N_LAUNCHES
#define MK_N_LAUNCHES 1
#endif

#ifndef PROBE_REP
#define PROBE_REP 1
#endif
#ifndef PROBE_MASK
#define PROBE_MASK 0
#endif

#ifndef PROBE_T_MUL
#define PROBE_T_MUL 1
#endif
#ifndef PROBE_SUB
#define PROBE_SUB 7
#endif

namespace pg8 {
#define PG8_LAS __attribute__((address_space(3)))
typedef unsigned short bf16_t;
typedef short bf16x8 __attribute__((ext_vector_type(8)));
typedef float f32x4 __attribute__((ext_vector_type(4)));
typedef unsigned u32x4 __attribute__((ext_vector_type(4)));
constexpr int BM = 256, BK = 64, HALF = 128, HTB = HALF * BK * 2  , STAGE_BYTES = 8 * HTB, NXCD = 8, WGM = 8;

__host__ __device__ __forceinline__ int lds_byte(int r, int c) { const int st = (r >> 4) * 2 + (c >> 5), rr = r & 15, cc = c & 31, ob = rr * 64 + cc * 2; return st * 1024 + (ob ^ (((ob >> 9) & 1) << 5)); }
__host__ __device__ __forceinline__ void stage_rc(int b, int& R, int& C) { const int st = b / 1024, sb = b % 1024, swz = sb ^ (((sb >> 9) & 1) << 5); R = (st >> 1) * 16 + swz / 64; C = (st & 1) * 32 + (swz % 64) / 2; }
__host__ __device__ __forceinline__ int perm32(int rho) { const int n = rho >> 4, i = rho & 15; return 8 * (i >> 2) + 4 * n + (i & 3); }

struct Unit { int pm, pn; };
struct Gemm { const bf16_t* A; const bf16_t* Bt; int M, N, K; int lda; };

struct StaticOrder {
    int nM, nN, nwg, G, c, rep;
    __host__ __device__ void init(int M, int N, int G_, int c_, int rep_ = 1) { nM = M / BM; nN = N / BM; nwg = nM * nN; G = G_; c = c_; rep = rep_; }
    __host__ __device__ bool next(int i, Unit& u) const {
        long L = (long)i * G + c; if (L >= (long)nwg * rep) return false; L %= nwg;
        int wgid = (int)L; { const int q = nwg / NXCD, r = nwg % NXCD, xcd = wgid % NXCD, off = wgid / NXCD; wgid = (xcd < r ? xcd * (q + 1) : r * (q + 1) + (xcd - r) * q) + off; }
        const int nig = WGM * nN, gid = wgid / nig, fm = gid * WGM, gsz = (nM - fm) < WGM ? (nM - fm) : WGM;
        u.pm = fm + ((wgid % nig) % gsz); u.pn = (wgid % nig) / gsz; return true;
    }
    __device__ __forceinline__ void a_ready(const Unit&) const {}
    __device__ __forceinline__ void done(const Unit&) const {}
};


__device__ __forceinline__ float sum_x16_x32(float v) {
    { const auto r = __builtin_amdgcn_permlane16_swap(__float_as_uint(v), __float_as_uint(v), false, false); v = __uint_as_float(r[0]) + __uint_as_float(r[1]); }
    { const auto r = __builtin_amdgcn_permlane32_swap(__float_as_uint(v), __float_as_uint(v), false, false); v = __uint_as_float(r[0]) + __uint_as_float(r[1]); }
    return v;
}
__device__ __forceinline__ unsigned cvt_pk_bf16(float lo, float hi) { unsigned r; asm volatile("v_cvt_pk_bf16_f32 %0, %1, %2" : "=v"(r) : "v"(lo), "v"(hi)); return r; }

struct EpiBf16 {
    static constexpr bool PERM = true, AFTER_DRAIN = false;
    bf16_t* O; int ldc;
    __device__ __forceinline__ void operator()(const f32x4 (&acc)[2][2][4][2], const Unit& u, int wr, int wc, int fr, int fq) const {
        const int row0 = u.pm * BM + wr * 64 + fr, col0 = u.pn * BM + wc * 32 + 8 * fq;
#pragma unroll
        for (int ai = 0; ai < 2; ++ai)
#pragma unroll
            for (int m = 0; m < 4; ++m) { bf16_t* rowp = O + (size_t)(row0 + ai * HALF + m * 16) * ldc + col0;
#pragma unroll
                for (int bj = 0; bj < 2; ++bj) { const f32x4 v0 = acc[ai][bj][m][0], v1 = acc[ai][bj][m][1];
                    u32x4 w; w.x = cvt_pk_bf16(v0[0], v0[1]); w.y = cvt_pk_bf16(v0[2], v0[3]); w.z = cvt_pk_bf16(v1[0], v1[1]); w.w = cvt_pk_bf16(v1[2], v1[3]);
                    *(u32x4*)(rowp + bj * HALF) = w; } }
    }
};
struct EpiTile {
    static constexpr bool PERM = true, AFTER_DRAIN = false;
    bf16_t* O; int sm, sn;
    __device__ __forceinline__ void operator()(const f32x4 (&acc)[2][2][4][2], const Unit& u, int wr, int wc, int fr, int fq) const {
        bf16_t* base = O + (size_t)(u.pm * sm + u.pn * sn) * 65536 + (size_t)(wr * 64 + fr) * 256 + wc * 32 + 8 * fq;
#pragma unroll
        for (int ai = 0; ai < 2; ++ai)
#pragma unroll
            for (int m = 0; m < 4; ++m) { bf16_t* rowp = base + (size_t)(ai * HALF + m * 16) * 256;
#pragma unroll
                for (int bj = 0; bj < 2; ++bj) { const f32x4 v0 = acc[ai][bj][m][0], v1 = acc[ai][bj][m][1];
                    u32x4 w; w.x = cvt_pk_bf16(v0[0], v0[1]); w.y = cvt_pk_bf16(v0[2], v0[3]); w.z = cvt_pk_bf16(v1[0], v1[1]); w.w = cvt_pk_bf16(v1[2], v1[3]);
                    *(u32x4*)(rowp + bj * HALF) = w; } }
    }
};
struct EpiResid {
    static constexpr bool PERM = true, AFTER_DRAIN = false;
    const float* basef; const bf16_t* baseb; bf16_t* xb; float* part; int sliced;
    __device__ __forceinline__ void operator()(const f32x4 (&acc)[2][2][4][2], const Unit& u, int wr, int wc, int fr, int fq) const {
        const int row0 = u.pm * BM + wr * 64 + fr, col0 = u.pn * BM + wc * 32 + 8 * fq;
#pragma unroll
        for (int ai = 0; ai < 2; ++ai)
#pragma unroll
            for (int m = 0; m < 4; ++m) { const int row = row0 + ai * HALF + m * 16; const size_t off = (size_t)row * 1024 + col0; float s = 0.f;
#pragma unroll
                for (int bj = 0; bj < 2; ++bj) {
                    f32x4 b0, b1;
                    if (basef) { b0 = *(const f32x4*)(basef + off + bj * HALF); b1 = *(const f32x4*)(basef + off + bj * HALF + 4); }
                    else { const u32x4 bw = *(const u32x4*)(baseb + off + bj * HALF);
                        b0 = (f32x4){__uint_as_float(bw.x << 16), __uint_as_float(bw.x & 0xffff0000u), __uint_as_float(bw.y << 16), __uint_as_float(bw.y & 0xffff0000u)};
                        b1 = (f32x4){__uint_as_float(bw.z << 16), __uint_as_float(bw.z & 0xffff0000u), __uint_as_float(bw.w << 16), __uint_as_float(bw.w & 0xffff0000u)}; }
                    const f32x4 v0 = acc[ai][bj][m][0] + b0, v1 = acc[ai][bj][m][1] + b1;
                    u32x4 w; w.x = cvt_pk_bf16(v0[0], v0[1]); w.y = cvt_pk_bf16(v0[2], v0[3]); w.z = cvt_pk_bf16(v1[0], v1[1]); w.w = cvt_pk_bf16(v1[2], v1[3]);
                    if (sliced) { const int col = col0 + bj * HALF; *(u32x4*)(xb + ((size_t)(col >> 6) * sliced + row) * 64 + (col & 63)) = w; }
                    else *(u32x4*)(xb + off + bj * HALF) = w;
                    s += (v0[0] * v0[0] + v0[1] * v0[1]) + (v0[2] * v0[2] + v0[3] * v0[3]) + (v1[0] * v1[0] + v1[1] * v1[1]) + (v1[2] * v1[2] + v1[3] * v1[3]); }
                s = sum_x16_x32(s);
                if (fq == 0) part[(size_t)row * 16 + u.pn * 4 + wc] = s; }
    }
};
__device__ __forceinline__ float row_rstd(const float* part, int row, int fq) {
    const f32x4 p = *(const f32x4*)(part + (size_t)row * 16 + 4 * fq); float t = (p[0] + p[1]) + (p[2] + p[3]);
    t = sum_x16_x32(t);
    return rsqrtf(t * (1.0f / 1024.0f) + 1e-6f);
}
struct EpiScaleBf16 {
    static constexpr bool PERM = true, AFTER_DRAIN = false;
    bf16_t* O; int ldc; const float* part; float scale;
    __device__ __forceinline__ void operator()(const f32x4 (&acc)[2][2][4][2], const Unit& u, int wr, int wc, int fr, int fq) const {
        const int row0 = u.pm * BM + wr * 64 + fr, col0 = u.pn * BM + wc * 32 + 8 * fq;
#pragma unroll
        for (int ai = 0; ai < 2; ++ai)
#pragma unroll
            for (int m = 0; m < 4; ++m) { const int row = row0 + ai * HALF + m * 16; const float sc = row_rstd(part, row, fq) * scale; bf16_t* rowp = O + (size_t)row * ldc + col0;
#pragma unroll
                for (int bj = 0; bj < 2; ++bj) { const f32x4 v0 = acc[ai][bj][m][0] * sc, v1 = acc[ai][bj][m][1] * sc;
                    u32x4 w; w.x = cvt_pk_bf16(v0[0], v0[1]); w.y = cvt_pk_bf16(v0[2], v0[3]); w.z = cvt_pk_bf16(v1[0], v1[1]); w.w = cvt_pk_bf16(v1[2], v1[3]);
                    *(u32x4*)(rowp + bj * HALF) = w; } }
    }
};
typedef int i32x4e __attribute__((ext_vector_type(4)));
typedef _Float16 f16x4 __attribute__((ext_vector_type(4)));
typedef _Float16 f16x2 __attribute__((ext_vector_type(2)));
struct EpiScoresT {
    static constexpr bool PERM = false, AFTER_DRAIN = false;
    unsigned short* scT; int Mtok; const float* part;
    __device__ __forceinline__ void operator()(const f32x4 (&acc)[2][2][4][2], const Unit& u, int wr, int wc, int fr, int fq) const {
        const int row0 = u.pm * BM + wr * 64 + fr;
#pragma unroll
        for (int ai = 0; ai < 2; ++ai)
#pragma unroll
            for (int m = 0; m < 4; ++m) { const int row = row0 + ai * HALF + m * 16; const float sc = row_rstd(part, row, fq);
#pragma unroll
                for (int bj = 0; bj < 2; ++bj)
#pragma unroll
                    for (int n = 0; n < 2; ++n) { const int hp = 2 * u.pn + bj, kq = 8 * wc + 4 * n + fq; const f32x4 v = acc[ai][bj][m][n] * sc;
                        *(f16x4*)(scT + ((size_t)(hp * 32 + kq) * Mtok + row) * 4) = (f16x4){(_Float16)v[0], (_Float16)v[1], (_Float16)v[2], (_Float16)v[3]}; } }
    }
};
struct EpiBf16I8 {
    static constexpr bool PERM = true, AFTER_DRAIN = false;
    bf16_t* O; int ldc; const float* rowscale; const float* colscale;
    __device__ __forceinline__ void operator()(const i32x4e (&acc)[2][2][4][2], const Unit& u, int wr, int wc, int fr, int fq) const {
        const int row0 = u.pm * BM + wr * 64 + fr, col0 = u.pn * BM + wc * 32 + 8 * fq;
        f32x4 cs[2][2];
#pragma unroll
        for (int bj = 0; bj < 2; ++bj) { cs[bj][0] = *(const f32x4*)(colscale + col0 + bj * HALF); cs[bj][1] = *(const f32x4*)(colscale + col0 + bj * HALF + 4); }
        float rs[2][4];
#pragma unroll
        for (int ai = 0; ai < 2; ++ai)
#pragma unroll
            for (int m = 0; m < 4; ++m) rs[ai][m] = rowscale[row0 + ai * HALF + m * 16];
#pragma unroll
        for (int ai = 0; ai < 2; ++ai)
#pragma unroll
            for (int m = 0; m < 4; ++m) { bf16_t* rowp = O + (size_t)(row0 + ai * HALF + m * 16) * ldc + col0; const float r_ = rs[ai][m];
#pragma unroll
                for (int bj = 0; bj < 2; ++bj) { const i32x4e a0 = acc[ai][bj][m][0], a1 = acc[ai][bj][m][1]; const f32x4 c0 = cs[bj][0] * r_, c1 = cs[bj][1] * r_;
                    u32x4 w; w.x = cvt_pk_bf16((float)a0[0] * c0[0], (float)a0[1] * c0[1]); w.y = cvt_pk_bf16((float)a0[2] * c0[2], (float)a0[3] * c0[3]);
                    w.z = cvt_pk_bf16((float)a1[0] * c1[0], (float)a1[1] * c1[1]); w.w = cvt_pk_bf16((float)a1[2] * c1[2], (float)a1[3] * c1[3]);
                    *(u32x4*)(rowp + bj * HALF) = w; } }
    }
};
struct EpiScoresI8 {
    static constexpr bool PERM = false, AFTER_DRAIN = false;
    unsigned short* scT; int Mtok; const float* part; const float* xscale; const float* wscale;
    __device__ __forceinline__ void operator()(const i32x4e (&acc)[2][2][4][2], const Unit& u, int wr, int wc, int fr, int fq) const {
        const int row0 = u.pm * BM + wr * 64 + fr, colb = u.pn * BM + wc * 32 + 4 * fq;
        f32x4 ws[2][2];
#pragma unroll
        for (int bj = 0; bj < 2; ++bj)
#pragma unroll
            for (int n = 0; n < 2; ++n) ws[bj][n] = *(const f32x4*)(wscale + colb + bj * HALF + 16 * n);
#pragma unroll
        for (int ai = 0; ai < 2; ++ai)
#pragma unroll
            for (int m = 0; m < 4; ++m) { const int row = row0 + ai * HALF + m * 16; const float sc = row_rstd(part, row, fq) * xscale[row];
#pragma unroll
                for (int bj = 0; bj < 2; ++bj)
#pragma unroll
                    for (int n = 0; n < 2; ++n) { const int hp = 2 * u.pn + bj, kq = 8 * wc + 4 * n + fq; const i32x4e a = acc[ai][bj][m][n]; const f32x4 w = ws[bj][n];
                        *(f16x4*)(scT + ((size_t)(hp * 32 + kq) * Mtok + row) * 4) = (f16x4){(_Float16)((float)a[0] * sc * w[0]), (_Float16)((float)a[1] * sc * w[1]), (_Float16)((float)a[2] * sc * w[2]), (_Float16)((float)a[3] * sc * w[3])}; } }
    }
};

template <class Epi, class Sched, bool ALIGN_EPI = false, bool SP2 = false>
__device__ __forceinline__ void gemm_phase(PG8_LAS unsigned char* lds, const Gemm g, const Sched& S, const Epi& E, const int tid) {
    const int wid = __builtin_amdgcn_readfirstlane(tid >> 6), lane = tid & 63, wr = wid >> 2, wc = wid & 3, fr = lane & 15, fq = lane >> 4;
    const int K = g.K, nt = K / BK;
    const int ldA = g.lda ? g.lda : K;
    unsigned voffA[2], voffB[2];
#pragma unroll
    for (int i = 0; i < 2; ++i) { int R, C; stage_rc(tid * 16 + i * 8192, R, C); const int Rb = Epi::PERM ? ((R & ~31) + perm32(R & 31)) : R;
        voffA[i] = (unsigned)(R * ldA + C) * 2u; voffB[i] = (unsigned)(Rb * K + C) * 2u; }
    const size_t kstepA = g.lda ? (size_t)g.M * 64 * 2 : (size_t)(BK * 2);
    const size_t hstepA = (size_t)HALF * ldA * 2, tstepA = 2 * hstepA;
    const size_t kstep = (size_t)(BK * 2);
    const size_t hstep = (size_t)HALF * K * 2;
    const size_t tstep = 2 * hstep;
    const unsigned ldsw = (unsigned)wid * 1024u;
    const int aoff = lds_byte(wr * 64 + fr, fq * 8), boff = lds_byte(wc * 32 + fr, fq * 8);
#define PG8_SA(b, h) (((b) * 2 + (h)) * HTB)
#define PG8_SB(b, h) ((4 + (b) * 2 + (h)) * HTB)
#define PG8_STAGE(bufoff, gbase, voff) do { _Pragma("unroll") for (int _i = 0; _i < 2; ++_i) \
        __builtin_amdgcn_global_load_lds((const unsigned*)((const char*)(gbase) + (voff)[_i]), (PG8_LAS unsigned*)(lds + (bufoff) + ldsw + _i * 8192), 16, 0, 0); } while (0)
#define PG8_LDA(dst, b, h) do { _Pragma("unroll") for (int m = 0; m < 4; ++m) _Pragma("unroll") for (int k = 0; k < 2; ++k) dst[m][k] = *(const PG8_LAS bf16x8*)(lds + PG8_SA(b, h) + aoff + m * 2048 + k * 1024); } while (0)
#define PG8_LDB(dst, b, h) do { _Pragma("unroll") for (int n = 0; n < 2; ++n) _Pragma("unroll") for (int k = 0; k < 2; ++k) dst[n][k] = *(const PG8_LAS bf16x8*)(lds + PG8_SB(b, h) + boff + n * 2048 + k * 1024); } while (0)
#define PG8_MMA(ai, bj, At, Bt) do { __builtin_amdgcn_s_setprio(1); _Pragma("unroll") for (int m = 0; m < 4; ++m) _Pragma("unroll") for (int n = 0; n < 2; ++n) _Pragma("unroll") for (int k = 0; k < 2; ++k) \
        acc[ai][bj][m][n] = __builtin_amdgcn_mfma_f32_16x16x32_bf16(Bt[n][k], At[m][k], acc[ai][bj][m][n], 0, 0, 0); __builtin_amdgcn_s_setprio(0); } while (0)
#define PG8_WAIT_V(n) asm volatile("s_waitcnt vmcnt(" #n ")" ::: "memory")
#define PG8_WAIT_L(n) asm volatile("s_waitcnt lgkmcnt(" #n ")" ::: "memory")
#define PG8_BAR __builtin_amdgcn_s_barrier()
#define PG8_SCHED __builtin_amdgcn_sched_barrier(0)
    Unit cur, nxt; int ui = 0;
    if (!S.next(0, cur)) return;
    f32x4 acc[2][2][4][2];
#pragma unroll
    for (int a = 0; a < 2; ++a)
#pragma unroll
        for (int b = 0; b < 2; ++b)
#pragma unroll
            for (int m = 0; m < 4; ++m)
#pragma unroll
                for (int n = 0; n < 2; ++n) acc[a][b][m][n] = (f32x4){0.f, 0.f, 0.f, 0.f};
    bf16x8 At[4][2], B0[2][2], B1[2][2];
    const char* cA = (const char*)g.A + (size_t)cur.pm * tstepA; const char* cB = (const char*)g.Bt + (size_t)cur.pn * tstep;
    S.a_ready(cur);
    if constexpr (SP2) {
        PG8_STAGE(PG8_SB(0, 0), cB, voffB); PG8_STAGE(PG8_SB(0, 1), cB + hstep, voffB); PG8_STAGE(PG8_SA(0, 0), cA, voffA); PG8_STAGE(PG8_SA(0, 1), cA + hstepA, voffA);
        if (wr == 1) PG8_BAR;
        PG8_WAIT_V(2); PG8_BAR;
        PG8_STAGE(PG8_SB(1, 0), cB + kstep, voffB); PG8_STAGE(PG8_SA(1, 0), cA + kstepA, voffA); PG8_STAGE(PG8_SB(1, 1), cB + hstep + kstep, voffB);
        PG8_WAIT_V(6); PG8_BAR;
    } else {
        PG8_STAGE(PG8_SB(0, 0), cB, voffB); PG8_STAGE(PG8_SA(0, 0), cA, voffA); PG8_STAGE(PG8_SB(0, 1), cB + hstep, voffB); PG8_STAGE(PG8_SA(0, 1), cA + hstepA, voffA);
        if (wr == 1) PG8_BAR;
        PG8_WAIT_V(4); PG8_BAR;
        PG8_STAGE(PG8_SB(1, 0), cB + kstep, voffB); PG8_STAGE(PG8_SA(1, 0), cA + kstepA, voffA); PG8_STAGE(PG8_SB(1, 1), cB + hstep + kstep, voffB);
        PG8_WAIT_V(6); PG8_BAR;
    }
    for (;;) {
        const bool has_next = S.next(ui + 1, nxt);
        const char* nA = has_next ? (const char*)g.A + (size_t)nxt.pm * tstepA : cA; const char* nB = has_next ? (const char*)g.Bt + (size_t)nxt.pn * tstep : cB;
        for (int t = 0; t < nt; t += 2) {
            const bool last = (t == nt - 2);
            const char* a1 = cA + (size_t)(t + 1) * kstepA;
            const char* a2 = last ? nA : cA + (size_t)(t + 2) * kstepA; const char* b2 = last ? nB : cB + (size_t)(t + 2) * kstep;
            const char* a3 = a2 + kstepA; const char* b3 = b2 + kstep;
            if (last && has_next) S.a_ready(nxt);
            if constexpr (SP2) {
            PG8_LDB(B0, 0, 0); PG8_LDB(B1, 0, 1); PG8_SCHED; PG8_LDA(At, 0, 0); PG8_STAGE(PG8_SA(1, 1), a1 + hstepA, voffA);
            PG8_WAIT_V(8); PG8_WAIT_L(0); PG8_BAR; PG8_MMA(0, 0, At, B0); PG8_MMA(0, 1, At, B1); PG8_BAR; PG8_SCHED;
            PG8_LDA(At, 0, 1); PG8_STAGE(PG8_SB(0, 0), b2, voffB); PG8_STAGE(PG8_SB(0, 1), b2 + hstep, voffB); PG8_STAGE(PG8_SA(0, 0), a2, voffA);
            PG8_WAIT_V(8); PG8_WAIT_L(0); PG8_BAR; PG8_MMA(1, 0, At, B0); PG8_MMA(1, 1, At, B1); PG8_BAR; PG8_SCHED;
            PG8_LDB(B0, 1, 0); PG8_LDB(B1, 1, 1); PG8_SCHED; PG8_LDA(At, 1, 0); PG8_STAGE(PG8_SA(0, 1), a2 + hstepA, voffA);
            PG8_WAIT_V(8); PG8_WAIT_L(0); PG8_BAR; PG8_MMA(0, 0, At, B0); PG8_MMA(0, 1, At, B1); PG8_BAR; PG8_SCHED;
            PG8_LDA(At, 1, 1); PG8_STAGE(PG8_SB(1, 0), b3, voffB); PG8_STAGE(PG8_SB(1, 1), b3 + hstep, voffB); PG8_STAGE(PG8_SA(1, 0), a3, voffA);
            PG8_WAIT_V(8); PG8_WAIT_L(0); PG8_BAR; PG8_MMA(1, 0, At, B0); PG8_MMA(1, 1, At, B1); PG8_BAR; PG8_SCHED;
            } else {
            PG8_LDB(B0, 0, 0); PG8_SCHED; PG8_LDA(At, 0, 0); PG8_STAGE(PG8_SA(1, 1), a1 + hstepA, voffA);
            PG8_WAIT_L(8); PG8_BAR; PG8_WAIT_L(0); PG8_MMA(0, 0, At, B0); PG8_BAR; PG8_SCHED;
            PG8_LDB(B1, 0, 1); PG8_STAGE(PG8_SB(0, 0), b2, voffB);
            PG8_BAR; PG8_WAIT_L(0); PG8_MMA(0, 1, At, B1); PG8_BAR;
            PG8_LDA(At, 0, 1); PG8_STAGE(PG8_SA(0, 0), a2, voffA);
            PG8_BAR; PG8_WAIT_L(0); PG8_MMA(1, 0, At, B0); PG8_BAR; PG8_SCHED;
            PG8_STAGE(PG8_SB(0, 1), b2 + hstep, voffB);
            PG8_WAIT_V(6); PG8_BAR; PG8_MMA(1, 1, At, B1); PG8_BAR;
            PG8_LDB(B0, 1, 0); PG8_SCHED; PG8_LDA(At, 1, 0); PG8_STAGE(PG8_SA(0, 1), a2 + hstepA, voffA);
            PG8_WAIT_L(8); PG8_BAR; PG8_WAIT_L(0); PG8_MMA(0, 0, At, B0); PG8_BAR; PG8_SCHED;
            PG8_LDB(B1, 1, 1); PG8_STAGE(PG8_SB(1, 0), b3, voffB);
            PG8_BAR; PG8_WAIT_L(0); PG8_MMA(0, 1, At, B1); PG8_BAR;
            PG8_LDA(At, 1, 1); PG8_STAGE(PG8_SA(1, 0), a3, voffA);
            PG8_BAR; PG8_WAIT_L(0); PG8_MMA(1, 0, At, B0); PG8_BAR; PG8_SCHED;
            PG8_STAGE(PG8_SB(1, 1), b3 + hstep, voffB);
            PG8_WAIT_V(6); PG8_BAR; PG8_MMA(1, 1, At, B1); PG8_BAR;
            }
        }
        if constexpr (ALIGN_EPI) { if (wr == 0) PG8_BAR; }
        if constexpr (!Epi::AFTER_DRAIN) { E(acc, cur, wr, wc, fr, fq); S.done(cur); }
        if (!has_next) break;
#pragma unroll
        for (int a = 0; a < 2; ++a)
#pragma unroll
            for (int b = 0; b < 2; ++b)
#pragma unroll
                for (int m = 0; m < 4; ++m)
#pragma unroll
                    for (int n = 0; n < 2; ++n) acc[a][b][m][n] = (f32x4){0.f, 0.f, 0.f, 0.f};
        cur = nxt; cA = nA; cB = nB; ++ui;
        if constexpr (ALIGN_EPI) { if (wr == 1) PG8_BAR; }
    }
    PG8_WAIT_V(0);
    if constexpr (!ALIGN_EPI) { if (wr == 0) PG8_BAR; }
    PG8_BAR;
    if constexpr (Epi::AFTER_DRAIN) { E.fused(acc, cur, wr, wc, fr, fq, lds, wid, lane); S.done(cur); }
#undef PG8_SA
#undef PG8_SB
#undef PG8_STAGE
#undef PG8_LDA
#undef PG8_LDB
#undef PG8_MMA
#undef PG8_WAIT_V
#undef PG8_WAIT_L
#undef PG8_BAR
#undef PG8_SCHED
}
typedef int i32x4 __attribute__((ext_vector_type(4)));
template <class Epi, class Sched, bool ALIGN_EPI = false, bool SP2 = false>
__device__ __forceinline__ void gemm_phase_i8(PG8_LAS unsigned char* lds, const Gemm g, const Sched& S, const Epi& E, const int tid) {
    const int wid = __builtin_amdgcn_readfirstlane(tid >> 6), lane = tid & 63, wr = wid >> 2, wc = wid & 3, fr = lane & 15, fq = lane >> 4;
    const int K = g.K, nt = K / BK;
    const int ldA = g.lda ? g.lda : K;
    unsigned voffA[2], voffB[2];
#pragma unroll
    for (int i = 0; i < 2; ++i) { int R, C; stage_rc(tid * 16 + i * 8192, R, C); const int Rb = Epi::PERM ? ((R & ~31) + perm32(R & 31)) : R;
        voffA[i] = (unsigned)(R * ldA + C) * 2u; voffB[i] = (unsigned)(Rb * K + C) * 2u; }
    const size_t kstepA = g.lda ? (size_t)g.M * 64 * 2 : (size_t)(BK * 2);
    const size_t hstepA = (size_t)HALF * ldA * 2, tstepA = 2 * hstepA;
    const size_t kstep = (size_t)(BK * 2);
    const size_t hstep = (size_t)HALF * K * 2;
    const size_t tstep = 2 * hstep;
    const unsigned ldsw = (unsigned)wid * 1024u;
    const int aoff = lds_byte(wr * 64 + fr, fq * 8), boff = lds_byte(wc * 32 + fr, fq * 8);
#define PG8_SA(b, h) (((b) * 2 + (h)) * HTB)
#define PG8_SB(b, h) ((4 + (b) * 2 + (h)) * HTB)
#define PG8_STAGE(bufoff, gbase, voff) do { _Pragma("unroll") for (int _i = 0; _i < 2; ++_i) \
        __builtin_amdgcn_global_load_lds((const unsigned*)((const char*)(gbase) + (voff)[_i]), (PG8_LAS unsigned*)(lds + (bufoff) + ldsw + _i * 8192), 16, 0, 0); } while (0)
#define PG8_LDA(dst, b, h) do { _Pragma("unroll") for (int m = 0; m < 4; ++m) _Pragma("unroll") for (int k = 0; k < 2; ++k) dst[m][k] = *(const PG8_LAS bf16x8*)(lds + PG8_SA(b, h) + aoff + m * 2048 + k * 1024); } while (0)
#define PG8_LDB(dst, b, h) do { _Pragma("unroll") for (int n = 0; n < 2; ++n) _Pragma("unroll") for (int k = 0; k < 2; ++k) dst[n][k] = *(const PG8_LAS bf16x8*)(lds + PG8_SB(b, h) + boff + n * 2048 + k * 1024); } while (0)
#define PG8_MMA(ai, bj, At, Bt) do { __builtin_amdgcn_s_setprio(1); _Pragma("unroll") for (int m = 0; m < 4; ++m) _Pragma("unroll") for (int n = 0; n < 2; ++n) _Pragma("unroll") for (int k = 0; k < 2; ++k) \
        acc[ai][bj][m][n] = __builtin_amdgcn_mfma_i32_16x16x64_i8(__builtin_bit_cast(i32x4, Bt[n][k]), __builtin_bit_cast(i32x4, At[m][k]), acc[ai][bj][m][n], 0, 0, 0); __builtin_amdgcn_s_setprio(0); } while (0)
#define PG8_WAIT_V(n) asm volatile("s_waitcnt vmcnt(" #n ")" ::: "memory")
#define PG8_WAIT_L(n) asm volatile("s_waitcnt lgkmcnt(" #n ")" ::: "memory")
#define PG8_BAR __builtin_amdgcn_s_barrier()
#define PG8_SCHED __builtin_amdgcn_sched_barrier(0)
    Unit cur, nxt; int ui = 0;
    if (!S.next(0, cur)) return;
    i32x4 acc[2][2][4][2];
#pragma unroll
    for (int a = 0; a < 2; ++a)
#pragma unroll
        for (int b = 0; b < 2; ++b)
#pragma unroll
            for (int m = 0; m < 4; ++m)
#pragma unroll
                for (int n = 0; n < 2; ++n) acc[a][b][m][n] = (i32x4){0, 0, 0, 0};
    bf16x8 At[4][2], B0[2][2], B1[2][2];
    const char* cA = (const char*)g.A + (size_t)cur.pm * tstepA; const char* cB = (const char*)g.Bt + (size_t)cur.pn * tstep;
    S.a_ready(cur);
    if constexpr (SP2) {
        PG8_STAGE(PG8_SB(0, 0), cB, voffB); PG8_STAGE(PG8_SB(0, 1), cB + hstep, voffB); PG8_STAGE(PG8_SA(0, 0), cA, voffA); PG8_STAGE(PG8_SA(0, 1), cA + hstepA, voffA);
        if (wr == 1) PG8_BAR;
        PG8_WAIT_V(2); PG8_BAR;
        PG8_STAGE(PG8_SB(1, 0), cB + kstep, voffB); PG8_STAGE(PG8_SA(1, 0), cA + kstepA, voffA); PG8_STAGE(PG8_SB(1, 1), cB + hstep + kstep, voffB);
        PG8_WAIT_V(6); PG8_BAR;
    } else {
        PG8_STAGE(PG8_SB(0, 0), cB, voffB); PG8_STAGE(PG8_SA(0, 0), cA, voffA); PG8_STAGE(PG8_SB(0, 1), cB + hstep, voffB); PG8_STAGE(PG8_SA(0, 1), cA + hstepA, voffA);
        if (wr == 1) PG8_BAR;
        PG8_WAIT_V(4); PG8_BAR;
        PG8_STAGE(PG8_SB(1, 0), cB + kstep, voffB); PG8_STAGE(PG8_SA(1, 0), cA + kstepA, voffA); PG8_STAGE(PG8_SB(1, 1), cB + hstep + kstep, voffB);
        PG8_WAIT_V(6); PG8_BAR;
    }
    for (;;) {
        const bool has_next = S.next(ui + 1, nxt);
        const char* nA = has_next ? (const char*)g.A + (size_t)nxt.pm * tstepA : cA; const char* nB = has_next ? (const char*)g.Bt + (size_t)nxt.pn * tstep : cB;
        for (int t = 0; t < nt; t += 2) {
            const bool last = (t == nt - 2);
            const char* a1 = cA + (size_t)(t + 1) * kstepA;
            const char* a2 = last ? nA : cA + (size_t)(t + 2) * kstepA; const char* b2 = last ? nB : cB + (size_t)(t + 2) * kstep;
            const char* a3 = a2 + kstepA; const char* b3 = b2 + kstep;
            if (last && has_next) S.a_ready(nxt);
            if constexpr (SP2) {
            PG8_LDB(B0, 0, 0); PG8_LDB(B1, 0, 1); PG8_SCHED; PG8_LDA(At, 0, 0); PG8_STAGE(PG8_SA(1, 1), a1 + hstepA, voffA);
            PG8_WAIT_V(8); PG8_WAIT_L(0); PG8_BAR; PG8_MMA(0, 0, At, B0); PG8_MMA(0, 1, At, B1); PG8_BAR; PG8_SCHED;
            PG8_LDA(At, 0, 1); PG8_STAGE(PG8_SB(0, 0), b2, voffB); PG8_STAGE(PG8_SB(0, 1), b2 + hstep, voffB); PG8_STAGE(PG8_SA(0, 0), a2, voffA);
            PG8_WAIT_V(8); PG8_WAIT_L(0); PG8_BAR; PG8_MMA(1, 0, At, B0); PG8_MMA(1, 1, At, B1); PG8_BAR; PG8_SCHED;
            PG8_LDB(B0, 1, 0); PG8_LDB(B1, 1, 1); PG8_SCHED; PG8_LDA(At, 1, 0); PG8_STAGE(PG8_SA(0, 1), a2 + hstepA, voffA);
            PG8_WAIT_V(8); PG8_WAIT_L(0); PG8_BAR; PG8_MMA(0, 0, At, B0); PG8_MMA(0, 1, At, B1); PG8_BAR; PG8_SCHED;
            PG8_LDA(At, 1, 1); PG8_STAGE(PG8_SB(1, 0), b3, voffB); PG8_STAGE(PG8_SB(1, 1), b3 + hstep, voffB); PG8_STAGE(PG8_SA(1, 0), a3, voffA);
            PG8_WAIT_V(8); PG8_WAIT_L(0); PG8_BAR; PG8_MMA(1, 0, At, B0); PG8_MMA(1, 1, At, B1); PG8_BAR; PG8_SCHED;
            } else {
            PG8_LDB(B0, 0, 0); PG8_SCHED; PG8_LDA(At, 0, 0); PG8_STAGE(PG8_SA(1, 1), a1 + hstepA, voffA);
            PG8_WAIT_L(8); PG8_BAR; PG8_WAIT_L(0); PG8_MMA(0, 0, At, B0); PG8_BAR; PG8_SCHED;
            PG8_LDB(B1, 0, 1); PG8_STAGE(PG8_SB(0, 0), b2, voffB);
            PG8_BAR; PG8_WAIT_L(0); PG8_MMA(0, 1, At, B1); PG8_BAR;
            PG8_LDA(At, 0, 1); PG8_STAGE(PG8_SA(0, 0), a2, voffA);
            PG8_BAR; PG8_WAIT_L(0); PG8_MMA(1, 0, At, B0); PG8_BAR; PG8_SCHED;
            PG8_STAGE(PG8_SB(0, 1), b2 + hstep, voffB);
            PG8_WAIT_V(6); PG8_BAR; PG8_MMA(1, 1, At, B1); PG8_BAR;
            PG8_LDB(B0, 1, 0); PG8_SCHED; PG8_LDA(At, 1, 0); PG8_STAGE(PG8_SA(0, 1), a2 + hstepA, voffA);
            PG8_WAIT_L(8); PG8_BAR; PG8_WAIT_L(0); PG8_MMA(0, 0, At, B0); PG8_BAR; PG8_SCHED;
            PG8_LDB(B1, 1, 1); PG8_STAGE(PG8_SB(1, 0), b3, voffB);
            PG8_BAR; PG8_WAIT_L(0); PG8_MMA(0, 1, At, B1); PG8_BAR;
            PG8_LDA(At, 1, 1); PG8_STAGE(PG8_SA(1, 0), a3, voffA);
            PG8_BAR; PG8_WAIT_L(0); PG8_MMA(1, 0, At, B0); PG8_BAR; PG8_SCHED;
            PG8_STAGE(PG8_SB(1, 1), b3 + hstep, voffB);
            PG8_WAIT_V(6); PG8_BAR; PG8_MMA(1, 1, At, B1); PG8_BAR;
            }
        }
        if constexpr (ALIGN_EPI) { if (wr == 0) PG8_BAR; }
        if constexpr (!Epi::AFTER_DRAIN) { E(acc, cur, wr, wc, fr, fq); S.done(cur); }
        if (!has_next) break;
#pragma unroll
        for (int a = 0; a < 2; ++a)
#pragma unroll
            for (int b = 0; b < 2; ++b)
#pragma unroll
                for (int m = 0; m < 4; ++m)
#pragma unroll
                    for (int n = 0; n < 2; ++n) acc[a][b][m][n] = (i32x4){0, 0, 0, 0};
        cur = nxt; cA = nA; cB = nB; ++ui;
        if constexpr (ALIGN_EPI) { if (wr == 1) PG8_BAR; }
    }
    PG8_WAIT_V(0);
    if constexpr (!ALIGN_EPI) { if (wr == 0) PG8_BAR; }
    PG8_BAR;
    if constexpr (Epi::AFTER_DRAIN) { E.fused(acc, cur, wr, wc, fr, fq, lds, wid, lane); S.done(cur); }
#undef PG8_SA
#undef PG8_SB
#undef PG8_STAGE
#undef PG8_LDA
#undef PG8_LDB
#undef PG8_MMA
#undef PG8_WAIT_V
#undef PG8_WAIT_L
#undef PG8_BAR
#undef PG8_SCHED
}
}

#ifndef PG8_SP2
#define PG8_SP2 true
#endif
#ifndef PG8_ALIGN
#define PG8_ALIGN true
#endif

constexpr int NWAVES = 8, NT = NWAVES * 64;
constexpr int BATCH = 4, SEQ = 8192, D = 1024, M = BATCH * SEQ;
constexpr int IN_COLS = 3584;
constexpr int NMEM = 256, MROWS = BATCH * NMEM;
constexpr int NEXP = 16384;
constexpr float EPS = 1e-6f;
constexpr float QSCALE = 0.0625f * 1.4426950408889634f;

constexpr size_t MiB = 1u << 20;
constexpr size_t WS_CTL = 0, CTL_ZERO_BYTES = 64 * 1024;
constexpr size_t WS_PART1 = 1 * MiB;
constexpr size_t WS_DECAY = 5 * MiB;
constexpr size_t WS_WIN = 6 * MiB, WS_WOUT = 13 * MiB, WS_WQ = 15 * MiB, WS_WKV = 17 * MiB, WS_WO = 21 * MiB, WS_WEFF = 23 * MiB;
constexpr size_t WS_MEMN = 27 * MiB, WS_KB = 29 * MiB, WS_VT = 31 * MiB;
constexpr size_t WS_PUP = 1 * MiB;
constexpr size_t WS_A = 33 * MiB;
constexpr size_t WS_X = 97 * MiB;
constexpr size_t WS_PROJ = WS_X, WS_US = WS_X + 224 * MiB;
constexpr size_t WS_B1 = WS_X, WS_Q = WS_X + 64 * MiB;
constexpr size_t WS_X2S = WS_X + 64 * MiB;
constexpr size_t WS_SCT = WS_X + 128 * MiB;
constexpr size_t WS_PDOWN = WS_X;
constexpr size_t WS_IDX = WS_A, WS_GATE = WS_A + 8 * MiB;
constexpr size_t WS_PART2 = WS_X + 384 * MiB;
constexpr size_t WS_SSQ = WS_PART2 + 2 * MiB;
constexpr size_t WS_DSCALE = WS_SSQ + 2 * MiB, WS_USCALE = WS_DSCALE + 65536;
constexpr size_t WS_XSCALE = WS_USCALE + 65536, WS_CORR = WS_XSCALE + 131072;
constexpr size_t WS_WPK = WS_A + 56 * MiB;
constexpr size_t WS_XQ = WS_A + 24 * MiB;
constexpr size_t WS_END = WS_CORR + 131072;

constexpr size_t WS_PROBE_DUMMY = WS_X + 256 * MiB;
constexpr int RING_BYTES = 131072, LDS_BYTES = 147456;

#define LAS __attribute__((address_space(3)))
typedef unsigned short bf16;
typedef float f32x2 __attribute__((ext_vector_type(2)));
typedef float f32x4 __attribute__((ext_vector_type(4)));
typedef float f32x16 __attribute__((ext_vector_type(16)));
typedef short bf16x8 __attribute__((ext_vector_type(8)));
typedef unsigned v4u __attribute__((ext_vector_type(4)));
typedef unsigned v2u __attribute__((ext_vector_type(2)));
typedef __bf16 bf16x2_t __attribute__((ext_vector_type(2)));
#define LDS_WAIT() asm volatile("s_waitcnt lgkmcnt(0)" ::: "memory")
__device__ __forceinline__ float bf2f(unsigned short b) { return __uint_as_float(((unsigned)b) << 16); }
__device__ __forceinline__ float bflo(unsigned u) { return __uint_as_float(u << 16); }
__device__ __forceinline__ float bfhi(unsigned u) { return __uint_as_float(u & 0xffff0000u); }
__device__ __forceinline__ unsigned pk2(float lo, float hi) { f32x2 v = {lo, hi}; bf16x2_t b = __builtin_convertvector(v, bf16x2_t); return __builtin_bit_cast(unsigned, b); }
__device__ __forceinline__ float xlane_dpp_b1(float v) { return __uint_as_float((unsigned)__builtin_amdgcn_update_dpp(0, (int)__float_as_uint(v), 0xB1, 0xF, 0xF, false)); }
__device__ __forceinline__ float xlane_dpp_4e(float v) { return __uint_as_float((unsigned)__builtin_amdgcn_update_dpp(0, (int)__float_as_uint(v), 0x4E, 0xF, 0xF, false)); }
__device__ __forceinline__ float xlane_dpp_x4(float v) { int r = __builtin_amdgcn_update_dpp(0, (int)__float_as_uint(v), 0x12C, 0xF, 0x5, false); r = __builtin_amdgcn_update_dpp(r, (int)__float_as_uint(v), 0x124, 0xF, 0xA, false); return __uint_as_float((unsigned)r); }
__device__ __forceinline__ float xlane_dpp_x8(float v) { return __uint_as_float((unsigned)__builtin_amdgcn_update_dpp(0, (int)__float_as_uint(v), 0x128, 0xF, 0xF, false)); }
__device__ __forceinline__ float xlane_x16(float v) { const auto r = __builtin_amdgcn_permlane16_swap(__float_as_uint(v), __float_as_uint(v), false, false); return __uint_as_float((__builtin_amdgcn_mbcnt_lo(~0u, 0u) + __builtin_amdgcn_mbcnt_hi(~0u, 0u)) & 16 ? r[0] : r[1]); }
__device__ __forceinline__ float xlane_x32(float v) { const auto r = __builtin_amdgcn_permlane32_swap(__float_as_uint(v), __float_as_uint(v), false, false); return __uint_as_float((__builtin_amdgcn_mbcnt_lo(~0u, 0u) + __builtin_amdgcn_mbcnt_hi(~0u, 0u)) & 32 ? r[0] : r[1]); }
__device__ __forceinline__ float wave_sum(float v) {
    v += xlane_dpp_b1(v); v += xlane_dpp_4e(v); v += xlane_dpp_x4(v); v += xlane_dpp_x8(v);
    { const auto r = __builtin_amdgcn_permlane16_swap(__float_as_uint(v), __float_as_uint(v), false, false); v = __uint_as_float(r[0]) + __uint_as_float(r[1]); }
    { const auto r = __builtin_amdgcn_permlane32_swap(__float_as_uint(v), __float_as_uint(v), false, false); v = __uint_as_float(r[0]) + __uint_as_float(r[1]); }
    return v;
}
__device__ __forceinline__ float wave_max(float v) {
    v = fmaxf(v, xlane_dpp_b1(v)); v = fmaxf(v, xlane_dpp_4e(v)); v = fmaxf(v, xlane_dpp_x4(v)); v = fmaxf(v, xlane_dpp_x8(v));
    { const auto r = __builtin_amdgcn_permlane16_swap(__float_as_uint(v), __float_as_uint(v), false, false); v = fmaxf(__uint_as_float(r[0]), __uint_as_float(r[1])); }
    { const auto r = __builtin_amdgcn_permlane32_swap(__float_as_uint(v), __float_as_uint(v), false, false); v = fmaxf(__uint_as_float(r[0]), __uint_as_float(r[1])); }
    return v;
}
__device__ __forceinline__ float sigmoidf_(float x) { return __builtin_amdgcn_rcpf(1.0f + __expf(-x)); }
__device__ __forceinline__ int kappa(int rho) { return (rho & 0x13) | ((rho & 4) << 1) | ((rho & 8) >> 1); }
__device__ __forceinline__ bf16x8 as_bf16x8(v4u v) { return __builtin_bit_cast(bf16x8, v); }

__device__ __forceinline__ void p0_transpose_item(const float* W, int K, int N, bf16* WT, const float* gain, LAS float* scr, int item, int lane) {
    const int nblk = N / 32, kb = item / nblk, nb = item % nblk, k0 = 64 * kb, n0 = 32 * nb;
    float wv[32];
#pragma unroll
    for (int i = 0; i < 32; ++i) { const int kk = 2 * i + (lane >> 5); wv[i] = W[(size_t)(k0 + kk) * N + n0 + (lane & 31)]; }
#pragma unroll
    for (int i = 0; i < 32; ++i) { const int kk = 2 * i + (lane >> 5); const float g = gain ? gain[k0 + kk] : 1.0f; scr[kk * 33 + (lane & 31)] = wv[i] * g; }
    LDS_WAIT();
    const int c = lane & 7;
#pragma unroll
    for (int j = 0; j < 4; ++j) { const int n = (lane >> 3) + 8 * j; const LAS float* s = scr + (8 * c) * 33 + n;
        v4u o; o.x = pk2(s[0 * 33], s[1 * 33]); o.y = pk2(s[2 * 33], s[3 * 33]); o.z = pk2(s[4 * 33], s[5 * 33]); o.w = pk2(s[6 * 33], s[7 * 33]);
        *(v4u*)(WT + (size_t)(n0 + n) * K + k0 + 8 * c) = o; }
    LDS_WAIT();
}
__device__ __forceinline__ void rms_row_to_bf16(const float* xrow, const float* gain, bf16* orow, int lane) {
    const f32x4* xr = (const f32x4*)xrow + lane; f32x4 v[4]; float s = 0.f;
#pragma unroll
    for (int j = 0; j < 4; ++j) { v[j] = xr[64 * j]; s += (v[j].x * v[j].x + v[j].y * v[j].y) + (v[j].z * v[j].z + v[j].w * v[j].w); }
    const float r = rsqrtf(wave_sum(s) * (1.0f / 1024.0f) + EPS);
    const f32x4* gr = (const f32x4*)gain + lane; unsigned long long* o8 = (unsigned long long*)orow + lane;
#pragma unroll
    for (int j = 0; j < 4; ++j) { const f32x4 g = gr[64 * j]; o8[64 * j] = (unsigned long long)pk2(v[j].x * r * g.x, v[j].y * r * g.y) | ((unsigned long long)pk2(v[j].z * r * g.z, v[j].w * r * g.w) << 32); }
}
__device__ __forceinline__ void p0_weffq_wg(const float* wquery, const float* subkeys, const float* gain, signed char* WQ, float* wscale, int item, LAS unsigned char* lds, int tid) {
    const int hp = item >> 4, kg = item & 15, lane = tid & 63, wave = tid >> 6;
    LAS f32x4* sk = (LAS f32x4*)lds;
    LAS float* am_s = (LAS float*)(lds + 8192);
    if (tid < 256) sk[tid] = ((const f32x4*)(subkeys + (size_t)(hp * 128 + kg * 8) * 128))[tid];
    __syncthreads();
    float acc[2][8];
#pragma unroll
    for (int ph = 0; ph < 2; ++ph) { const int k = (ph * 8 + wave) * 64 + lane; const f32x4* wrow = (const f32x4*)(wquery + (size_t)k * 2048 + hp * 128);
#pragma unroll
        for (int i = 0; i < 8; ++i) acc[ph][i] = 0.f;
#pragma unroll 4
        for (int d4 = 0; d4 < 32; ++d4) { const f32x4 w = wrow[d4];
#pragma unroll
            for (int key = 0; key < 8; ++key) { const f32x4 sv = sk[key * 32 + d4]; acc[ph][key] += (w.x * sv.x + w.y * sv.y) + (w.z * sv.z + w.w * sv.w); } }
        const float g = gain[k];
#pragma unroll
        for (int i = 0; i < 8; ++i) acc[ph][i] *= g; }
#pragma unroll
    for (int key = 0; key < 8; ++key) { const float m = wave_max(fmaxf(fabsf(acc[0][key]), fabsf(acc[1][key]))); if (lane == 0) am_s[wave * 8 + key] = m; }
    __syncthreads();
    if (tid < 8) { float m = 0.f;
#pragma unroll
        for (int w8 = 0; w8 < 8; ++w8) m = fmaxf(m, am_s[w8 * 8 + tid]);
        am_s[256 + tid] = m; wscale[hp * 128 + kg * 8 + tid] = m * (1.0f / 127.0f); }
    __syncthreads();
#pragma unroll
    for (int key = 0; key < 8; ++key) { const float am = am_s[256 + key]; const float inv = am > 0.f ? 127.0f / am : 0.f;
#pragma unroll
        for (int ph = 0; ph < 2; ++ph) WQ[(size_t)(hp * 128 + kg * 8 + key) * 1024 + (ph * 8 + wave) * 64 + lane] = (signed char)(int)rintf(acc[ph][key] * inv); }
    __syncthreads();
}
__device__ __forceinline__ void p0_win_wg(const float* W, signed char* WQ, float* wscale, int item, LAS unsigned char* lds, int tid) {
    const int n0 = 14 * item, nl = tid & 15, kr = tid >> 4; const bool act = nl < 14;
    LAS float* am_s = (LAS float*)lds;
    LAS unsigned char* tile = lds + 4096;
    float wv[32]; float am = 0.f;
#pragma unroll
    for (int i = 0; i < 32; ++i) wv[i] = act ? W[(size_t)(kr + 32 * i) * IN_COLS + n0 + nl] : 0.f;
#pragma unroll
    for (int i = 0; i < 32; ++i) am = fmaxf(am, fabsf(wv[i]));
    am_s[kr * 16 + nl] = am;
    __syncthreads();
    if (tid < 16) { float m = 0.f;
#pragma unroll
        for (int r = 0; r < 32; ++r) m = fmaxf(m, am_s[r * 16 + tid]);
        am_s[512 + tid] = m; if (tid < 14) wscale[n0 + tid] = m * (1.0f / 127.0f); }
    __syncthreads();
    { const float amx = am_s[512 + nl]; const float inv = amx > 0.f ? 127.0f / amx : 0.f;
      if (act) {
#pragma unroll
          for (int i = 0; i < 32; ++i) tile[nl * 1028 + kr + 32 * i] = (unsigned char)((int)rintf(wv[i] * inv) & 255); } }
    __syncthreads();
    for (int p = tid; p < 14 * 64; p += NT) { const int n = p >> 6, c = p & 63; const LAS unsigned* src = (const LAS unsigned*)(tile + n * 1028 + 16 * c);
        *(v4u*)(WQ + (size_t)(n0 + n) * 1024 + 16 * c) = (v4u){src[0], src[1], src[2], src[3]}; }
    __syncthreads();
}
__device__ __forceinline__ void p0_prologue(const float* const* in, unsigned char* ws, LAS unsigned char* lds, int vcu, int G, int tid, int sel) {
    const int lane = tid & 63, wave = __builtin_amdgcn_readfirstlane(tid >> 6), gw = vcu * NWAVES + wave, NGW = G * NWAVES;
    LAS float* scr = (LAS float*)(lds + wave * 16384);
    const float *x = in[0], *mem = in[1], *mix_norm_w = in[2], *w_in = in[3], *w_out = in[8], *xattn_norm_w = in[9], *mem_norm_w = in[10], *wq = in[11], *wkv = in[12], *wo = in[13],
                *ffn_norm_w = in[14], *w_query = in[15], *sub_keys = in[16];
    if (sel & 1) for (int it = vcu; it < 256; it += G) { p0_weffq_wg(w_query, sub_keys, ffn_norm_w, (signed char*)(ws + WS_WEFF), (float*)(ws + WS_WEFF + 2 * MiB), it, lds, tid);
                                                          p0_win_wg(w_in, (signed char*)(ws + WS_WIN), (float*)(ws + WS_WIN + 4 * MiB), it, lds, tid); }
    constexpr int I_SQ = 16 * 32, I_KV = 16 * 64;
    constexpr int NITEMS = 3 * I_SQ + I_KV;
    if (sel & 2) for (int it = gw; it < NITEMS; it += NGW) {
        int r = it;
        if (r < I_SQ) { p0_transpose_item(w_out, 1024, 1024, (bf16*)(ws + WS_WOUT), nullptr, scr, r, lane); continue; } r -= I_SQ;
        if (r < I_SQ) { p0_transpose_item(wq, 1024, 1024, (bf16*)(ws + WS_WQ), xattn_norm_w, scr, r, lane); continue; } r -= I_SQ;
        if (r < I_KV) { p0_transpose_item(wkv, 1024, 2048, (bf16*)(ws + WS_WKV), nullptr, scr, r, lane); continue; } r -= I_KV;
        p0_transpose_item(wo, 1024, 1024, (bf16*)(ws + WS_WO), nullptr, scr, r, lane);
    }
    if (!(sel & 4)) return;
    for (int m = gw; m < MROWS; m += NGW) rms_row_to_bf16(mem + (size_t)m * D, mem_norm_w, (bf16*)(ws + WS_MEMN) + (size_t)m * D, lane);
    for (int m = gw; m < M; m += 4 * NGW) {
        f32x4 v[4][4]; float ss[4], am[4];
#pragma unroll
        for (int r = 0; r < 4; ++r) { const int mr = m + r * NGW < M ? m + r * NGW : m; const f32x4* xr = (const f32x4*)(x + (size_t)mr * D) + lane;
#pragma unroll
            for (int j = 0; j < 4; ++j) v[r][j] = xr[64 * j]; }
        const f32x4* gr = (const f32x4*)mix_norm_w + lane;
#pragma unroll
        for (int r = 0; r < 4; ++r) { float s = 0.f, a_ = 0.f;
#pragma unroll
            for (int j = 0; j < 4; ++j) { s += (v[r][j].x * v[r][j].x + v[r][j].y * v[r][j].y) + (v[r][j].z * v[r][j].z + v[r][j].w * v[r][j].w); v[r][j] = v[r][j] * gr[64 * j];
                a_ = fmaxf(a_, fmaxf(fmaxf(fabsf(v[r][j].x), fabsf(v[r][j].y)), fmaxf(fabsf(v[r][j].z), fabsf(v[r][j].w)))); }
            ss[r] = s; am[r] = a_; }
#pragma unroll
        for (int r = 0; r < 4; ++r) { ss[r] = wave_sum(ss[r]); am[r] = wave_max(am[r]); }
#pragma unroll
        for (int r = 0; r < 4; ++r) { if (m + r * NGW < M) { const int mr = m + r * NGW; const float rr = rsqrtf(ss[r] * (1.0f / 1024.0f) + EPS), inv = am[r] > 0.f ? 127.0f / am[r] : 0.f;
            unsigned* o4 = (unsigned*)(ws + WS_A + (size_t)mr * D) + lane;
#pragma unroll
            for (int j = 0; j < 4; ++j) { const int q0 = (int)rintf(v[r][j].x * inv), q1 = (int)rintf(v[r][j].y * inv), q2 = (int)rintf(v[r][j].z * inv), q3 = (int)rintf(v[r][j].w * inv);
                o4[64 * j] = (unsigned)(q0 & 255) | ((unsigned)(q1 & 255) << 8) | ((unsigned)(q2 & 255) << 16) | ((unsigned)(q3 & 255) << 24); }
            if (lane == 0) ((float*)(ws + WS_PART1))[mr] = rr * am[r] * (1.0f / 127.0f); } }
    }
}

struct ConvIn { v4u bg, cg0, vv0, cg1, vv1, cg2, vv2; };
__device__ __forceinline__ ConvIn conv_load(const bf16* P, int m, int lane) {
    const int t = m & (SEQ - 1), c0 = 8 * lane; const bf16* row = P + (size_t)m * IN_COLS; ConvIn in;
    in.bg = *(const v4u*)(row + c0); in.cg0 = *(const v4u*)(row + 512 + c0); in.vv0 = *(const v4u*)(row + 1024 + c0);
    in.cg1 = (v4u){0, 0, 0, 0}; in.vv1 = (v4u){0, 0, 0, 0}; in.cg2 = (v4u){0, 0, 0, 0}; in.vv2 = (v4u){0, 0, 0, 0};
    if (t >= 1) { in.cg1 = *(const v4u*)(row - IN_COLS + 512 + c0); in.vv1 = *(const v4u*)(row - IN_COLS + 1024 + c0); }
    if (t >= 2) { in.cg2 = *(const v4u*)(row - 2 * IN_COLS + 512 + c0); in.vv2 = *(const v4u*)(row - 2 * IN_COLS + 1024 + c0); }
    return in;
}
__device__ __forceinline__ void conv_finish(const ConvIn& in, const float* conv_w, const float* conv_norm_w, bf16* Y, int m, int lane) {
    const int c0 = 8 * lane;
    const f32x4 w0a = *(const f32x4*)(conv_w + c0), w0b = *(const f32x4*)(conv_w + c0 + 4);
    const f32x4 w1a = *(const f32x4*)(conv_w + 512 + c0), w1b = *(const f32x4*)(conv_w + 512 + c0 + 4);
    const f32x4 w2a = *(const f32x4*)(conv_w + 1024 + c0), w2b = *(const f32x4*)(conv_w + 1024 + c0 + 4);
    float y[8]; float ss = 0.f;
#pragma unroll
    for (int q = 0; q < 4; ++q) {
#pragma unroll
        for (int hl = 0; hl < 2; ++hl) { const int e = 2 * q + hl;
            const float b = hl ? bfhi(in.bg[q]) : bflo(in.bg[q]);
            const float u0 = (hl ? bfhi(in.cg0[q]) : bflo(in.cg0[q])) * (hl ? bfhi(in.vv0[q]) : bflo(in.vv0[q]));
            const float u1 = (hl ? bfhi(in.cg1[q]) : bflo(in.cg1[q])) * (hl ? bfhi(in.vv1[q]) : bflo(in.vv1[q]));
            const float u2 = (hl ? bfhi(in.cg2[q]) : bflo(in.cg2[q])) * (hl ? bfhi(in.vv2[q]) : bflo(in.vv2[q]));
            const float wt0 = e < 4 ? w0a[e & 3] : w0b[e & 3], wt1 = e < 4 ? w1a[e & 3] : w1b[e & 3], wt2 = e < 4 ? w2a[e & 3] : w2b[e & 3];
            y[e] = b * (wt0 * u2 + wt1 * u1 + wt2 * u0); ss += y[e] * y[e]; } }
    const float r = rsqrtf(wave_sum(ss) * (1.0f / 512.0f) + EPS);
    const f32x4 ga = *(const f32x4*)(conv_norm_w + c0), gb = *(const f32x4*)(conv_norm_w + c0 + 4);
    v4u o; o.x = pk2(y[0] * r * ga[0], y[1] * r * ga[1]); o.y = pk2(y[2] * r * ga[2], y[3] * r * ga[3]); o.z = pk2(y[4] * r * gb[0], y[5] * r * gb[1]); o.w = pk2(y[6] * r * gb[2], y[7] * r * gb[3]);
    *(v4u*)(Y + (size_t)m * 1024 + c0) = o;
}
__device__ __forceinline__ void conv_tokens4(const bf16* P, const float* conv_w, const float* conv_norm_w, bf16* Y, int m0, int lane) {
    const int t0 = m0 & (SEQ - 1), c0 = 8 * lane; const bf16* row = P + (size_t)m0 * IN_COLS;
    v4u bg[4], cg[6], vv[6];
#pragma unroll
    for (int r = 0; r < 4; ++r) bg[r] = *(const v4u*)(row + (size_t)r * IN_COLS + c0);
#pragma unroll
    for (int r = 0; r < 6; ++r) { if (t0 + r - 2 >= 0) { cg[r] = *(const v4u*)(row + (ptrdiff_t)(r - 2) * IN_COLS + 512 + c0); vv[r] = *(const v4u*)(row + (ptrdiff_t)(r - 2) * IN_COLS + 1024 + c0); } else { cg[r] = (v4u){0, 0, 0, 0}; vv[r] = (v4u){0, 0, 0, 0}; } }
    const f32x4 w0a = *(const f32x4*)(conv_w + c0), w0b = *(const f32x4*)(conv_w + c0 + 4);
    const f32x4 w1a = *(const f32x4*)(conv_w + 512 + c0), w1b = *(const f32x4*)(conv_w + 512 + c0 + 4);
    const f32x4 w2a = *(const f32x4*)(conv_w + 1024 + c0), w2b = *(const f32x4*)(conv_w + 1024 + c0 + 4);
    const f32x4 ga = *(const f32x4*)(conv_norm_w + c0), gb = *(const f32x4*)(conv_norm_w + c0 + 4);
    float u[6][8];
#pragma unroll
    for (int r = 0; r < 6; ++r)
#pragma unroll
        for (int q = 0; q < 4; ++q) { u[r][2 * q] = bflo(cg[r][q]) * bflo(vv[r][q]); u[r][2 * q + 1] = bfhi(cg[r][q]) * bfhi(vv[r][q]); }
    float y[4][8], ss[4];
#pragma unroll
    for (int r = 0; r < 4; ++r) { float s = 0.f;
#pragma unroll
        for (int e = 0; e < 8; ++e) { const float b = (e & 1) ? bfhi(bg[r][e >> 1]) : bflo(bg[r][e >> 1]);
            const float wt0 = e < 4 ? w0a[e & 3] : w0b[e & 3], wt1 = e < 4 ? w1a[e & 3] : w1b[e & 3], wt2 = e < 4 ? w2a[e & 3] : w2b[e & 3];
            y[r][e] = b * (wt0 * u[r][e] + wt1 * u[r + 1][e] + wt2 * u[r + 2][e]); s += y[r][e] * y[r][e]; }
        ss[r] = s; }
#pragma unroll
    for (int r = 0; r < 4; ++r) { const float rr = rsqrtf(wave_sum(ss[r]) * (1.0f / 512.0f) + EPS);
        v4u o; o.x = pk2(y[r][0] * rr * ga[0], y[r][1] * rr * ga[1]); o.y = pk2(y[r][2] * rr * ga[2], y[r][3] * rr * ga[3]); o.z = pk2(y[r][4] * rr * gb[0], y[r][5] * rr * gb[1]); o.w = pk2(y[r][6] * rr * gb[2], y[r][7] * rr * gb[3]);
        *(v4u*)(Y + (size_t)(m0 + r) * 1024 + c0) = o; }
}

__device__ __forceinline__ void h1_unit(int b, int n, const bf16* P, const float* lbl, bf16* UsT, float* decay, LAS unsigned char* lds, int tid) {
    const int c = tid, h = c >> 7, kch = c & 127, lane = tid & 63, w = tid >> 6;
    const size_t tok0 = (size_t)b * SEQ + (size_t)n * 64;
    const float lb = sigmoidf_(lbl[c] - lbl[512 + c]), oml = 1.0f - lb;
    LAS unsigned char* KT = lds; LAS unsigned char* IT = lds + 65536; LAS float* DEC = (LAS float*)(lds + 131072);
    {
        const bf16* pf = P + tok0 * IN_COLS + 2048 + c;
        float Pf = 1.f;
#pragma unroll 1
        for (int seg = 0; seg < 2; ++seg) {
            float fv[32]; unsigned iv[16];
#pragma unroll
            for (int j = 0; j < 32; ++j) fv[j] = bf2f(pf[(size_t)j * IN_COLS]);
#pragma unroll
            for (int j = 0; j < 16; ++j) iv[j] = (unsigned)pf[(size_t)(2 * j) * IN_COLS + 512] | ((unsigned)pf[(size_t)(2 * j + 1) * IN_COLS + 512] << 16);
            pf += (size_t)32 * IN_COLS;
#pragma unroll
            for (int q = 0; q < 4; ++q) { unsigned pk[4];
#pragma unroll
                for (int e = 0; e < 4; ++e) { float kt2[2];
#pragma unroll
                    for (int hl = 0; hl < 2; ++hl) { const float sg = sigmoidf_(fv[8 * q + 2 * e + hl]); Pf *= lb + oml * sg; kt2[hl] = oml * (1.0f - sg) * __builtin_amdgcn_rcpf(Pf); }
                    pk[e] = pk2(kt2[0], kt2[1]); }
                *(LAS v4u*)(KT + c * 128 + (((4 * seg + q) ^ (c & 7)) * 16)) = (v4u){pk[0], pk[1], pk[2], pk[3]}; }
#pragma unroll
            for (int q = 0; q < 4; ++q) *(LAS v4u*)(IT + c * 128 + (((4 * seg + q) ^ (c & 7)) * 16)) = (v4u){iv[4 * q], iv[4 * q + 1], iv[4 * q + 2], iv[4 * q + 3]};
        }
        const float dcy = Pf;
        DEC[c] = dcy;
        decay[((size_t)(b * 4 + h) * 128 + n) * 128 + kch] = dcy;
    }
    __syncthreads();
    {
        const int hd = w >> 1, half = w & 1, l31 = lane & 31, hh = lane >> 5;
        bf16* ub = UsT + ((size_t)(b * 4 + hd) * 128 + n) * 16384;
#pragma unroll 1
        for (int vb = 0; vb < 2; ++vb) {
            f32x16 acc[4];
#pragma unroll
            for (int bq = 0; bq < 4; ++bq)
#pragma unroll
                for (int r = 0; r < 16; ++r) acc[bq][r] = 0.f;
            const int v = hd * 128 + (half * 2 + vb) * 32 + l31;
#pragma unroll
            for (int s = 0; s < 4; ++s) { const int chunk = 2 * s + hh; bf16x8 bfr[4];
                const bf16x8 af = *(const LAS bf16x8*)(IT + v * 128 + ((chunk ^ (v & 7)) * 16));
#pragma unroll
                for (int kb = 0; kb < 4; ++kb) { const int k = hd * 128 + kb * 32 + l31; bfr[kb] = *(const LAS bf16x8*)(KT + k * 128 + ((chunk ^ (k & 7)) * 16)); }
#pragma unroll
                for (int kb = 0; kb < 4; ++kb) acc[kb] = __builtin_amdgcn_mfma_f32_32x32x16_bf16(af, bfr[kb], acc[kb], 0, 0, 0); }
#pragma unroll
            for (int kb = 0; kb < 4; ++kb) { const float dk = DEC[hd * 128 + kb * 32 + l31];
#pragma unroll
                for (int r = 0; r < 16; ++r) { const int vr = (half * 2 + vb) * 32 + (r & 3) + 8 * (r >> 2) + 4 * hh; ub[(size_t)vr * 128 + kb * 32 + l31] = (bf16)(pk2(acc[kb][r] * dk, 0.f) & 0xffffu); } }
        }
    }
    __syncthreads();
}

__device__ __forceinline__ void h2_scan(bf16* UsT, const float* decay, int gw, int NGW, int lane, long dry_off) {
    for (int task = gw; task < 16 * 128; task += NGW) {
        const int bh = task >> 7, v = task & 127;
        unsigned* p = (unsigned*)(UsT + (size_t)bh * 128 * 16384 + (size_t)v * 128) + lane;
        const f32x2* dp = (const f32x2*)(decay + (size_t)bh * 128 * 128) + lane;
        f32x2 S = {0.f, 0.f};
        for (int n0 = 0; n0 < 128; n0 += 16) { unsigned u[16]; f32x2 d[16];
#pragma unroll
            for (int j = 0; j < 16; ++j) { u[j] = p[(size_t)(n0 + j) * 8192]; d[j] = dp[(size_t)(n0 + j) * 64]; }
#pragma unroll
            for (int j = 0; j < 16; ++j) { p[(size_t)(n0 + j) * 8192 + dry_off] = pk2(S.x, S.y); S = d[j] * S + (f32x2){bflo(u[j]), bfhi(u[j])}; } }
    }
}

__device__ __forceinline__ void h3_unit(int b, int n, int h, const bf16* P, const float* lbl, const bf16* UsT, const float* hnw, bf16* Y, LAS unsigned char* lds, int tid) {
    const int lane = tid & 63, w = tid >> 6, bh = b * 4 + h;
    const size_t tok0 = (size_t)b * SEQ + (size_t)n * 64;
    LAS unsigned char* RAW = lds; LAS unsigned char* QD = lds + 49152; LAS unsigned char* KI = lds + 65536; LAS unsigned char* IT = lds + 81920; LAS unsigned char* ST = lds + 98304;
    LAS float* OS = (LAS float*)lds; LAS float* TOT = (LAS float*)(lds + 131072);
    {
        { v4u raw[3][2];
#pragma unroll
          for (int tl = 0; tl < 3; ++tl)
#pragma unroll
              for (int i = 0; i < 2; ++i) { const int idx = tid + 512 * i, row = idx >> 4, ch = idx & 15; raw[tl][i] = *(const v4u*)(P + (tok0 + row) * IN_COLS + 1536 + 512 * tl + h * 128 + 8 * ch); }
          const int v = tid >> 2, kq = tid & 3; const v4u* src = (const v4u*)(UsT + ((size_t)bh * 128 + n) * 16384 + (size_t)v * 128 + 32 * kq); v4u stv[4];
#pragma unroll
          for (int i = 0; i < 4; ++i) stv[i] = src[i];
#pragma unroll
          for (int tl = 0; tl < 3; ++tl)
#pragma unroll
              for (int i = 0; i < 2; ++i) *(LAS v4u*)(RAW + tl * 16384 + (tid + 512 * i) * 16) = raw[tl][i];
#pragma unroll
          for (int i = 0; i < 4; ++i) *(LAS v4u*)(ST + v * 256 + (((4 * kq + i) ^ (v & 15)) * 16)) = stv[i]; }
        __syncthreads();
        const int k = tid & 127, tq = tid >> 7;
        const float lb = sigmoidf_(lbl[h * 128 + k] - lbl[512 + h * 128 + k]), oml = 1.0f - lb;
        const LAS bf16* rq = (const LAS bf16*)RAW + (16 * tq) * 128 + k; const LAS bf16* rf = rq + 8192; const LAS bf16* ri = rq + 16384;
        float sg[16], cs[16], qv[16]; float c = 1.f;
#pragma unroll
        for (int j = 0; j < 16; ++j) { const float f = bf2f(rf[j * 128]); qv[j] = bf2f(rq[j * 128]); sg[j] = sigmoidf_(f); c *= lb + oml * sg[j]; cs[j] = c; }
        TOT[tq * 128 + k] = c;
        { unsigned iv[8];
#pragma unroll
          for (int j = 0; j < 8; ++j) iv[j] = (unsigned)ri[(2 * j) * 128] | ((unsigned)ri[(2 * j + 1) * 128] << 16);
          const int sw = (k >> 1) & 7;
          *(LAS v4u*)(IT + k * 128 + (((2 * tq) ^ sw) * 16)) = (v4u){iv[0], iv[1], iv[2], iv[3]};
          *(LAS v4u*)(IT + k * 128 + (((2 * tq + 1) ^ sw) * 16)) = (v4u){iv[4], iv[5], iv[6], iv[7]}; }
        __syncthreads();
        float off = 1.f;
#pragma unroll
        for (int q = 0; q < 4; ++q) off *= (q < tq) ? TOT[q * 128 + k] : 1.f;
#pragma unroll
        for (int j = 0; j < 16; ++j) { const int t = 16 * tq + j; const float eg = off * cs[j];
            const float qd = qv[j] * sigmoidf_(qv[j]) * eg, ki = oml * (1.0f - sg[j]) * __builtin_amdgcn_rcpf(eg);
            const int o = t * 256 + (((k >> 3) ^ (t & 15)) * 16) + (k & 7) * 2;
            *(LAS bf16*)(QD + o) = (bf16)(pk2(qd, 0.f) & 0xffffu); *(LAS bf16*)(KI + o) = (bf16)(pk2(ki, 0.f) & 0xffffu); }
    }
    __syncthreads();
    {
        const int tb = w & 1, vb = w >> 1, l31 = lane & 31, hh = lane >> 5, t = 32 * tb + l31;
        bf16x8 qf[8];
#pragma unroll
        for (int ks = 0; ks < 8; ++ks) qf[ks] = *(const LAS bf16x8*)(QD + t * 256 + (((2 * ks + hh) ^ (t & 15)) * 16));
        f32x16 o;
#pragma unroll
        for (int r = 0; r < 16; ++r) o[r] = 0.f;
        const int v = 32 * vb + l31;
#pragma unroll
        for (int sb = 0; sb < 2; ++sb) {
            if (sb <= tb) {
                f32x16 x;
#pragma unroll
                for (int r = 0; r < 16; ++r) x[r] = 0.f;
                const int srow = 32 * sb + kappa(l31);
#pragma unroll
                for (int ks = 0; ks < 8; ++ks) { const bf16x8 a = *(const LAS bf16x8*)(KI + srow * 256 + (((2 * ks + hh) ^ (srow & 15)) * 16)); x = __builtin_amdgcn_mfma_f32_32x32x16_bf16(a, qf[ks], x, 0, 0, 0); }
                if (sb == tb) {
#pragma unroll
                    for (int r = 0; r < 16; ++r) { const int sp = 16 * ((r >> 3) & 1) + 8 * hh + 4 * ((r >> 2) & 1) + (r & 3); if (sp > l31) x[r] = 0.f; } }
#pragma unroll
                for (int st = 0; st < 2; ++st) {
                    const v4u pb = {pk2(x[8 * st + 0], x[8 * st + 1]), pk2(x[8 * st + 2], x[8 * st + 3]), pk2(x[8 * st + 4], x[8 * st + 5]), pk2(x[8 * st + 6], x[8 * st + 7])};
                    const bf16x8 a = *(const LAS bf16x8*)(IT + v * 128 + (((4 * sb + 2 * st + hh) ^ ((v >> 1) & 7)) * 16));
                    o = __builtin_amdgcn_mfma_f32_32x32x16_bf16(a, as_bf16x8(pb), o, 0, 0, 0); }
            }
        }
#pragma unroll
        for (int ks = 0; ks < 8; ++ks) { const bf16x8 a = *(const LAS bf16x8*)(ST + v * 256 + (((2 * ks + hh) ^ (v & 15)) * 16)); o = __builtin_amdgcn_mfma_f32_32x32x16_bf16(a, qf[ks], o, 0, 0, 0); }
#pragma unroll
        for (int r = 0; r < 16; ++r) OS[t * 129 + 32 * vb + (r & 3) + 8 * (r >> 2) + 4 * hh] = o[r];
    }
    __syncthreads();
    {
        const int t = tid >> 3, vc = tid & 7; float ov[16]; float ss = 0.f;
#pragma unroll
        for (int j = 0; j < 16; ++j) { ov[j] = OS[t * 129 + 16 * vc + j]; ss += ov[j] * ov[j]; }
        ss += xlane_dpp_b1(ss); ss += xlane_dpp_4e(ss); ss += xlane_dpp_x4(ss);
        const float r = rsqrtf(ss * (1.0f / 128.0f) + EPS);
        const bf16* gp = P + (tok0 + t) * IN_COLS + 3072 + h * 128 + 16 * vc;
        const v4u g0 = *(const v4u*)gp, g1 = *(const v4u*)(gp + 8);
        const float* nw = hnw + h * 128 + 16 * vc;
        unsigned ow[8];
#pragma unroll
        for (int j = 0; j < 8; ++j) { const unsigned gw_ = j < 4 ? g0[j] : g1[j - 4]; const float ga = bflo(gw_), gb = bfhi(gw_);
            ow[j] = pk2(ov[2 * j] * r * nw[2 * j] * (ga * sigmoidf_(ga)), ov[2 * j + 1] * r * nw[2 * j + 1] * (gb * sigmoidf_(gb))); }
        bf16* yp = Y + (tok0 + t) * 1024 + 512 + h * 128 + 16 * vc;
        *(v4u*)yp = (v4u){ow[0], ow[1], ow[2], ow[3]}; *(v4u*)(yp + 8) = (v4u){ow[4], ow[5], ow[6], ow[7]};
    }
    __syncthreads();
}

typedef float f32x4a __attribute__((ext_vector_type(4)));
__device__ __forceinline__ int kswz(int row) { return (row & 3) | (((row >> 3) & 3) << 2); }
__device__ __forceinline__ void attn_phase(const bf16* Q, const bf16* Kb, const bf16* VT, bf16* O, LAS unsigned char* lds, int tid, int vcu, int G) {
    const int lane = tid & 63, w = __builtin_amdgcn_readfirstlane(tid >> 6), l15 = lane & 15, kq = lane >> 4;
    int u = vcu; if (u >= 1024) return;
#define ATT_LOAD(j, kbase_, vbase_) do { _Pragma("unroll") for (int i = 0; i < 4; ++i) { const int idx = tid + 512 * i; const bf16* src_; \
        if ((j) < 4) { const int row = idx >> 5, ch = idx & 31; src_ = (kbase_) + (size_t)(j) * 16384 + row * 256 + ((ch ^ kswz(row)) * 8); } \
        else { const int row = idx >> 3, ch = idx & 7; src_ = (vbase_) + (size_t)row * 256 + 64 * ((j) - 4) + ((ch ^ ((row >> 1) & 7)) * 8); } \
        __builtin_amdgcn_global_load_lds((const unsigned*)src_, (LAS unsigned*)(lds + ((j) & 3) * 32768 + i * 8192 + w * 1024), 16, 0, 0); } } while (0)
#define ATT_LANDED(n) do { asm volatile("s_waitcnt vmcnt(" #n ") lgkmcnt(0)" ::: "memory"); __builtin_amdgcn_s_barrier(); asm volatile("" ::: "memory"); } while (0)
#define ATT_LANDED2(n_next, n_last) do { if (has_next) asm volatile("s_waitcnt vmcnt(" #n_next ") lgkmcnt(0)" ::: "memory"); else asm volatile("s_waitcnt vmcnt(" #n_last ") lgkmcnt(0)" ::: "memory"); __builtin_amdgcn_s_barrier(); asm volatile("" ::: "memory"); } while (0)
#define ATT_UNIT(u_, tok_, kbase_, vbase_, hd_) const int b_##u_ = (u_) >> 8, hd_ = ((u_) >> 6) & 3; const int tok_ = b_##u_ * SEQ + ((u_) & 63) * 128 + 16 * w;     \
        const bf16* kbase_ = Kb + (size_t)(b_##u_ * 4 + hd_) * 65536; const bf16* vbase_ = VT + (size_t)(b_##u_ * 4 + hd_) * 65536;
    bf16x8 qf[8];
    { ATT_UNIT(u, tok0, kb0, vb0, hd0)
      const bf16* qp = Q + (size_t)tok0 * 1024 + hd0 * 256 + (l15 * 1024 + 8 * kq);
#pragma unroll
      for (int ks = 0; ks < 8; ++ks) qf[ks] = *(const bf16x8*)(qp + 32 * ks);
      asm volatile("" ::: "memory");
      ATT_LOAD(0, kb0, vb0); ATT_LOAD(1, kb0, vb0); ATT_LOAD(2, kb0, vb0); }
    ATT_LANDED(0);
#define ATT_TOUCH_Q() do { _Pragma("unroll") for (int ks = 0; ks < 8; ++ks) asm volatile("" :: "v"(__builtin_bit_cast(v4u, qf[ks]))); } while (0)
    ATT_TOUCH_Q();
#pragma unroll 1
    for (; u < 1024; u += G) {
        const bool has_next = u + G < 1024;
        const int un = has_next ? u + G : u;
        ATT_UNIT(u, tok, kbase, vbase, hd)
        ATT_UNIT(un, tokn, kbn, vbn, hdn)
        f32x4a p[16];
#pragma unroll
        for (int j = 0; j < 4; ++j) {
            ATT_LOAD(j + 3, kbase, vbase);
            const LAS unsigned char* buf = lds + (j & 3) * 32768;
#pragma unroll
            for (int blk = 0; blk < 4; ++blk) { f32x4a x = {0.f, 0.f, 0.f, 0.f};
                const int row = 32 * (blk >> 1) + 8 * (l15 >> 2) + 4 * (blk & 1) + (l15 & 3);
#pragma unroll
                for (int ks = 0; ks < 8; ++ks) { const bf16x8 a = *(const LAS bf16x8*)(buf + row * 512 + (((4 * ks + kq) ^ kswz(row)) * 16)); x = __builtin_amdgcn_mfma_f32_16x16x32_bf16(a, qf[ks], x, 0, 0, 0); }
                p[4 * j + blk] = x; }
            if (j < 2) ATT_LANDED(63); else ATT_LANDED(8);
        }
        float mx = p[0][0];
#pragma unroll
        for (int i = 0; i < 16; ++i)
#pragma unroll
            for (int r = 0; r < 4; ++r) mx = fmaxf(mx, p[i][r]);
        mx = fmaxf(mx, __shfl_xor(mx, 16)); mx = fmaxf(mx, __shfl_xor(mx, 32));
        float lsum = 0.f;
#pragma unroll
        for (int i = 0; i < 16; ++i)
#pragma unroll
            for (int r = 0; r < 4; ++r) { p[i][r] = __builtin_amdgcn_exp2f(p[i][r] - mx); lsum += p[i][r]; }
        lsum += __shfl_xor(lsum, 16); lsum += __shfl_xor(lsum, 32);
        const float inv = 1.0f / lsum;
        v4u pb[8];
#pragma unroll
        for (int s = 0; s < 8; ++s) pb[s] = (v4u){pk2(p[2 * s][0], p[2 * s][1]), pk2(p[2 * s][2], p[2 * s][3]), pk2(p[2 * s + 1][0], p[2 * s + 1][1]), pk2(p[2 * s + 1][2], p[2 * s + 1][3])};
        f32x4a ot[16];
#pragma unroll
        for (int i = 0; i < 16; ++i) ot[i] = (f32x4a){0.f, 0.f, 0.f, 0.f};
#pragma unroll
        for (int j = 4; j < 8; ++j) {
            if (j == 4) ATT_LOAD(7, kbase, vbase);
            else if (has_next) { if (j == 5) ATT_LOAD(0, kbn, vbn); else if (j == 6) ATT_LOAD(1, kbn, vbn); else ATT_LOAD(2, kbn, vbn); }
            const LAS unsigned char* buf = lds + (j & 3) * 32768;
#pragma unroll
            for (int db = 0; db < 16; ++db) { const int row = 16 * db + l15;
#pragma unroll
                for (int s = 0; s < 2; ++s) { const bf16x8 a = *(const LAS bf16x8*)(buf + row * 128 + (((4 * s + kq) ^ ((row >> 1) & 7)) * 16));
                    ot[db] = __builtin_amdgcn_mfma_f32_16x16x32_bf16(a, as_bf16x8(pb[2 * (j - 4) + s]), ot[db], 0, 0, 0); } }
            if (j == 4) { if (has_next) { const bf16* qp = Q + (size_t)tokn * 1024 + hdn * 256 + (l15 * 1024 + 8 * kq);
#pragma unroll
                    for (int ks = 0; ks < 8; ++ks) qf[ks] = *(const bf16x8*)(qp + 32 * ks); }
                ATT_LANDED2(16, 8); }
            else if (j == 5) ATT_LANDED2(16, 4);
            else if (j == 6) ATT_LANDED2(16, 0);
            else ATT_LANDED(0);
        }
        ATT_TOUCH_Q();
        bf16* op = O + (size_t)tok * 1024 + hd * 256 + (l15 * 1024 + 4 * kq);
#pragma unroll
        for (int db = 0; db < 16; ++db) { v2u o2 = {pk2(ot[db][0] * inv, ot[db][1] * inv), pk2(ot[db][2] * inv, ot[db][3] * inv)}; *(v2u*)(op + 16 * db) = o2; }
    }
#undef ATT_LOAD
#undef ATT_LANDED
#undef ATT_LANDED2
#undef ATT_TOUCH_Q
#undef ATT_UNIT
}

__device__ __forceinline__ unsigned ord_f32(float f) { const unsigned u = __float_as_uint(f); return u ^ ((unsigned)((int)u >> 31) | 0x80000000u); }
__device__ __forceinline__ float unord_f32(unsigned o) { return __uint_as_float(o ^ (~(unsigned)((int)o >> 31) | 0x80000000u)); }
__device__ __forceinline__ void ce_desc(unsigned& a, unsigned& b) { const unsigned hi = a > b ? a : b, lo = a > b ? b : a; a = hi; b = lo; }
__device__ __forceinline__ void sort16_desc(unsigned (&a)[16]) {
    ce_desc(a[0], a[1]); ce_desc(a[2], a[3]); ce_desc(a[0], a[2]); ce_desc(a[1], a[3]); ce_desc(a[1], a[2]); ce_desc(a[4], a[5]); ce_desc(a[6], a[7]); ce_desc(a[4], a[6]); ce_desc(a[5], a[7]); ce_desc(a[5], a[6]);
    ce_desc(a[0], a[4]); ce_desc(a[2], a[6]); ce_desc(a[2], a[4]); ce_desc(a[1], a[5]); ce_desc(a[3], a[7]); ce_desc(a[3], a[5]); ce_desc(a[1], a[2]); ce_desc(a[3], a[4]); ce_desc(a[5], a[6]); ce_desc(a[8], a[9]);
    ce_desc(a[10], a[11]); ce_desc(a[8], a[10]); ce_desc(a[9], a[11]); ce_desc(a[9], a[10]); ce_desc(a[12], a[13]); ce_desc(a[14], a[15]); ce_desc(a[12], a[14]); ce_desc(a[13], a[15]); ce_desc(a[13], a[14]);
    ce_desc(a[8], a[12]); ce_desc(a[10], a[14]); ce_desc(a[10], a[12]); ce_desc(a[9], a[13]); ce_desc(a[11], a[15]); ce_desc(a[11], a[13]); ce_desc(a[9], a[10]); ce_desc(a[11], a[12]); ce_desc(a[13], a[14]);
    ce_desc(a[0], a[8]); ce_desc(a[4], a[12]); ce_desc(a[4], a[8]); ce_desc(a[2], a[10]); ce_desc(a[6], a[14]); ce_desc(a[6], a[10]); ce_desc(a[2], a[4]); ce_desc(a[6], a[8]); ce_desc(a[10], a[12]); ce_desc(a[1], a[9]);
    ce_desc(a[5], a[13]); ce_desc(a[5], a[9]); ce_desc(a[3], a[11]); ce_desc(a[7], a[15]); ce_desc(a[7], a[11]); ce_desc(a[3], a[5]); ce_desc(a[7], a[9]); ce_desc(a[11], a[13]); ce_desc(a[1], a[2]); ce_desc(a[3], a[4]);
    ce_desc(a[5], a[6]); ce_desc(a[7], a[8]); ce_desc(a[9], a[10]); ce_desc(a[11], a[12]); ce_desc(a[13], a[14]);
}
__device__ __forceinline__ void merge_prune16(unsigned (&top)[16], const unsigned (&nw)[16]) {
#pragma unroll
    for (int i = 0; i < 16; ++i) top[i] = top[i] > nw[15 - i] ? top[i] : nw[15 - i];
#pragma unroll
    for (int j = 8; j > 0; j >>= 1)
#pragma unroll
        for (int i = 0; i < 16; ++i) { const int l = i ^ j; if (l > i) ce_desc(top[i], top[l]); }
}
__device__ __forceinline__ void topk_load(const unsigned short* scT, int hp, int token, v2u (&raw)[32]) {
#pragma unroll
    for (int kq = 0; kq < 32; ++kq) raw[kq] = *(const v2u*)(scT + ((size_t)(hp * 32 + kq) * M + token) * 4);
}
typedef short s16x2v __attribute__((ext_vector_type(2)));
__device__ __forceinline__ unsigned ord_f16x2(unsigned w) { const s16x2v m = __builtin_bit_cast(s16x2v, w) >> 15; return w ^ (__builtin_bit_cast(unsigned, m) | 0x80008000u); }
__device__ __forceinline__ float unord_f16_hi(unsigned key) { const unsigned o = key >> 16; const unsigned h = o ^ ((o & 0x8000u) ? 0x8000u : 0xffffu); return (float)__builtin_bit_cast(_Float16, (unsigned short)h); }
__device__ __forceinline__ void topk_half(const v2u (&raw)[32], unsigned (&top)[16]) {
#pragma unroll
    for (int c = 0; c < 8; ++c) { unsigned nw[16];
#pragma unroll
        for (int q = 0; q < 4; ++q) { const unsigned x0 = ord_f16x2(raw[4 * c + q].x), x1 = ord_f16x2(raw[4 * c + q].y); const int b0 = 127 - (16 * c + 4 * q);
            nw[4 * q + 0] = (x0 << 16) | (unsigned)b0;         nw[4 * q + 1] = (x0 & 0xffff0000u) | (unsigned)(b0 - 1);
            nw[4 * q + 2] = (x1 << 16) | (unsigned)(b0 - 2);   nw[4 * q + 3] = (x1 & 0xffff0000u) | (unsigned)(b0 - 3); }
        sort16_desc(nw);
        if (c == 0) {
#pragma unroll
            for (int i = 0; i < 16; ++i) top[i] = nw[i]; }
        else merge_prune16(top, nw); }
}
__device__ __forceinline__ void peer_topk_task(const unsigned short* scT, int head, int token, unsigned short* idx_out, float* gate_out, LAS unsigned char* slot) {
    unsigned ta[16], tb[16];
    { v2u ra[32], rb[32]; topk_load(scT, 2 * head, token, ra); topk_load(scT, 2 * head + 1, token, rb); topk_half(ra, ta); topk_half(rb, tb); }
    float av[16], bv[16];
#pragma unroll
    for (int i = 0; i < 16; ++i) { av[i] = unord_f16_hi(ta[i]); bv[i] = unord_f16_hi(tb[i]); }
#pragma unroll
    for (int q = 0; q < 4; ++q) {
        unsigned wa = 0, wb = 0;
#pragma unroll
        for (int e = 0; e < 4; ++e) { wa |= (127u - (ta[4 * q + e] & 127u)) << (8 * e); wb |= (127u - (tb[4 * q + e] & 127u)) << (8 * e); }
        *(LAS unsigned*)(slot + 4 * q) = wa; *(LAS unsigned*)(slot + 16 + 4 * q) = wb; }
    unsigned cd[4][16];
#pragma unroll
    for (int q = 0; q < 4; ++q)
#pragma unroll
        for (int e = 0; e < 16; ++e) cd[q][e] = 0u;
    {
        constexpr int cnt[16] = {16, 8, 5, 4, 3, 2, 2, 2, 1, 1, 1, 1, 1, 1, 1, 1};
        constexpr int stt[16] = {0, 16, 24, 29, 33, 36, 38, 40, 42, 43, 44, 45, 46, 47, 48, 49};
#pragma unroll
        for (int i = 0; i < 16; ++i)
#pragma unroll
            for (int j = 0; j < 16; ++j) if (j < cnt[i]) { const int t = stt[i] + j; const int ch = t < 16 ? 0 : t < 24 ? 1 : t < 40 ? 2 : 3, ps = t < 16 ? t : t < 24 ? t - 16 : t < 40 ? t - 24 : t - 40;
                cd[ch][ps] = (ord_f32(av[i] + bv[j]) & ~63u) | (unsigned)(63 - t); }
    }
    sort16_desc(cd[2]); sort16_desc(cd[3]);
    merge_prune16(cd[0], cd[1]); merge_prune16(cd[2], cd[3]); merge_prune16(cd[0], cd[2]);
    LDS_WAIT();
    float gv[16]; float gs = 0.f; const float vmax = unord_f32(cd[0][0] & ~63u);
    unsigned ex[16];
#pragma unroll
    for (int r = 0; r < 16; ++r) {
        const int t = 63 - (int)(cd[0][r] & 63u);
        int i = (t >= 16) + (t >= 24) + (t >= 29) + (t >= 33) + (t >= 36) + (t >= 38) + (t >= 40);
        int st = t >= 40 ? 40 : t >= 38 ? 38 : t >= 36 ? 36 : t >= 33 ? 33 : t >= 29 ? 29 : t >= 24 ? 24 : t >= 16 ? 16 : 0;
        int j = t - st;
        if (t >= 42) { i = 8 + (t - 42); j = 0; }
        const unsigned ia = *(LAS unsigned char*)(slot + i), ib = *(LAS unsigned char*)(slot + 16 + j);
        ex[r] = ia * 128u + ib;
        gv[r] = __expf(unord_f32(cd[0][r] & ~63u) - vmax); gs += gv[r]; }
    const float ginv = 1.0f / gs;
    float* gp = gate_out + (size_t)token * 128 + head * 16;
#pragma unroll
    for (int jj = 0; jj < 8; ++jj) *(unsigned*)(idx_out + (size_t)token * 128 + jj * 16 + 2 * head) = ex[jj] | (ex[jj + 8] << 16);
#pragma unroll
    for (int q = 0; q < 4; ++q) *(f32x4*)(gp + 4 * q) = (f32x4){gv[4 * q] * ginv, gv[4 * q + 1] * ginv, gv[4 * q + 2] * ginv, gv[4 * q + 3] * ginv};
}

__device__ __forceinline__ float quant_row_sliced(const float* src, const float* gain, unsigned char* dst, int rows, int r, int offset, int lane) {
    f32x4 v[4]; float am = 0.f;
#pragma unroll
    for (int jq = 0; jq < 4; ++jq) { v[jq] = ((const f32x4*)src)[64 * jq + lane]; if (gain) v[jq] = v[jq] * ((const f32x4*)gain)[64 * jq + lane];
        am = fmaxf(am, fmaxf(fmaxf(fabsf(v[jq].x), fabsf(v[jq].y)), fmaxf(fabsf(v[jq].z), fabsf(v[jq].w)))); }
    am = wave_max(am);
    const float inv = am > 0.f ? 127.0f / am : 0.f;
#pragma unroll
    for (int jq = 0; jq < 4; ++jq) { const int sl = 2 * jq + (lane >> 5);
        const int q0 = (int)rintf(v[jq].x * inv) + offset, q1 = (int)rintf(v[jq].y * inv) + offset, q2 = (int)rintf(v[jq].z * inv) + offset, q3 = (int)rintf(v[jq].w * inv) + offset;
        *(unsigned*)(dst + ((size_t)sl * rows + r) * 128 + 4 * (lane & 31)) = (unsigned)(q0 & 255) | ((unsigned)(q1 & 255) << 8) | ((unsigned)(q2 & 255) << 16) | ((unsigned)(q3 & 255) << 24); }
    return am * (1.0f / 127.0f);
}
template <bool EO = false>
__device__ __forceinline__ void quant_store_row(const f32x4 (&v)[4], float inv, unsigned char* dst, int rows, int r, int lane) {
#pragma unroll
    for (int jq = 0; jq < 4; ++jq) { const int sl = 2 * jq + (lane >> 5);
        const int q0 = (int)rintf(v[jq].x * inv), q1 = (int)rintf(v[jq].y * inv), q2 = (int)rintf(v[jq].z * inv), q3 = (int)rintf(v[jq].w * inv);
        unsigned char* d_ = dst + ((size_t)sl * rows + r) * 128;
        if (EO) { *(unsigned short*)(d_ + 2 * (lane & 31)) = (unsigned short)((q0 & 255) | ((q2 & 255) << 8)); *(unsigned short*)(d_ + 64 + 2 * (lane & 31)) = (unsigned short)((q1 & 255) | ((q3 & 255) << 8)); }
        else *(unsigned*)(d_ + 4 * (lane & 31)) = (unsigned)(q0 & 255) | ((unsigned)(q1 & 255) << 8) | ((unsigned)(q2 & 255) << 16) | ((unsigned)(q3 & 255) << 24); }
}
__device__ __forceinline__ float row_amax(const f32x4 (&v)[4]) { float am = 0.f;
#pragma unroll
    for (int jq = 0; jq < 4; ++jq) am = fmaxf(am, fmaxf(fmaxf(fabsf(v[jq].x), fabsf(v[jq].y)), fmaxf(fabsf(v[jq].z), fabsf(v[jq].w))));
    return wave_max(am); }
__device__ __forceinline__ void quant_rows4(const float* down, const float* up, const float* gain, unsigned char* dstd, unsigned char* dstu, int e0, int e1, int lane, float* dscale, float* uscale) {
    f32x4 vd0[4], vu0[4], vd1[4], vu1[4];
#pragma unroll
    for (int jq = 0; jq < 4; ++jq) { vd0[jq] = ((const f32x4*)(down + (size_t)e0 * 1024))[64 * jq + lane]; vu0[jq] = ((const f32x4*)(up + (size_t)e0 * 1024))[64 * jq + lane];
        vd1[jq] = ((const f32x4*)(down + (size_t)e1 * 1024))[64 * jq + lane]; vu1[jq] = ((const f32x4*)(up + (size_t)e1 * 1024))[64 * jq + lane]; }
#pragma unroll
    for (int jq = 0; jq < 4; ++jq) { const f32x4 g = ((const f32x4*)gain)[64 * jq + lane]; vd0[jq] = vd0[jq] * g; vd1[jq] = vd1[jq] * g; }
    const float ad0 = row_amax(vd0), au0 = row_amax(vu0), ad1 = row_amax(vd1), au1 = row_amax(vu1);
    quant_store_row(vd0, ad0 > 0.f ? 127.0f / ad0 : 0.f, dstd, NEXP, e0, lane); quant_store_row<true>(vu0, au0 > 0.f ? 127.0f / au0 : 0.f, dstu, NEXP, e0, lane);
    if (lane == 0) { dscale[e0] = ad0 * (1.0f / 127.0f); uscale[e0] = au0 * (1.0f / 127.0f); }
    if (e1 != e0) { quant_store_row(vd1, ad1 > 0.f ? 127.0f / ad1 : 0.f, dstd, NEXP, e1, lane); quant_store_row<true>(vu1, au1 > 0.f ? 127.0f / au1 : 0.f, dstu, NEXP, e1, lane);
        if (lane == 0) { dscale[e1] = ad1 * (1.0f / 127.0f); uscale[e1] = au1 * (1.0f / 127.0f); } }
}
__device__ __forceinline__ void quant_x2_rows4(const bf16* x2S, unsigned char* dst, float* xscale, int m, int stride, int lane) {
    f32x4 v[4][4]; int mr[4];
#pragma unroll
    for (int r = 0; r < 4; ++r) { mr[r] = m + r * stride < M ? m + r * stride : m;
#pragma unroll
        for (int jq = 0; jq < 4; ++jq) { const v2u w = *(const v2u*)(x2S + ((size_t)(4 * jq + (lane >> 4)) * M + mr[r]) * 64 + 4 * (lane & 15)); v[r][jq] = (f32x4){bflo(w.x), bfhi(w.x), bflo(w.y), bfhi(w.y)}; } }
#pragma unroll
    for (int r = 0; r < 4; ++r) { const float am = row_amax(v[r]);
        if (r == 0 || mr[r] != m) { quant_store_row(v[r], am > 0.f ? 127.0f / am : 0.f, dst, M, mr[r], lane); if (lane == 0) xscale[mr[r]] = am * (1.0f / 127.0f); } }
}
__device__ __forceinline__ float swap_add32(float a, float b) { const auto r = __builtin_amdgcn_permlane32_swap(__float_as_uint(a), __float_as_uint(b), false, false); return __uint_as_float(r[0]) + __uint_as_float(r[1]); }
__device__ __forceinline__ float swap_add16(float a, float b) { const auto r = __builtin_amdgcn_permlane16_swap(__float_as_uint(a), __float_as_uint(b), false, false); return __uint_as_float(r[0]) + __uint_as_float(r[1]); }
template <int CTRL> __device__ __forceinline__ float dpp_f(float v) { return __uint_as_float((unsigned)__builtin_amdgcn_update_dpp(0, (int)__float_as_uint(v), CTRL, 0xF, 0xF, false)); }
__device__ __forceinline__ float dpp_xor4(float v) {
    int r = __builtin_amdgcn_update_dpp(0, (int)__float_as_uint(v), 0x12C, 0xF, 0x5, false);
    r = __builtin_amdgcn_update_dpp(r, (int)__float_as_uint(v), 0x124, 0xF, 0xA, false);
    return __uint_as_float((unsigned)r);
}
__device__ __forceinline__ float bfly8_low(const float (&p)[8], int lane) {
    float q4[4], q2[2];
    { const bool u = (lane & 4) != 0;
#pragma unroll
      for (int i = 0; i < 4; ++i) { const float keep = u ? p[4 + i] : p[i], send = u ? p[i] : p[4 + i]; q4[i] = keep + dpp_xor4(send); } }
    { const bool u = (lane & 2) != 0;
#pragma unroll
      for (int i = 0; i < 2; ++i) { const float keep = u ? q4[2 + i] : q4[i], send = u ? q4[i] : q4[2 + i]; q2[i] = keep + dpp_f<0x4E>(send); } }
    { const bool u = (lane & 1) != 0; const float keep = u ? q2[1] : q2[0], send = u ? q2[0] : q2[1]; return keep + dpp_f<0xB1>(send); }
}
__device__ __forceinline__ f32x2 bfly16_high(const float (&p)[16], int lane) {
    float q8[8], q4[4];
#pragma unroll
    for (int i = 0; i < 8; ++i) q8[i] = swap_add32(p[i], p[8 + i]);
#pragma unroll
    for (int i = 0; i < 4; ++i) q4[i] = swap_add16(q8[i], q8[4 + i]);
    { const bool u = (lane & 8) != 0; f32x2 r;
      { const float keep = u ? q4[2] : q4[0], send = u ? q4[0] : q4[2]; r.x = keep + dpp_f<0x128>(send); }
      { const float keep = u ? q4[3] : q4[1], send = u ? q4[1] : q4[3]; r.y = keep + dpp_f<0x128>(send); }
      return r; }
}
#define PEER_ISSUE(dst, iwa, iwb, base) do { _Pragma("unroll") for (int i = 0; i < 16; ++i) { const unsigned wvv_ = i < 8 ? (iwa)[i >> 1] : (iwb)[(i - 8) >> 1]; \
        const unsigned e_ = (i & 1) ? (wvv_ >> 16) : (wvv_ & 0xffffu); dst[i] = *(const v4u*)((base) + (size_t)e_ * 128); } } while (0)
#define PEER_LOADIDX(da, db, k) do { const v4u* ip_ = (const v4u*)(idxp + (size_t)TOKC(k) * 128 + 16 * j); da = ip_[0]; db = ip_[1]; } while (0)
#define TOKC(k) (wv + ((k) < ntok ? (k) : ntok - 1) * nwv)
__device__ __forceinline__ void peer_down_phase(const unsigned char* xq, const unsigned char* downQ, const unsigned short* idxp, unsigned* part, int sl, int wv, int nwv, int lane) {
    const int j = lane >> 3, sub = lane & 7;
    const int ntok = wv < M ? (M - wv + nwv - 1) / nwv : 0;
    const unsigned char* xs = xq + (size_t)sl * M * 128 + 16 * sub; const unsigned char* ds = downQ + (size_t)sl * NEXP * 128 + 16 * sub;
    unsigned* ps = part + (size_t)sl * M * 64 + ((j & 1) ? 32 + 4 * sub + (j >> 1) : 4 * sub + (j >> 1));
    if (ntok == 0) return;
#define D_COMPUTE(dsrc, xvv, k) do { float p0[8], p1[8]; _Pragma("unroll") for (int i = 0; i < 8; ++i) { int s = 0, u = 0; \
        _Pragma("unroll") for (int q = 0; q < 4; ++q) { s = __builtin_amdgcn_sdot4((int)dsrc[i][q], (int)xvv[q], s, false); u = __builtin_amdgcn_sdot4((int)dsrc[8 + i][q], (int)xvv[q], u, false); } p0[i] = (float)s; p1[i] = (float)u; } \
        const float r0 = bfly8_low(p0, lane) * 0.015625f, r1 = bfly8_low(p1, lane) * 0.015625f;     \
        const float rc_ = dpp_f<0x128>((j & 1) ? r0 : r1);              \
        const pg8::f16x2 hv_ = (j & 1) ? (pg8::f16x2){(_Float16)rc_, (_Float16)r1} : (pg8::f16x2){(_Float16)r0, (_Float16)rc_}; \
        ps[(size_t)(wv + (k) * nwv) * 64] = __builtin_bit_cast(unsigned, hv_); } while (0)
    v4u dA[16], dB[16];
    v4u ia0, ib0, ia1, ib1; PEER_LOADIDX(ia0, ib0, 0); PEER_LOADIDX(ia1, ib1, 1);
    v4u xv0 = *(const v4u*)(xs + (size_t)TOKC(0) * 128), xv1 = *(const v4u*)(xs + (size_t)TOKC(1) * 128);
    PEER_ISSUE(dA, ia0, ib0, ds);
#pragma unroll 1
    for (int k = 0; k < ntok; k += 2) {
        v4u ia2, ib2; PEER_LOADIDX(ia2, ib2, k + 2); const v4u xv2 = *(const v4u*)(xs + (size_t)TOKC(k + 2) * 128);
        PEER_ISSUE(dB, ia1, ib1, ds);
        D_COMPUTE(dA, xv0, k);
        v4u ia3, ib3; PEER_LOADIDX(ia3, ib3, k + 3); const v4u xv3 = *(const v4u*)(xs + (size_t)TOKC(k + 3) * 128);
        PEER_ISSUE(dA, ia2, ib2, ds);
        if (k + 1 < ntok) D_COMPUTE(dB, xv1, k + 1);
        ia0 = ia2; ib0 = ib2; xv0 = xv2; ia1 = ia3; ib1 = ib3; xv1 = xv3;
    }
#undef D_COMPUTE
}
__device__ __forceinline__ void peer_combine_tokens4(const unsigned* part, const float* part2, const unsigned short* idxp, const float* dscale, const float* uscale, const float* xscale, const float* gate, unsigned* wpk, float* wscale, int t0, int stride, int lane) {
    int tk[4]; float pp[4], xs[4]; f32x2 s[4], gt[4]; unsigned ex[4];
#pragma unroll
    for (int r = 0; r < 4; ++r) { tk[r] = t0 + r * stride < M ? t0 + r * stride : t0; pp[r] = lane < 16 ? part2[(size_t)tk[r] * 16 + lane] : 0.f; xs[r] = xscale[tk[r]];
        const size_t o = (size_t)tk[r] * 64 + lane; { const unsigned short* ipp = idxp + (size_t)tk[r] * 128 + 32 * (lane & 3) + (lane >> 2); ex[r] = (unsigned)ipp[0] | ((unsigned)ipp[16] << 16); }
        gt[r] = *(const f32x2*)(gate + 2 * o); f32x2 a = {0.f, 0.f};
#pragma unroll
        for (int sl = 0; sl < 8; ++sl) { const pg8::f16x2 h = __builtin_bit_cast(pg8::f16x2, part[(size_t)sl * M * 64 + o]); a.x += (float)h[0]; a.y += (float)h[1]; }
        s[r] = a; }
    f32x2 ds[4], us[4];
#pragma unroll
    for (int r = 0; r < 4; ++r) { ds[r] = (f32x2){dscale[ex[r] & 0xffffu], dscale[ex[r] >> 16]}; us[r] = (f32x2){uscale[ex[r] & 0xffffu], uscale[ex[r] >> 16]}; }
#pragma unroll
    for (int r = 0; r < 4; ++r) { if (r > 0 && tk[r] == t0) continue;
        const float rx = rsqrtf(wave_sum(pp[r]) * (1.0f / 1024.0f) + EPS) * xs[r] * 64.0f;
        const float z0 = s[r].x * rx * ds[r].x, z1 = s[r].y * rx * ds[r].y;
        const float w0 = 0.5f * z0 * (1.0f + erff(z0 * 0.70710678118654752f)) * gt[r].x * us[r].x, w1 = 0.5f * z1 * (1.0f + erff(z1 * 0.70710678118654752f)) * gt[r].y * us[r].y;
        const float am = wave_max(fmaxf(fabsf(w0), fabsf(w1)));
        const float inv = am > 0.f ? 127.0f / am : 0.f;
        const int qq = ((int)rintf(w0 * inv) & 255) | (((int)rintf(w1 * inv) & 255) << 8);
        ((unsigned short*)wpk)[(size_t)tk[r] * 64 + lane] = (unsigned short)qq;
        if (lane == 0) wscale[tk[r]] = am * (1.0f / 127.0f); }
}
typedef int v2i_t __attribute__((ext_vector_type(2)));
#define U_COMPUTE(dsrc, wreg, k) do { const size_t tk_ = (size_t)(wv + (k) * nwv); const unsigned xx_ = *(const unsigned*)(xi0 + tk_ * 64); const float ws_ = wscale[tk_]; int acc0 = 0, acc1 = 0; \
        _Pragma("unroll") for (int h = 0; h < 2; ++h) { LAS unsigned char* buf_ = ubuf + h * 8192; \
            _Pragma("unroll") for (int i = 0; i < 8; ++i) *(LAS v4u*)(buf_ + i * 1024 + wr_off) = dsrc[8 * h + i]; \
            _Pragma("unroll") for (int i = 0; i < 8; ++i) { const int wlo_ = __builtin_amdgcn_readlane((int)(wreg), 2 * (8 * h + i)), whi_ = __builtin_amdgcn_readlane((int)(wreg), 2 * (8 * h + i) + 1); \
                const v2i_t t0_ = __builtin_amdgcn_ds_read_tr8_b64_v2i32((LAS v2i_t*)(buf_ + i * 1024 + rd_off0)), t1_ = __builtin_amdgcn_ds_read_tr8_b64_v2i32((LAS v2i_t*)(buf_ + i * 1024 + rd_off1)); \
                acc0 = __builtin_amdgcn_sdot4(t0_.x, wlo_, acc0, false); acc0 = __builtin_amdgcn_sdot4(t0_.y, whi_, acc0, false); \
                acc1 = __builtin_amdgcn_sdot4(t1_.x, wlo_, acc1, false); acc1 = __builtin_amdgcn_sdot4(t1_.y, whi_, acc1, false); } } \
        *(unsigned*)(xo0 + tk_ * 64) = pk2(__uint_as_float(xx_ << 16) + (float)acc0 * ws_, __uint_as_float(xx_ & 0xffff0000u) + (float)acc1 * ws_); } while (0)
#define U_LOADW(dst, k) do { dst = wpk[(size_t)TOKC(k) * 32 + (lane & 31)]; } while (0)
__device__ __forceinline__ void peer_up_phase(bf16* x2S, bf16* x3S, const unsigned char* upQ, const unsigned short* idxp, const unsigned* wpk, const float* wscale, int sl, int wv, int nwv, int lane, LAS unsigned char* ubuf) {
    const int j = lane >> 3, sub = lane & 7;
    const int ntok = wv < M ? (M - wv + nwv - 1) / nwv : 0;
    const unsigned char* us = upQ + (size_t)sl * NEXP * 128 + 16 * sub;
    const bf16* xi0 = x2S + (size_t)(2 * sl + (lane >> 5)) * M * 64 + 2 * (lane & 31);
    bf16* xo0 = x3S + (size_t)(2 * sl + (lane >> 5)) * M * 64 + 2 * (lane & 31);
    const int wr_off = j * 128 + ((sub ^ (j >> 1)) * 16);
    const int g_ = lane >> 4, p_ = lane & 15, r_ = p_ >> 1;
    const int rd_off0 = r_ * 128 + (((g_) ^ (r_ >> 1)) * 16) + 8 * (p_ & 1);
    const int rd_off1 = r_ * 128 + (((4 + g_) ^ (r_ >> 1)) * 16) + 8 * (p_ & 1);
    if (ntok == 0) return;
    v4u dA[16], dB[16];
    v4u ia0, ib0, ia1, ib1; PEER_LOADIDX(ia0, ib0, 0); PEER_LOADIDX(ia1, ib1, 1);
    unsigned wq0, wq1; U_LOADW(wq0, 0); U_LOADW(wq1, 1);
    PEER_ISSUE(dA, ia0, ib0, us);
#pragma unroll 1
    for (int k = 0; k < ntok; k += 2) {
        v4u ia2, ib2; PEER_LOADIDX(ia2, ib2, k + 2); unsigned wq2; U_LOADW(wq2, k + 2);
        PEER_ISSUE(dB, ia1, ib1, us);
        U_COMPUTE(dA, wq0, k);
        v4u ia3, ib3; PEER_LOADIDX(ia3, ib3, k + 3); unsigned wq3; U_LOADW(wq3, k + 3);
        PEER_ISSUE(dA, ia2, ib2, us);
        if (k + 1 < ntok) U_COMPUTE(dB, wq1, k + 1);
        ia0 = ia2; ib0 = ib2; ia1 = ia3; ib1 = ib3; wq0 = wq2; wq1 = wq3;
    }
}
#undef U_COMPUTE
#undef U_LOADW
#undef TOKC
#undef PEER_ISSUE
#undef PEER_LOADIDX
#define FN_LOAD(dst, tb) do { _Pragma("unroll") for (int r = 0; r < 4; ++r) { const int t_ = (tb) + r * NGW < M ? (tb) + r * NGW : (tb); \
        _Pragma("unroll") for (int jq = 0; jq < 4; ++jq) dst[r][jq] = *(const v2u*)(xs_ + (size_t)jq * 4 * M * 64 + (size_t)t_ * 64); } } while (0)
__device__ __forceinline__ void final_norm_phase(const bf16* x3S, float* out, const float* fin_w, int gw, int NGW, int lane) {
    if (gw >= M) return;
    const bf16* xs_ = x3S + (size_t)(lane >> 4) * M * 64 + 4 * (lane & 15);
    f32x4 w[4];
#pragma unroll
    for (int jq = 0; jq < 4; ++jq) w[jq] = ((const f32x4*)fin_w + lane)[64 * jq];
    v2u cur[4][4], nxt[4][4];
    FN_LOAD(cur, gw);
#pragma unroll 1
    for (int t = gw; t < M; t += 4 * NGW) {
        if (t + 4 * NGW < M) FN_LOAD(nxt, t + 4 * NGW);
#pragma unroll
        for (int r = 0; r < 4; ++r) { if (t + r * NGW >= M) break;
            float sa = 0.f;
#pragma unroll
            for (int jq = 0; jq < 4; ++jq) sa += (bflo(cur[r][jq].x) * bflo(cur[r][jq].x) + bfhi(cur[r][jq].x) * bfhi(cur[r][jq].x)) + (bflo(cur[r][jq].y) * bflo(cur[r][jq].y) + bfhi(cur[r][jq].y) * bfhi(cur[r][jq].y));
            const float ra = rsqrtf(wave_sum(sa) * (1.0f / 1024.0f) + EPS);
            f32x4* oa = (f32x4*)(out + (size_t)(t + r * NGW) * 1024) + lane;
#pragma unroll
            for (int jq = 0; jq < 4; ++jq) oa[64 * jq] = (f32x4){bflo(cur[r][jq].x) * ra * w[jq].x, bfhi(cur[r][jq].x) * ra * w[jq].y, bflo(cur[r][jq].y) * ra * w[jq].z, bfhi(cur[r][jq].y) * ra * w[jq].w}; }
#pragma unroll
        for (int r = 0; r < 4; ++r)
#pragma unroll
            for (int jq = 0; jq < 4; ++jq) cur[r][jq] = nxt[r][jq];
    }
}

#define XB_TMO      128
#define XB_XCNT(j)  (256  + 64 * (j))
#define XB_XSUB(j)  (1280 + 64 * (j))
#define XB_XGEN(j)  (2304 + 64 * (j))
#define XB_TOP      3328
#define XB_TOPGEN   3392
#define XCD_BAR_WORDS 3456
#define XB_SPIN_CAP (1u << 22)
__device__ __forceinline__ unsigned xb_ld(unsigned* p)              { return __hip_atomic_load(p, __ATOMIC_RELAXED, __HIP_MEMORY_SCOPE_AGENT); }
__device__ __forceinline__ unsigned xb_add(unsigned* p, unsigned v) { return __hip_atomic_fetch_add(p, v, __ATOMIC_RELAXED, __HIP_MEMORY_SCOPE_AGENT); }
__device__ __forceinline__ unsigned xb_xcc_id() { return (unsigned)__builtin_amdgcn_s_getreg((3 << 11) | 20) & 0xFu; }
#define XB_SPIN(cond, bar) do { unsigned _sp = 0; while (cond) { __builtin_amdgcn_s_sleep(1); \
    if ((++_sp & 255u) == 0u) { if (xb_ld(&(bar)[XB_TMO])) break; if (_sp > XB_SPIN_CAP) { atomicAdd(&(bar)[XB_TMO], 1u); break; } } } } while (0)
__device__ __forceinline__ unsigned xcd_barrier_post(unsigned* bar, volatile LAS unsigned* st) {
    const unsigned x = xb_xcc_id();
    if (threadIdx.x == 0) { st[2] = xb_add(&bar[XB_XCNT(x)], 1u); st[3] = x; }
    return x;
}
__device__ __forceinline__ void xcd_barrier_complete(unsigned* bar, unsigned x, unsigned& nloc, unsigned& nx) {
    const unsigned G = gridDim.x * gridDim.y * gridDim.z;
    unsigned sum, cnt, mine, sp = 0u;
    for (;;) {
        sum = 0u; cnt = 0u; mine = 0u;
#pragma unroll
        for (unsigned jx = 0; jx < 16; ++jx) { const unsigned c = xb_ld(&bar[XB_XCNT(jx)]); sum += c; cnt += (c > 0u) ? 1u : 0u; mine = (jx == x) ? c : mine; }
        if (sum == G) break;
        __builtin_amdgcn_s_sleep(1);
        if ((++sp & 255u) == 0u) { if (xb_ld(&bar[XB_TMO])) break; if (sp > XB_SPIN_CAP) { atomicAdd(&bar[XB_TMO], 1u); break; } }
    }
    nloc = mine > 0u ? mine : 1u; nx = cnt > 0u ? cnt : 1u;
}
__device__ __forceinline__ void xcd_barrier(unsigned* bar, unsigned x, volatile LAS unsigned* st, const bool thread0) {
    asm volatile("s_waitcnt vmcnt(0)" ::: "memory");
    __syncthreads();
    if (thread0) {
        __builtin_amdgcn_s_waitcnt(0);
        unsigned nloc = st[0], nx = st[1];
        if (nloc == 0u) { xcd_barrier_complete(bar, x, nloc, nx); st[0] = nloc; st[1] = nx; }
        const unsigned old = xb_add(&bar[XB_XSUB(x)], 1u);
        const unsigned gen = old / nloc;
        if (old + 1u == (gen + 1u) * nloc) {
            __builtin_amdgcn_fence(__ATOMIC_RELEASE, "agent");
            asm volatile("s_waitcnt vmcnt(0)" ::: "memory");
            const unsigned og = xb_add(&bar[XB_TOP], 1u);
            const unsigned tg = og / nx;
            if (og + 1u == (tg + 1u) * nx) xb_add(&bar[XB_TOPGEN], 1u);
            else XB_SPIN(xb_ld(&bar[XB_TOPGEN]) == tg, bar);
            __builtin_amdgcn_fence(__ATOMIC_ACQUIRE, "agent");
            xb_add(&bar[XB_XGEN(x)], 1u);
            asm volatile("s_waitcnt vmcnt(0)" ::: "memory");
        } else {
            XB_SPIN(xb_ld(&bar[XB_XGEN(x)]) == gen, bar);
            __builtin_amdgcn_fence(__ATOMIC_ACQUIRE, "agent");
            asm volatile("s_waitcnt vmcnt(0)" ::: "memory");
        }
    }
    __syncthreads();
}

struct Args { const float* in[20]; float* out; unsigned char* ws; int ph_lo, ph_hi; };
constexpr int N_PHASES = 16;
constexpr int LDS_MISC = RING_BYTES + 4096;
#define REPS(k) for (int rep_ = 0; rep_ < (((PROBE_MASK >> (k)) & 1) ? PROBE_REP : 1); ++rep_)

__global__ void __launch_bounds__(NT, 2) fwd(Args args) {
    extern __shared__ __attribute__((aligned(16))) unsigned char lds_raw[];
    LAS unsigned char* lds = (LAS unsigned char*)lds_raw;
    const int G = gridDim.x, bx = blockIdx.x;
    const int wave_s = __builtin_amdgcn_readfirstlane((int)threadIdx.x >> 6);
#define TID_FLAT (wave_s * 64 + (int)__builtin_amdgcn_mbcnt_hi(~0u, __builtin_amdgcn_mbcnt_lo(~0u, 0u)))
    const int vcu = (G % 8 == 0) ? (bx % 8) * (G / 8) + bx / 8 : bx;
    const int NGW = G * NWAVES;
    unsigned char* ws = args.ws;
    const int lo = args.ph_lo, hi = args.ph_hi;
    volatile LAS unsigned* bst = (volatile LAS unsigned*)(lds + LDS_MISC);
#if MK_N_LAUNCHES == 1
    cg::grid_group grid = cg::this_grid();
    unsigned* const barw = (unsigned*)(ws + WS_CTL);
    if (threadIdx.x < 8) bst[threadIdx.x] = 0u;
    __syncthreads();
    const unsigned bxcc = xcd_barrier_post(barw, bst);
    if (hi > 1000) grid.sync();
#ifdef PROBE_T
#define PROBE_T_MARK(k) do { if ((k) == PROBE_T && bx == 0 && TID_FLAT == 0) *(volatile LAS unsigned long long*)(lds + LDS_MISC + 136) = wall_clock64(); } while (0)
    if (bx == 0 && threadIdx.x == 0) { *(volatile LAS unsigned long long*)(lds + LDS_MISC + 128) = wall_clock64(); *(volatile LAS unsigned long long*)(lds + LDS_MISC + 136) = 0ull; }
#else
#define PROBE_T_MARK(k) do { } while (0)
#endif
#define SEAM(k) do { if (lo <= (k) && (k) + 1 < hi) { REPS(15) xcd_barrier(barw, bxcc, bst, TID_FLAT == 0); } PROBE_T_MARK(k); } while (0)
#else
#define SEAM(k) do { } while (0)
#endif
#ifndef PH_MASK
#define PH_MASK 0xFFFFF
#endif
#define IN(k) (((PH_MASK >> (k)) & 1) && lo <= (k) && (k) < hi)
#define PH_IDS int tid = TID_FLAT; asm volatile("" : "+v"(tid)); const int lane = tid & 63; const int wave = __builtin_amdgcn_readfirstlane(tid >> 6); const int gw = vcu * NWAVES + wave; (void)lane; (void)gw;
#if MK_N_LAUNCHES == 1
#define PEER_GROUP int grp, mem, nmem; { const unsigned nl_ = bst[0], nx_ = bst[1]; if (nx_ == 8u && nl_ > 0u) { grp = (int)bst[3]; mem = (int)bst[2]; nmem = (int)nl_; } else { grp = bx & 7; mem = bx >> 3; nmem = G >> 3; } } \
    grp = __builtin_amdgcn_readfirstlane(grp); mem = __builtin_amdgcn_readfirstlane(mem); nmem = __builtin_amdgcn_readfirstlane(nmem);
#else
#define PEER_GROUP const int grp = bx & 7, mem = bx >> 3, nmem = G >> 3;
#endif
#define ABUF ((bf16*)(ws + WS_A))
#define PROJ ((bf16*)(ws + WS_PROJ))
#define UST ((bf16*)(ws + WS_US))
#define DECAY ((float*)(ws + WS_DECAY))

    if (IN(0)) REPS(0) { PH_IDS p0_prologue(args.in, ws, lds, vcu, G, tid, rep_ == 0 ? 7 : PROBE_SUB); }
    SEAM(0);
    if (IN(1)) {
        { pg8::Gemm g{ABUF, (const bf16*)(ws + WS_WIN), M, IN_COLS, 512}; pg8::StaticOrder S; S.init(M, IN_COLS, G, bx, ((PROBE_MASK >> 1) & 1) ? PROBE_REP : 1);
          pg8::EpiBf16I8 E{PROJ, IN_COLS, (const float*)(ws + WS_PART1), (const float*)(ws + WS_WIN + 4 * MiB)};
          pg8::gemm_phase_i8<pg8::EpiBf16I8, pg8::StaticOrder, PG8_ALIGN, PG8_SP2>(lds, g, S, E, TID_FLAT); }
        { pg8::Gemm g{(const bf16*)(ws + WS_MEMN), (const bf16*)(ws + WS_WKV), MROWS, 1024, 1024}; pg8::StaticOrder S; S.init(MROWS, 1024, G, bx); pg8::EpiTile E{(bf16*)(ws + WS_KB), 4, 1};
          pg8::gemm_phase<pg8::EpiTile, pg8::StaticOrder, PG8_ALIGN, PG8_SP2>(lds, g, S, E, TID_FLAT); }
        { pg8::Gemm g{(const bf16*)(ws + WS_WKV) + (size_t)1024 * 1024, (const bf16*)(ws + WS_MEMN), 1024, MROWS, 1024}; pg8::StaticOrder S; S.init(1024, MROWS, G, (bx + 128) % G); pg8::EpiTile E{(bf16*)(ws + WS_VT), 1, 4};
          pg8::gemm_phase<pg8::EpiTile, pg8::StaticOrder, PG8_ALIGN, PG8_SP2>(lds, g, S, E, TID_FLAT); }
    }
    SEAM(1);
    if (IN(2)) REPS(2) { PH_IDS
        for (int m = 4 * gw; m < M; m += 4 * NGW) conv_tokens4(PROJ, args.in[4], args.in[5], ABUF, m, lane);
        for (int u = vcu; u < BATCH * 128; u += G) h1_unit(u >> 7, u & 127, PROJ, args.in[6], UST, DECAY, lds, tid);
    }
    SEAM(2);
    if (IN(3)) REPS(3) { PH_IDS const bool dry = rep_ + 1 < ((((PROBE_MASK >> 3) & 1) ? PROBE_REP : 1)); h2_scan(UST, DECAY, gw, NGW, lane, dry ? (long)((WS_X + 288 * MiB - WS_US) / 4) : 0L); }
    SEAM(3);
    if (IN(4)) REPS(4) { PH_IDS for (int u = vcu; u < BATCH * 128 * 4; u += G) h3_unit(u >> 9, (u >> 2) & 127, u & 3, PROJ, args.in[6], UST, args.in[7], ABUF, lds, tid); }
    SEAM(4);
    if (IN(5)) {
        pg8::Gemm g{ABUF, (const bf16*)(ws + WS_WOUT), M, 1024, 1024}; pg8::StaticOrder S; S.init(M, 1024, G, bx, ((PROBE_MASK >> 5) & 1) ? PROBE_REP : 1);
        pg8::EpiResid E{args.in[0], nullptr, (bf16*)(ws + WS_B1), (float*)(ws + WS_PART1), 0};
        pg8::gemm_phase<pg8::EpiResid, pg8::StaticOrder, PG8_ALIGN, PG8_SP2>(lds, g, S, E, TID_FLAT);
    }
    SEAM(5);
    if (IN(6)) {
        pg8::Gemm g{(const bf16*)(ws + WS_B1), (const bf16*)(ws + WS_WQ), M, 1024, 1024}; pg8::StaticOrder S; S.init(M, 1024, G, bx, ((PROBE_MASK >> 6) & 1) ? PROBE_REP : 1);
        pg8::EpiScaleBf16 E{(bf16*)(ws + WS_Q), 1024, (const float*)(ws + WS_PART1), QSCALE};
        pg8::gemm_phase<pg8::EpiScaleBf16, pg8::StaticOrder, PG8_ALIGN, PG8_SP2>(lds, g, S, E, TID_FLAT);
    }
    SEAM(6);
    if (IN(7)) REPS(7) { PH_IDS attn_phase((const bf16*)(ws + WS_Q), (const bf16*)(ws + WS_KB), (const bf16*)(ws + WS_VT), ABUF, lds, tid, vcu, G); }
    SEAM(7);
    if (IN(8)) {
        pg8::Gemm g{ABUF, (const bf16*)(ws + WS_WO), M, 1024, 1024}; pg8::StaticOrder S; S.init(M, 1024, G, bx, ((PROBE_MASK >> 8) & 1) ? PROBE_REP : 1);
        pg8::EpiResid E{nullptr, (const bf16*)(ws + WS_B1), (bf16*)(ws + WS_X2S), (float*)(ws + WS_PART2), M};
        pg8::gemm_phase<pg8::EpiResid, pg8::StaticOrder, PG8_ALIGN, PG8_SP2>(lds, g, S, E, TID_FLAT);
    }
    SEAM(8);
    if (IN(9)) REPS(9) { PH_IDS
        const int sel = rep_ == 0 ? 7 : PROBE_SUB;
        if (sel & 4) for (int m = gw; m < M; m += 4 * NGW) quant_x2_rows4((const bf16*)(ws + WS_X2S), ws + WS_XQ, (float*)(ws + WS_XSCALE), m, NGW, lane);
        if (sel & 2) for (int e = gw; e < NEXP; e += 2 * NGW) {
            const int e2 = e + NGW < NEXP ? e + NGW : e;
            quant_rows4(args.in[17], args.in[18], args.in[14], ws + WS_PDOWN, ws + WS_PUP, e, e2, lane, (float*)(ws + WS_DSCALE), (float*)(ws + WS_USCALE)); }
    }
    SEAM(9);
    if (IN(10)) {
        pg8::Gemm g{(const bf16*)(ws + WS_XQ), (const bf16*)(ws + WS_WEFF), M, 2048, 512, 64}; pg8::StaticOrder S; S.init(M, 2048, G, bx, ((PROBE_MASK >> 10) & 1) ? PROBE_REP : 1);
        pg8::EpiScoresI8 E{(unsigned short*)(ws + WS_SCT), M, (const float*)(ws + WS_PART2), (const float*)(ws + WS_XSCALE), (const float*)(ws + WS_WEFF + 2 * MiB)};
        pg8::gemm_phase_i8<pg8::EpiScoresI8, pg8::StaticOrder, PG8_ALIGN, PG8_SP2>(lds, g, S, E, TID_FLAT);
    }
    SEAM(10);
    if (IN(11)) REPS(11) { PH_IDS
        for (int task = gw; task < 8 * (M / 64); task += NGW) { const int head = task & 7, token = (task >> 3) * 64 + lane;
            peer_topk_task((const unsigned short*)(ws + WS_SCT), head, token, (unsigned short*)(ws + WS_IDX), (float*)(ws + WS_GATE), lds + tid * 32); }
    }
    SEAM(11);
    if (IN(12)) REPS(12) { PH_IDS PEER_GROUP
        peer_down_phase(ws + WS_XQ, ws + WS_PDOWN, (const unsigned short*)(ws + WS_IDX), (unsigned*)(ws + WS_SCT), grp, mem * NWAVES + wave, nmem * NWAVES, lane);
    }
    SEAM(12);
    if (IN(13)) REPS(13) { PH_IDS
        for (int t = gw; t < M; t += 4 * NGW) peer_combine_tokens4((const unsigned*)(ws + WS_SCT), (const float*)(ws + WS_PART2), (const unsigned short*)(ws + WS_IDX), (const float*)(ws + WS_DSCALE), (const float*)(ws + WS_USCALE),
                                                                          (const float*)(ws + WS_XSCALE), (const float*)(ws + WS_GATE), (unsigned*)(ws + WS_WPK), (float*)(ws + WS_CORR), t, NGW, lane); }
    SEAM(13);
    if (IN(14)) REPS(14) { PH_IDS PEER_GROUP
        const bool dry = rep_ + 1 < ((((PROBE_MASK >> 14) & 1) ? PROBE_REP : 1));
        peer_up_phase((bf16*)(ws + WS_X2S), (bf16*)(ws + (dry ? WS_PROBE_DUMMY : WS_X2S)), ws + WS_PUP, (const unsigned short*)(ws + WS_IDX), (const unsigned*)(ws + WS_WPK), (const float*)(ws + WS_CORR), grp, mem * NWAVES + wave, nmem * NWAVES, lane, lds + wave * 16384); }
    SEAM(14);
    if (IN(15)) REPS(15) { PH_IDS final_norm_phase((const bf16*)(ws + WS_X2S), args.out, args.in[19], gw, NGW, lane); }
    PROBE_T_MARK(15);
#ifdef PROBE_T
    if (bx == 0 && TID_FLAT == 0) { const unsigned long long t0_ = *(volatile LAS unsigned long long*)(lds + LDS_MISC + 128), t1_ = *(volatile LAS unsigned long long*)(lds + LDS_MISC + 136);
        if (t1_ > t0_) { const unsigned long long te_ = wall_clock64(); while (wall_clock64() - te_ < (t1_ - t0_) * PROBE_T_MUL) __builtin_amdgcn_s_sleep(8); } }
#endif
#undef IN
#undef SEAM
}

extern "C" void kernel_launch(void* const* d_in, const int* in_sizes, int n_in, void* d_out, int out_size, void* d_ws, size_t ws_size, hipStream_t stream) {
    static int grid = 0;
    if (grid == 0) {
        if (n_in != 20 || in_sizes[0] != M * D || out_size != M * D || ws_size < WS_END) { fprintf(stderr, "kernel_launch: unexpected shapes: n_in %d in0 %d out %d ws %zu (need %zu)\n", n_in, n_in > 0 ? in_sizes[0] : -1, out_size, ws_size, (size_t)WS_END); grid = -1; return; }
        int dev = 0, cus = 0, per_cu = 0;
        if (hipGetDevice(&dev) != hipSuccess || hipDeviceGetAttribute(&cus, hipDeviceAttributeMultiprocessorCount, dev) != hipSuccess) { grid = -1; return; }
        if (hipFuncSetAttribute((const void*)fwd, hipFuncAttributeMaxDynamicSharedMemorySize, LDS_BYTES) != hipSuccess) { fprintf(stderr, "kernel_launch: hipFuncSetAttribute failed\n"); grid = -1; return; }
        if (hipOccupancyMaxActiveBlocksPerMultiprocessor(&per_cu, (const void*)fwd, NT, LDS_BYTES) != hipSuccess || per_cu < 1) { fprintf(stderr, "kernel_launch: occupancy query says %d blocks per CU\n", per_cu); (void)hipGetLastError(); grid = -1; return; }
        grid = cus;
    }
    if (grid < 0) return;
    Args a{};
    for (int i = 0; i < 20; ++i) a.in[i] = (const float*)d_in[i];
    a.out = (float*)d_out; a.ws = (unsigned char*)d_ws;
#if MK_N_LAUNCHES == 1
    if (hipMemsetAsync((char*)d_ws + WS_CTL, 0, CTL_ZERO_BYTES, stream) != hipSuccess) { fprintf(stderr, "kernel_launch: hipMemsetAsync failed\n"); return; }
    a.ph_lo = 0; a.ph_hi = N_PHASES;
    void* kargs[] = {&a};
    hipError_t e = hipLaunchCooperativeKernel((const void*)fwd, dim3(grid), dim3(NT), kargs, LDS_BYTES, stream);
    if (e != hipSuccess) fprintf(stderr, "kernel_launch: cooperative launch failed: %s (grid %d)\n", hipGetErrorString(e), grid);
#else
    for (int ph = 0; ph < N_PHASES; ++ph) { a.ph_lo = ph; a.ph_hi = ph + 1; hipLaunchKernelGGL(fwd, dim3(grid), dim3(NT), LDS_BYTES, stream, a); }
#endif
}
```

```cpp
#include <hip/hip_runtime.h>
#include <hip/hip_cooperative_groups.h>
#include <cstdio>
#include <cstdint>
namespace cg = cooperative_groups;

#ifndef MK_N_LAUNCHES
#define MK_N_LAUNCHES 1
#endif

#ifndef PROBE_REP
#define PROBE_REP 1
#endif
#ifndef PROBE_MASK
#define PROBE_MASK 0
#endif

#ifndef PROBE_T_BLK
#define PROBE_T_BLK 0
#endif
#ifndef PROBE_T_MUL
#define PROBE_T_MUL 1
#endif
#ifndef PROBE_SUB
#define PROBE_SUB 7
#endif

namespace pg8 {
#define PG8_LAS __attribute__((address_space(3)))
typedef unsigned short bf16_t;
typedef short bf16x8 __attribute__((ext_vector_type(8)));
typedef float f32x4 __attribute__((ext_vector_type(4)));
typedef unsigned u32x4 __attribute__((ext_vector_type(4)));
constexpr int BM = 256, BK = 64, HALF = 128, HTB = HALF * BK * 2  , STAGE_BYTES = 8 * HTB, NXCD = 8, WGM = 8;

__host__ __device__ __forceinline__ int lds_byte(int r, int c) { const int st = (r >> 4) * 2 + (c >> 5), rr = r & 15, cc = c & 31, ob = rr * 64 + cc * 2; return st * 1024 + (ob ^ (((ob >> 9) & 1) << 5)); }
__host__ __device__ __forceinline__ void stage_rc(int b, int& R, int& C) { const int st = b / 1024, sb = b % 1024, swz = sb ^ (((sb >> 9) & 1) << 5); R = (st >> 1) * 16 + swz / 64; C = (st & 1) * 32 + (swz % 64) / 2; }
__host__ __device__ __forceinline__ int perm32(int rho) { const int n = rho >> 4, i = rho & 15; return 8 * (i >> 2) + 4 * n + (i & 3); }

struct Unit { int pm, pn; };
struct Gemm { const bf16_t* A; const bf16_t* Bt; int M, N, K; int lda; };

struct StaticOrder {
    int nM, nN, nwg, G, c, rep;
    __host__ __device__ void init(int M, int N, int G_, int c_, int rep_ = 1) { nM = M / BM; nN = N / BM; nwg = nM * nN; G = G_; c = c_; rep = rep_; }
    __host__ __device__ bool next(int i, Unit& u) const {
        long L = (long)i * G + c; if (L >= (long)nwg * rep) return false; L %= nwg;
        int wgid = (int)L; { const int q = nwg / NXCD, r = nwg % NXCD, xcd = wgid % NXCD, off = wgid / NXCD; wgid = (xcd < r ? xcd * (q + 1) : r * (q + 1) + (xcd - r) * q) + off; }
        const int nig = WGM * nN, gid = wgid / nig, fm = gid * WGM, gsz = (nM - fm) < WGM ? (nM - fm) : WGM;
        u.pm = fm + ((wgid % nig) % gsz); u.pn = (wgid % nig) / gsz; return true;
    }
    __device__ __forceinline__ void a_ready(const Unit&) const {}
    __device__ __forceinline__ void done(const Unit&) const {}
};


__device__ __forceinline__ float sum_x16_x32(float v) {
    { const auto r = __builtin_amdgcn_permlane16_swap(__float_as_uint(v), __float_as_uint(v), false, false); v = __uint_as_float(r[0]) + __uint_as_float(r[1]); }
    { const auto r = __builtin_amdgcn_permlane32_swap(__float_as_uint(v), __float_as_uint(v), false, false); v = __uint_as_float(r[0]) + __uint_as_float(r[1]); }
    return v;
}
__device__ __forceinline__ unsigned cvt_pk_bf16(float lo, float hi) { unsigned r; asm volatile("v_cvt_pk_bf16_f32 %0, %1, %2" : "=v"(r) : "v"(lo), "v"(hi)); return r; }

struct EpiBf16 {
    static constexpr bool PERM = true, AFTER_DRAIN = false;
    bf16_t* O; int ldc;
    __device__ __forceinline__ void operator()(const f32x4 (&acc)[2][2][4][2], const Unit& u, int wr, int wc, int fr, int fq) const {
        const int row0 = u.pm * BM + wr * 64 + fr, col0 = u.pn * BM + wc * 32 + 8 * fq;
#pragma unroll
        for (int ai = 0; ai < 2; ++ai)
#pragma unroll
            for (int m = 0; m < 4; ++m) { bf16_t* rowp = O + (size_t)(row0 + ai * HALF + m * 16) * ldc + col0;
#pragma unroll
                for (int bj = 0; bj < 2; ++bj) { const f32x4 v0 = acc[ai][bj][m][0], v1 = acc[ai][bj][m][1];
                    u32x4 w; w.x = cvt_pk_bf16(v0[0], v0[1]); w.y = cvt_pk_bf16(v0[2], v0[3]); w.z = cvt_pk_bf16(v1[0], v1[1]); w.w = cvt_pk_bf16(v1[2], v1[3]);
                    *(u32x4*)(rowp + bj * HALF) = w; } }
    }
};
struct EpiTile {
    static constexpr bool PERM = true, AFTER_DRAIN = false;
    bf16_t* O; int sm, sn;
    __device__ __forceinline__ void operator()(const f32x4 (&acc)[2][2][4][2], const Unit& u, int wr, int wc, int fr, int fq) const {
        bf16_t* base = O + (size_t)(u.pm * sm + u.pn * sn) * 65536 + (size_t)(wr * 64 + fr) * 256 + wc * 32 + 8 * fq;
#pragma unroll
        for (int ai = 0; ai < 2; ++ai)
#pragma unroll
            for (int m = 0; m < 4; ++m) { bf16_t* rowp = base + (size_t)(ai * HALF + m * 16) * 256;
#pragma unroll
                for (int bj = 0; bj < 2; ++bj) { const f32x4 v0 = acc[ai][bj][m][0], v1 = acc[ai][bj][m][1];
                    u32x4 w; w.x = cvt_pk_bf16(v0[0], v0[1]); w.y = cvt_pk_bf16(v0[2], v0[3]); w.z = cvt_pk_bf16(v1[0], v1[1]); w.w = cvt_pk_bf16(v1[2], v1[3]);
                    *(u32x4*)(rowp + bj * HALF) = w; } }
    }
};
struct EpiResid {
    static constexpr bool PERM = true, AFTER_DRAIN = false;
    const float* basef; const bf16_t* baseb; bf16_t* xb; float* part; int sliced;
    __device__ __forceinline__ void operator()(const f32x4 (&acc)[2][2][4][2], const Unit& u, int wr, int wc, int fr, int fq) const {
        const int row0 = u.pm * BM + wr * 64 + fr, col0 = u.pn * BM + wc * 32 + 8 * fq;
#pragma unroll
        for (int ai = 0; ai < 2; ++ai)
#pragma unroll
            for (int m = 0; m < 4; ++m) { const int row = row0 + ai * HALF + m * 16; const size_t off = (size_t)row * 1024 + col0; float s = 0.f;
#pragma unroll
                for (int bj = 0; bj < 2; ++bj) {
                    f32x4 b0, b1;
                    if (basef) { b0 = *(const f32x4*)(basef + off + bj * HALF); b1 = *(const f32x4*)(basef + off + bj * HALF + 4); }
                    else { const u32x4 bw = *(const u32x4*)(baseb + off + bj * HALF);
                        b0 = (f32x4){__uint_as_float(bw.x << 16), __uint_as_float(bw.x & 0xffff0000u), __uint_as_float(bw.y << 16), __uint_as_float(bw.y & 0xffff0000u)};
                        b1 = (f32x4){__uint_as_float(bw.z << 16), __uint_as_float(bw.z & 0xffff0000u), __uint_as_float(bw.w << 16), __uint_as_float(bw.w & 0xffff0000u)}; }
                    const f32x4 v0 = acc[ai][bj][m][0] + b0, v1 = acc[ai][bj][m][1] + b1;
                    u32x4 w; w.x = cvt_pk_bf16(v0[0], v0[1]); w.y = cvt_pk_bf16(v0[2], v0[3]); w.z = cvt_pk_bf16(v1[0], v1[1]); w.w = cvt_pk_bf16(v1[2], v1[3]);
                    if (sliced) { const int col = col0 + bj * HALF; *(u32x4*)(xb + ((size_t)(col >> 6) * sliced + row) * 64 + (col & 63)) = w; }
                    else *(u32x4*)(xb + off + bj * HALF) = w;
                    s += (v0[0] * v0[0] + v0[1] * v0[1]) + (v0[2] * v0[2] + v0[3] * v0[3]) + (v1[0] * v1[0] + v1[1] * v1[1]) + (v1[2] * v1[2] + v1[3] * v1[3]); }
                s = sum_x16_x32(s);
                if (fq == 0) part[(size_t)row * 16 + u.pn * 4 + wc] = s; }
    }
};
__device__ __forceinline__ float row_rstd(const float* part, int row, int fq) {
    const f32x4 p = *(const f32x4*)(part + (size_t)row * 16 + 4 * fq); float t = (p[0] + p[1]) + (p[2] + p[3]);
    t = sum_x16_x32(t);
    return rsqrtf(t * (1.0f / 1024.0f) + 1e-6f);
}
struct EpiScaleBf16 {
    static constexpr bool PERM = true, AFTER_DRAIN = false;
    bf16_t* O; int ldc; const float* part; float scale;
    __device__ __forceinline__ void operator()(const f32x4 (&acc)[2][2][4][2], const Unit& u, int wr, int wc, int fr, int fq) const {
        const int row0 = u.pm * BM + wr * 64 + fr, col0 = u.pn * BM + wc * 32 + 8 * fq;
#pragma unroll
        for (int ai = 0; ai < 2; ++ai)
#pragma unroll
            for (int m = 0; m < 4; ++m) { const int row = row0 + ai * HALF + m * 16; const float sc = row_rstd(part, row, fq) * scale; bf16_t* rowp = O + (size_t)row * ldc + col0;
#pragma unroll
                for (int bj = 0; bj < 2; ++bj) { const f32x4 v0 = acc[ai][bj][m][0] * sc, v1 = acc[ai][bj][m][1] * sc;
                    u32x4 w; w.x = cvt_pk_bf16(v0[0], v0[1]); w.y = cvt_pk_bf16(v0[2], v0[3]); w.z = cvt_pk_bf16(v1[0], v1[1]); w.w = cvt_pk_bf16(v1[2], v1[3]);
                    *(u32x4*)(rowp + bj * HALF) = w; } }
    }
};
typedef int i32x4e __attribute__((ext_vector_type(4)));
typedef _Float16 f16x4 __attribute__((ext_vector_type(4)));
typedef _Float16 f16x2 __attribute__((ext_vector_type(2)));
struct EpiScoresT {
    static constexpr bool PERM = false, AFTER_DRAIN = false;
    unsigned short* scT; int Mtok; const float* part;
    __device__ __forceinline__ void operator()(const f32x4 (&acc)[2][2][4][2], const Unit& u, int wr, int wc, int fr, int fq) const {
        const int row0 = u.pm * BM + wr * 64 + fr;
#pragma unroll
        for (int ai = 0; ai < 2; ++ai)
#pragma unroll
            for (int m = 0; m < 4; ++m) { const int row = row0 + ai * HALF + m * 16; const float sc = row_rstd(part, row, fq);
#pragma unroll
                for (int bj = 0; bj < 2; ++bj)
#pragma unroll
                    for (int n = 0; n < 2; ++n) { const int hp = 2 * u.pn + bj, kq = 8 * wc + 4 * n + fq; const f32x4 v = acc[ai][bj][m][n] * sc;
                        *(f16x4*)(scT + ((size_t)(hp * 32 + kq) * Mtok + row) * 4) = (f16x4){(_Float16)v[0], (_Float16)v[1], (_Float16)v[2], (_Float16)v[3]}; } }
    }
};
struct EpiBf16I8 {
    static constexpr bool PERM = true, AFTER_DRAIN = false;
    bf16_t* O; int ldc; const float* rowscale; const float* colscale;
    __device__ __forceinline__ void operator()(const i32x4e (&acc)[2][2][4][2], const Unit& u, int wr, int wc, int fr, int fq) const {
        const int row0 = u.pm * BM + wr * 64 + fr, col0 = u.pn * BM + wc * 32 + 8 * fq;
        f32x4 cs[2][2];
#pragma unroll
        for (int bj = 0; bj < 2; ++bj) { cs[bj][0] = *(const f32x4*)(colscale + col0 + bj * HALF); cs[bj][1] = *(const f32x4*)(colscale + col0 + bj * HALF + 4); }
        float rs[2][4];
#pragma unroll
        for (int ai = 0; ai < 2; ++ai)
#pragma unroll
            for (int m = 0; m < 4; ++m) rs[ai][m] = rowscale[row0 + ai * HALF + m * 16];
#pragma unroll
        for (int ai = 0; ai < 2; ++ai)
#pragma unroll
            for (int m = 0; m < 4; ++m) { bf16_t* rowp = O + (size_t)(row0 + ai * HALF + m * 16) * ldc + col0; const float r_ = rs[ai][m];
#pragma unroll
                for (int bj = 0; bj < 2; ++bj) { const i32x4e a0 = acc[ai][bj][m][0], a1 = acc[ai][bj][m][1]; const f32x4 c0 = cs[bj][0] * r_, c1 = cs[bj][1] * r_;
                    u32x4 w; w.x = cvt_pk_bf16((float)a0[0] * c0[0], (float)a0[1] * c0[1]); w.y = cvt_pk_bf16((float)a0[2] * c0[2], (float)a0[3] * c0[3]);
                    w.z = cvt_pk_bf16((float)a1[0] * c1[0], (float)a1[1] * c1[1]); w.w = cvt_pk_bf16((float)a1[2] * c1[2], (float)a1[3] * c1[3]);
                    *(u32x4*)(rowp + bj * HALF) = w; } }
    }
};
struct EpiScoresI8 {
    static constexpr bool PERM = false, AFTER_DRAIN = false;
    unsigned short* scT; int Mtok; const float* part; const float* xscale; const float* wscale;
    __device__ __forceinline__ void operator()(const i32x4e (&acc)[2][2][4][2], const Unit& u, int wr, int wc, int fr, int fq) const {
        const int row0 = u.pm * BM + wr * 64 + fr, colb = u.pn * BM + wc * 32 + 4 * fq;
        f32x4 ws[2][2];
#pragma unroll
        for (int bj = 0; bj < 2; ++bj)
#pragma unroll
            for (int n = 0; n < 2; ++n) ws[bj][n] = *(const f32x4*)(wscale + colb + bj * HALF + 16 * n);
#pragma unroll
        for (int ai = 0; ai < 2; ++ai)
#pragma unroll
            for (int m = 0; m < 4; ++m) { const int row = row0 + ai * HALF + m * 16; const float sc = row_rstd(part, row, fq) * xscale[row];
#pragma unroll
                for (int bj = 0; bj < 2; ++bj)
#pragma unroll
                    for (int n = 0; n < 2; ++n) { const int hp = 2 * u.pn + bj, kq = 8 * wc + 4 * n + fq; const i32x4e a = acc[ai][bj][m][n]; const f32x4 w = ws[bj][n];
                        *(f16x4*)(scT + ((size_t)(hp * 32 + kq) * Mtok + row) * 4) = (f16x4){(_Float16)((float)a[0] * sc * w[0]), (_Float16)((float)a[1] * sc * w[1]), (_Float16)((float)a[2] * sc * w[2]), (_Float16)((float)a[3] * sc * w[3])}; } }
    }
};

template <class Epi, class Sched, bool ALIGN_EPI = false, bool SP2 = false>
__device__ __forceinline__ void gemm_phase(PG8_LAS unsigned char* lds, const Gemm g, const Sched& S, const Epi& E, const int tid) {
    const int wid = __builtin_amdgcn_readfirstlane(tid >> 6), lane = tid & 63, wr = wid >> 2, wc = wid & 3, fr = lane & 15, fq = lane >> 4;
    const int K = g.K, nt = K / BK;
    const int ldA = g.lda ? g.lda : K;
    unsigned voffA[2], voffB[2];
#pragma unroll
    for (int i = 0; i < 2; ++i) { int R, C; stage_rc(tid * 16 + i * 8192, R, C); const int Rb = Epi::PERM ? ((R & ~31) + perm32(R & 31)) : R;
        voffA[i] = (unsigned)(R * ldA + C) * 2u; voffB[i] = (unsigned)(Rb * K + C) * 2u; }
    const size_t kstepA = g.lda ? (size_t)g.M * 64 * 2 : (size_t)(BK * 2);
    const size_t hstepA = (size_t)HALF * ldA * 2, tstepA = 2 * hstepA;
    const size_t kstep = (size_t)(BK * 2);
    const size_t hstep = (size_t)HALF * K * 2;
    const size_t tstep = 2 * hstep;
    const unsigned ldsw = (unsigned)wid * 1024u;
    const int aoff = lds_byte(wr * 64 + fr, fq * 8), boff = lds_byte(wc * 32 + fr, fq * 8);
#define PG8_SA(b, h) (((b) * 2 + (h)) * HTB)
#define PG8_SB(b, h) ((4 + (b) * 2 + (h)) * HTB)
#define PG8_STAGE(bufoff, gbase, voff) do { _Pragma("unroll") for (int _i = 0; _i < 2; ++_i) \
        __builtin_amdgcn_global_load_lds((const unsigned*)((const char*)(gbase) + (voff)[_i]), (PG8_LAS unsigned*)(lds + (bufoff) + ldsw + _i * 8192), 16, 0, 0); } while (0)
#define PG8_LDA(dst, b, h) do { _Pragma("unroll") for (int m = 0; m < 4; ++m) _Pragma("unroll") for (int k = 0; k < 2; ++k) dst[m][k] = *(const PG8_LAS bf16x8*)(lds + PG8_SA(b, h) + aoff + m * 2048 + k * 1024); } while (0)
#define PG8_LDB(dst, b, h) do { _Pragma("unroll") for (int n = 0; n < 2; ++n) _Pragma("unroll") for (int k = 0; k < 2; ++k) dst[n][k] = *(const PG8_LAS bf16x8*)(lds + PG8_SB(b, h) + boff + n * 2048 + k * 1024); } while (0)
#define PG8_MMA(ai, bj, At, Bt) do { __builtin_amdgcn_s_setprio(1); _Pragma("unroll") for (int m = 0; m < 4; ++m) _Pragma("unroll") for (int n = 0; n < 2; ++n) _Pragma("unroll") for (int k = 0; k < 2; ++k) \
        acc[ai][bj][m][n] = __builtin_amdgcn_mfma_f32_16x16x32_bf16(Bt[n][k], At[m][k], acc[ai][bj][m][n], 0, 0, 0); __builtin_amdgcn_s_setprio(0); } while (0)
#define PG8_WAIT_V(n) asm volatile("s_waitcnt vmcnt(" #n ")" ::: "memory")
#define PG8_WAIT_L(n) asm volatile("s_waitcnt lgkmcnt(" #n ")" ::: "memory")
#define PG8_BAR __builtin_amdgcn_s_barrier()
#define PG8_SCHED __builtin_amdgcn_sched_barrier(0)
    Unit cur, nxt; int ui = 0;
    if (!S.next(0, cur)) return;
    f32x4 acc[2][2][4][2];
#pragma unroll
    for (int a = 0; a < 2; ++a)
#pragma unroll
        for (int b = 0; b < 2; ++b)
#pragma unroll
            for (int m = 0; m < 4; ++m)
#pragma unroll
                for (int n = 0; n < 2; ++n) acc[a][b][m][n] = (f32x4){0.f, 0.f, 0.f, 0.f};
    bf16x8 At[4][2], B0[2][2], B1[2][2];
    const char* cA = (const char*)g.A + (size_t)cur.pm * tstepA; const char* cB = (const char*)g.Bt + (size_t)cur.pn * tstep;
    S.a_ready(cur);
    if constexpr (SP2) {
        PG8_STAGE(PG8_SB(0, 0), cB, voffB); PG8_STAGE(PG8_SB(0, 1), cB + hstep, voffB); PG8_STAGE(PG8_SA(0, 0), cA, voffA); PG8_STAGE(PG8_SA(0, 1), cA + hstepA, voffA);
        if (wr == 1) PG8_BAR;
        PG8_WAIT_V(2); PG8_BAR;
        PG8_STAGE(PG8_SB(1, 0), cB + kstep, voffB); PG8_STAGE(PG8_SA(1, 0), cA + kstepA, voffA); PG8_STAGE(PG8_SB(1, 1), cB + hstep + kstep, voffB);
        PG8_WAIT_V(6); PG8_BAR;
    } else {
        PG8_STAGE(PG8_SB(0, 0), cB, voffB); PG8_STAGE(PG8_SA(0, 0), cA, voffA); PG8_STAGE(PG8_SB(0, 1), cB + hstep, voffB); PG8_STAGE(PG8_SA(0, 1), cA + hstepA, voffA);
        if (wr == 1) PG8_BAR;
        PG8_WAIT_V(4); PG8_BAR;
        PG8_STAGE(PG8_SB(1, 0), cB + kstep, voffB); PG8_STAGE(PG8_SA(1, 0), cA + kstepA, voffA); PG8_STAGE(PG8_SB(1, 1), cB + hstep + kstep, voffB);
        PG8_WAIT_V(6); PG8_BAR;
    }
    for (;;) {
        const bool has_next = S.next(ui + 1, nxt);
        const char* nA = has_next ? (const char*)g.A + (size_t)nxt.pm * tstepA : cA; const char* nB = has_next ? (const char*)g.Bt + (size_t)nxt.pn * tstep : cB;
        for (int t = 0; t < nt; t += 2) {
            const bool last = (t == nt - 2);
            const char* a1 = cA + (size_t)(t + 1) * kstepA;
            const char* a2 = last ? nA : cA + (size_t)(t + 2) * kstepA; const char* b2 = last ? nB : cB + (size_t)(t + 2) * kstep;
            const char* a3 = a2 + kstepA; const char* b3 = b2 + kstep;
            if (last && has_next) S.a_ready(nxt);
            if constexpr (SP2) {
            PG8_LDB(B0, 0, 0); PG8_LDB(B1, 0, 1); PG8_SCHED; PG8_LDA(At, 0, 0); PG8_STAGE(PG8_SA(1, 1), a1 + hstepA, voffA);
            PG8_WAIT_V(8); PG8_WAIT_L(0); PG8_BAR; PG8_MMA(0, 0, At, B0); PG8_MMA(0, 1, At, B1); PG8_BAR; PG8_SCHED;
            PG8_LDA(At, 0, 1); PG8_STAGE(PG8_SB(0, 0), b2, voffB); PG8_STAGE(PG8_SB(0, 1), b2 + hstep, voffB); PG8_STAGE(PG8_SA(0, 0), a2, voffA);
            PG8_WAIT_V(8); PG8_WAIT_L(0); PG8_BAR; PG8_MMA(1, 0, At, B0); PG8_MMA(1, 1, At, B1); PG8_BAR; PG8_SCHED;
            PG8_LDB(B0, 1, 0); PG8_LDB(B1, 1, 1); PG8_SCHED; PG8_LDA(At, 1, 0); PG8_STAGE(PG8_SA(0, 1), a2 + hstepA, voffA);
            PG8_WAIT_V(8); PG8_WAIT_L(0); PG8_BAR; PG8_MMA(0, 0, At, B0); PG8_MMA(0, 1, At, B1); PG8_BAR; PG8_SCHED;
            PG8_LDA(At, 1, 1); PG8_STAGE(PG8_SB(1, 0), b3, voffB); PG8_STAGE(PG8_SB(1, 1), b3 + hstep, voffB); PG8_STAGE(PG8_SA(1, 0), a3, voffA);
            PG8_WAIT_V(8); PG8_WAIT_L(0); PG8_BAR; PG8_MMA(1, 0, At, B0); PG8_MMA(1, 1, At, B1); PG8_BAR; PG8_SCHED;
            } else {
            PG8_LDB(B0, 0, 0); PG8_SCHED; PG8_LDA(At, 0, 0); PG8_STAGE(PG8_SA(1, 1), a1 + hstepA, voffA);
            PG8_WAIT_L(8); PG8_BAR; PG8_WAIT_L(0); PG8_MMA(0, 0, At, B0); PG8_BAR; PG8_SCHED;
            PG8_LDB(B1, 0, 1); PG8_STAGE(PG8_SB(0, 0), b2, voffB);
            PG8_BAR; PG8_WAIT_L(0); PG8_MMA(0, 1, At, B1); PG8_BAR;
            PG8_LDA(At, 0, 1); PG8_STAGE(PG8_SA(0, 0), a2, voffA);
            PG8_BAR; PG8_WAIT_L(0); PG8_MMA(1, 0, At, B0); PG8_BAR; PG8_SCHED;
            PG8_STAGE(PG8_SB(0, 1), b2 + hstep, voffB);
            PG8_WAIT_V(6); PG8_BAR; PG8_MMA(1, 1, At, B1); PG8_BAR;
            PG8_LDB(B0, 1, 0); PG8_SCHED; PG8_LDA(At, 1, 0); PG8_STAGE(PG8_SA(0, 1), a2 + hstepA, voffA);
            PG8_WAIT_L(8); PG8_BAR; PG8_WAIT_L(0); PG8_MMA(0, 0, At, B0); PG8_BAR; PG8_SCHED;
            PG8_LDB(B1, 1, 1); PG8_STAGE(PG8_SB(1, 0), b3, voffB);
            PG8_BAR; PG8_WAIT_L(0); PG8_MMA(0, 1, At, B1); PG8_BAR;
            PG8_LDA(At, 1, 1); PG8_STAGE(PG8_SA(1, 0), a3, voffA);
            PG8_BAR; PG8_WAIT_L(0); PG8_MMA(1, 0, At, B0); PG8_BAR; PG8_SCHED;
            PG8_STAGE(PG8_SB(1, 1), b3 + hstep, voffB);
            PG8_WAIT_V(6); PG8_BAR; PG8_MMA(1, 1, At, B1); PG8_BAR;
            }
        }
        if constexpr (ALIGN_EPI) { if (wr == 0) PG8_BAR; }
        if constexpr (!Epi::AFTER_DRAIN) { E(acc, cur, wr, wc, fr, fq); S.done(cur); }
        if (!has_next) break;
#pragma unroll
        for (int a = 0; a < 2; ++a)
#pragma unroll
            for (int b = 0; b < 2; ++b)
#pragma unroll
                for (int m = 0; m < 4; ++m)
#pragma unroll
                    for (int n = 0; n < 2; ++n) acc[a][b][m][n] = (f32x4){0.f, 0.f, 0.f, 0.f};
        cur = nxt; cA = nA; cB = nB; ++ui;
        if constexpr (ALIGN_EPI) { if (wr == 1) PG8_BAR; }
    }
    PG8_WAIT_V(0);
    if constexpr (!ALIGN_EPI) { if (wr == 0) PG8_BAR; }
    PG8_BAR;
    if constexpr (Epi::AFTER_DRAIN) { E.fused(acc, cur, wr, wc, fr, fq, lds, wid, lane); S.done(cur); }
#undef PG8_SA
#undef PG8_SB
#undef PG8_STAGE
#undef PG8_LDA
#undef PG8_LDB
#undef PG8_MMA
#undef PG8_WAIT_V
#undef PG8_WAIT_L
#undef PG8_BAR
#undef PG8_SCHED
}
typedef int i32x4 __attribute__((ext_vector_type(4)));
template <class Epi, class Sched, bool ALIGN_EPI = false, bool SP2 = false>
__device__ __forceinline__ void gemm_phase_i8(PG8_LAS unsigned char* lds, const Gemm g, const Sched& S, const Epi& E, const int tid) {
    const int wid = __builtin_amdgcn_readfirstlane(tid >> 6), lane = tid & 63, wr = wid >> 2, wc = wid & 3, fr = lane & 15, fq = lane >> 4;
    const int K = g.K, nt = K / BK;
    const int ldA = g.lda ? g.lda : K;
    unsigned voffA[2], voffB[2];
#pragma unroll
    for (int i = 0; i < 2; ++i) { int R, C; stage_rc(tid * 16 + i * 8192, R, C); const int Rb = Epi::PERM ? ((R & ~31) + perm32(R & 31)) : R;
        voffA[i] = (unsigned)(R * ldA + C) * 2u; voffB[i] = (unsigned)(Rb * K + C) * 2u; }
    const size_t kstepA = g.lda ? (size_t)g.M * 64 * 2 : (size_t)(BK * 2);
    const size_t hstepA = (size_t)HALF * ldA * 2, tstepA = 2 * hstepA;
    const size_t kstep = (size_t)(BK * 2);
    const size_t hstep = (size_t)HALF * K * 2;
    const size_t tstep = 2 * hstep;
    const unsigned ldsw = (unsigned)wid * 1024u;
    const int aoff = lds_byte(wr * 64 + fr, fq * 8), boff = lds_byte(wc * 32 + fr, fq * 8);
#define PG8_SA(b, h) (((b) * 2 + (h)) * HTB)
#define PG8_SB(b, h) ((4 + (b) * 2 + (h)) * HTB)
#define PG8_STAGE(bufoff, gbase, voff) do { _Pragma("unroll") for (int _i = 0; _i < 2; ++_i) \
        __builtin_amdgcn_global_load_lds((const unsigned*)((const char*)(gbase) + (voff)[_i]), (PG8_LAS unsigned*)(lds + (bufoff) + ldsw + _i * 8192), 16, 0, 0); } while (0)
#define PG8_LDA(dst, b, h) do { _Pragma("unroll") for (int m = 0; m < 4; ++m) _Pragma("unroll") for (int k = 0; k < 2; ++k) dst[m][k] = *(const PG8_LAS bf16x8*)(lds + PG8_SA(b, h) + aoff + m * 2048 + k * 1024); } while (0)
#define PG8_LDB(dst, b, h) do { _Pragma("unroll") for (int n = 0; n < 2; ++n) _Pragma("unroll") for (int k = 0; k < 2; ++k) dst[n][k] = *(const PG8_LAS bf16x8*)(lds + PG8_SB(b, h) + boff + n * 2048 + k * 1024); } while (0)
#define PG8_MMA(ai, bj, At, Bt) do { __builtin_amdgcn_s_setprio(1); _Pragma("unroll") for (int m = 0; m < 4; ++m) _Pragma("unroll") for (int n = 0; n < 2; ++n) _Pragma("unroll") for (int k = 0; k < 2; ++k) \
        acc[ai][bj][m][n] = __builtin_amdgcn_mfma_i32_16x16x64_i8(__builtin_bit_cast(i32x4, Bt[n][k]), __builtin_bit_cast(i32x4, At[m][k]), acc[ai][bj][m][n], 0, 0, 0); __builtin_amdgcn_s_setprio(0); } while (0)
#define PG8_WAIT_V(n) asm volatile("s_waitcnt vmcnt(" #n ")" ::: "memory")
#define PG8_WAIT_L(n) asm volatile("s_waitcnt lgkmcnt(" #n ")" ::: "memory")
#define PG8_BAR __builtin_amdgcn_s_barrier()
#define PG8_SCHED __builtin_amdgcn_sched_barrier(0)
    Unit cur, nxt; int ui = 0;
    if (!S.next(0, cur)) return;
    i32x4 acc[2][2][4][2];
#pragma unroll
    for (int a = 0; a < 2; ++a)
#pragma unroll
        for (int b = 0; b < 2; ++b)
#pragma unroll
            for (int m = 0; m < 4; ++m)
#pragma unroll
                for (int n = 0; n < 2; ++n) acc[a][b][m][n] = (i32x4){0, 0, 0, 0};
    bf16x8 At[4][2], B0[2][2], B1[2][2];
    const char* cA = (const char*)g.A + (size_t)cur.pm * tstepA; const char* cB = (const char*)g.Bt + (size_t)cur.pn * tstep;
    S.a_ready(cur);
    if constexpr (SP2) {
        PG8_STAGE(PG8_SB(0, 0), cB, voffB); PG8_STAGE(PG8_SB(0, 1), cB + hstep, voffB); PG8_STAGE(PG8_SA(0, 0), cA, voffA); PG8_STAGE(PG8_SA(0, 1), cA + hstepA, voffA);
        if (wr == 1) PG8_BAR;
        PG8_WAIT_V(2); PG8_BAR;
        PG8_STAGE(PG8_SB(1, 0), cB + kstep, voffB); PG8_STAGE(PG8_SA(1, 0), cA + kstepA, voffA); PG8_STAGE(PG8_SB(1, 1), cB + hstep + kstep, voffB);
        PG8_WAIT_V(6); PG8_BAR;
    } else {
        PG8_STAGE(PG8_SB(0, 0), cB, voffB); PG8_STAGE(PG8_SA(0, 0), cA, voffA); PG8_STAGE(PG8_SB(0, 1), cB + hstep, voffB); PG8_STAGE(PG8_SA(0, 1), cA + hstepA, voffA);
        if (wr == 1) PG8_BAR;
        PG8_WAIT_V(4); PG8_BAR;
        PG8_STAGE(PG8_SB(1, 0), cB + kstep, voffB); PG8_STAGE(PG8_SA(1, 0), cA + kstepA, voffA); PG8_STAGE(PG8_SB(1, 1), cB + hstep + kstep, voffB);
        PG8_WAIT_V(6); PG8_BAR;
    }
    for (;;) {
        const bool has_next = S.next(ui + 1, nxt);
        const char* nA = has_next ? (const char*)g.A + (size_t)nxt.pm * tstepA : cA; const char* nB = has_next ? (const char*)g.Bt + (size_t)nxt.pn * tstep : cB;
        for (int t = 0; t < nt; t += 2) {
            const bool last = (t == nt - 2);
            const char* a1 = cA + (size_t)(t + 1) * kstepA;
            const char* a2 = last ? nA : cA + (size_t)(t + 2) * kstepA; const char* b2 = last ? nB : cB + (size_t)(t + 2) * kstep;
            const char* a3 = a2 + kstepA; const char* b3 = b2 + kstep;
            if (last && has_next) S.a_ready(nxt);
            if constexpr (SP2) {
            PG8_LDB(B0, 0, 0); PG8_LDB(B1, 0, 1); PG8_SCHED; PG8_LDA(At, 0, 0); PG8_STAGE(PG8_SA(1, 1), a1 + hstepA, voffA);
            PG8_WAIT_V(8); PG8_WAIT_L(0); PG8_BAR; PG8_MMA(0, 0, At, B0); PG8_MMA(0, 1, At, B1); PG8_BAR; PG8_SCHED;
            PG8_LDA(At, 0, 1); PG8_STAGE(PG8_SB(0, 0), b2, voffB); PG8_STAGE(PG8_SB(0, 1), b2 + hstep, voffB); PG8_STAGE(PG8_SA(0, 0), a2, voffA);
            PG8_WAIT_V(8); PG8_WAIT_L(0); PG8_BAR; PG8_MMA(1, 0, At, B0); PG8_MMA(1, 1, At, B1); PG8_BAR; PG8_SCHED;
            PG8_LDB(B0, 1, 0); PG8_LDB(B1, 1, 1); PG8_SCHED; PG8_LDA(At, 1, 0); PG8_STAGE(PG8_SA(0, 1), a2 + hstepA, voffA);
            PG8_WAIT_V(8); PG8_WAIT_L(0); PG8_BAR; PG8_MMA(0, 0, At, B0); PG8_MMA(0, 1, At, B1); PG8_BAR; PG8_SCHED;
            PG8_LDA(At, 1, 1); PG8_STAGE(PG8_SB(1, 0), b3, voffB); PG8_STAGE(PG8_SB(1, 1), b3 + hstep, voffB); PG8_STAGE(PG8_SA(1, 0), a3, voffA);
            PG8_WAIT_V(8); PG8_WAIT_L(0); PG8_BAR; PG8_MMA(1, 0, At, B0); PG8_MMA(1, 1, At, B1); PG8_BAR; PG8_SCHED;
            } else {
            PG8_LDB(B0, 0, 0); PG8_SCHED; PG8_LDA(At, 0, 0); PG8_STAGE(PG8_SA(1, 1), a1 + hstepA, voffA);
            PG8_WAIT_L(8); PG8_BAR; PG8_WAIT_L(0); PG8_MMA(0, 0, At, B0); PG8_BAR; PG8_SCHED;
            PG8_LDB(B1, 0, 1); PG8_STAGE(PG8_SB(0, 0), b2, voffB);
            PG8_BAR; PG8_WAIT_L(0); PG8_MMA(0, 1, At, B1); PG8_BAR;
            PG8_LDA(At, 0, 1); PG8_STAGE(PG8_SA(0, 0), a2, voffA);
            PG8_BAR; PG8_WAIT_L(0); PG8_MMA(1, 0, At, B0); PG8_BAR; PG8_SCHED;
            PG8_STAGE(PG8_SB(0, 1), b2 + hstep, voffB);
            PG8_WAIT_V(6); PG8_BAR; PG8_MMA(1, 1, At, B1); PG8_BAR;
            PG8_LDB(B0, 1, 0); PG8_SCHED; PG8_LDA(At, 1, 0); PG8_STAGE(PG8_SA(0, 1), a2 + hstepA, voffA);
            PG8_WAIT_L(8); PG8_BAR; PG8_WAIT_L(0); PG8_MMA(0, 0, At, B0); PG8_BAR; PG8_SCHED;
            PG8_LDB(B1, 1, 1); PG8_STAGE(PG8_SB(1, 0), b3, voffB);
            PG8_BAR; PG8_WAIT_L(0); PG8_MMA(0, 1, At, B1); PG8_BAR;
            PG8_LDA(At, 1, 1); PG8_STAGE(PG8_SA(1, 0), a3, voffA);
            PG8_BAR; PG8_WAIT_L(0); PG8_MMA(1, 0, At, B0); PG8_BAR; PG8_SCHED;
            PG8_STAGE(PG8_SB(1, 1), b3 + hstep, voffB);
            PG8_WAIT_V(6); PG8_BAR; PG8_MMA(1, 1, At, B1); PG8_BAR;
            }
        }
        if constexpr (ALIGN_EPI) { if (wr == 0) PG8_BAR; }
        if constexpr (!Epi::AFTER_DRAIN) { E(acc, cur, wr, wc, fr, fq); S.done(cur); }
        if (!has_next) break;
#pragma unroll
        for (int a = 0; a < 2; ++a)
#pragma unroll
            for (int b = 0; b < 2; ++b)
#pragma unroll
                for (int m = 0; m < 4; ++m)
#pragma unroll
                    for (int n = 0; n < 2; ++n) acc[a][b][m][n] = (i32x4){0, 0, 0, 0};
        cur = nxt; cA = nA; cB = nB; ++ui;
        if constexpr (ALIGN_EPI) { if (wr == 1) PG8_BAR; }
    }
    PG8_WAIT_V(0);
    if constexpr (!ALIGN_EPI) { if (wr == 0) PG8_BAR; }
    PG8_BAR;
    if constexpr (Epi::AFTER_DRAIN) { E.fused(acc, cur, wr, wc, fr, fq, lds, wid, lane); S.done(cur); }
#undef PG8_SA
#undef PG8_SB
#undef PG8_STAGE
#undef PG8_LDA
#undef PG8_LDB
#undef PG8_MMA
#undef PG8_WAIT_V
#undef PG8_WAIT_L
#undef PG8_BAR
#undef PG8_SCHED
}
}

#ifndef PG8_SP2
#define PG8_SP2 true
#endif
#ifndef PG8_ALIGN
#define PG8_ALIGN true
#endif

constexpr int NWAVES = 8, NT = NWAVES * 64;
constexpr int BATCH = 4, SEQ = 8192, D = 1024, M = BATCH * SEQ;
constexpr int IN_COLS = 3584;
constexpr int NMEM = 256, MROWS = BATCH * NMEM;
constexpr int NEXP = 16384;
constexpr float EPS = 1e-6f;
constexpr float QSCALE = 0.0625f * 1.4426950408889634f;

constexpr size_t MiB = 1u << 20;
constexpr size_t WS_CTL = 0, CTL_ZERO_BYTES = 64 * 1024;
constexpr size_t WS_PART1 = 1 * MiB;
constexpr size_t WS_DECAY = 5 * MiB;
constexpr size_t WS_WIN = 6 * MiB, WS_WOUT = 13 * MiB, WS_WQ = 15 * MiB, WS_WKV = 17 * MiB, WS_WO = 21 * MiB, WS_WEFF = 23 * MiB;
constexpr size_t WS_MEMN = 27 * MiB, WS_KB = 29 * MiB, WS_VT = 31 * MiB;
constexpr size_t WS_PUP = 1 * MiB;
constexpr size_t WS_A = 33 * MiB;
constexpr size_t WS_X = 97 * MiB;
constexpr size_t WS_PROJ = WS_X, WS_US = WS_X + 224 * MiB;
constexpr size_t WS_B1 = WS_X, WS_Q = WS_X + 64 * MiB;
constexpr size_t WS_X2S = WS_X + 64 * MiB;
constexpr size_t WS_SCT = WS_X + 128 * MiB;
constexpr size_t WS_PDOWN = WS_X;
constexpr size_t WS_IDX = WS_A, WS_GATE = WS_A + 8 * MiB;
constexpr size_t WS_PART2 = WS_X + 384 * MiB;
constexpr size_t WS_SSQ = WS_PART2 + 2 * MiB;
constexpr size_t WS_DSCALE = WS_SSQ + 2 * MiB, WS_USCALE = WS_DSCALE + 65536;
constexpr size_t WS_XSCALE = WS_USCALE + 65536, WS_CORR = WS_XSCALE + 131072;
constexpr size_t WS_WPK = WS_A + 56 * MiB;
constexpr size_t WS_XQ = WS_A + 24 * MiB;
constexpr size_t WS_END = WS_CORR + 131072;

constexpr size_t WS_PROBE_DUMMY = WS_X + 256 * MiB;
constexpr int RING_BYTES = 131072, LDS_BYTES = 147456;

#define LAS __attribute__((address_space(3)))
typedef unsigned short bf16;
typedef float f32x2 __attribute__((ext_vector_type(2)));
typedef float f32x4 __attribute__((ext_vector_type(4)));
typedef float f32x16 __attribute__((ext_vector_type(16)));
typedef short bf16x8 __attribute__((ext_vector_type(8)));
typedef unsigned v4u __attribute__((ext_vector_type(4)));
typedef unsigned v2u __attribute__((ext_vector_type(2)));
typedef __bf16 bf16x2_t __attribute__((ext_vector_type(2)));
#define LDS_WAIT() asm volatile("s_waitcnt lgkmcnt(0)" ::: "memory")
__device__ __forceinline__ float bf2f(unsigned short b) { return __uint_as_float(((unsigned)b) << 16); }
__device__ __forceinline__ float bflo(unsigned u) { return __uint_as_float(u << 16); }
__device__ __forceinline__ float bfhi(unsigned u) { return __uint_as_float(u & 0xffff0000u); }
__device__ __forceinline__ unsigned pk2(float lo, float hi) { f32x2 v = {lo, hi}; bf16x2_t b = __builtin_convertvector(v, bf16x2_t); return __builtin_bit_cast(unsigned, b); }
__device__ __forceinline__ float xlane_dpp_b1(float v) { return __uint_as_float((unsigned)__builtin_amdgcn_update_dpp(0, (int)__float_as_uint(v), 0xB1, 0xF, 0xF, false)); }
__device__ __forceinline__ float xlane_dpp_4e(float v) { return __uint_as_float((unsigned)__builtin_amdgcn_update_dpp(0, (int)__float_as_uint(v), 0x4E, 0xF, 0xF, false)); }
__device__ __forceinline__ float xlane_dpp_x4(float v) { int r = __builtin_amdgcn_update_dpp(0, (int)__float_as_uint(v), 0x12C, 0xF, 0x5, false); r = __builtin_amdgcn_update_dpp(r, (int)__float_as_uint(v), 0x124, 0xF, 0xA, false); return __uint_as_float((unsigned)r); }
__device__ __forceinline__ float xlane_dpp_x8(float v) { return __uint_as_float((unsigned)__builtin_amdgcn_update_dpp(0, (int)__float_as_uint(v), 0x128, 0xF, 0xF, false)); }
__device__ __forceinline__ float xlane_x16(float v) { const auto r = __builtin_amdgcn_permlane16_swap(__float_as_uint(v), __float_as_uint(v), false, false); return __uint_as_float((__builtin_amdgcn_mbcnt_lo(~0u, 0u) + __builtin_amdgcn_mbcnt_hi(~0u, 0u)) & 16 ? r[0] : r[1]); }
__device__ __forceinline__ float xlane_x32(float v) { const auto r = __builtin_amdgcn_permlane32_swap(__float_as_uint(v), __float_as_uint(v), false, false); return __uint_as_float((__builtin_amdgcn_mbcnt_lo(~0u, 0u) + __builtin_amdgcn_mbcnt_hi(~0u, 0u)) & 32 ? r[0] : r[1]); }
__device__ __forceinline__ float wave_sum(float v) {
    v += xlane_dpp_b1(v); v += xlane_dpp_4e(v); v += xlane_dpp_x4(v); v += xlane_dpp_x8(v);
    { const auto r = __builtin_amdgcn_permlane16_swap(__float_as_uint(v), __float_as_uint(v), false, false); v = __uint_as_float(r[0]) + __uint_as_float(r[1]); }
    { const auto r = __builtin_amdgcn_permlane32_swap(__float_as_uint(v), __float_as_uint(v), false, false); v = __uint_as_float(r[0]) + __uint_as_float(r[1]); }
    return v;
}
__device__ __forceinline__ float wave_max(float v) {
    v = fmaxf(v, xlane_dpp_b1(v)); v = fmaxf(v, xlane_dpp_4e(v)); v = fmaxf(v, xlane_dpp_x4(v)); v = fmaxf(v, xlane_dpp_x8(v));
    { const auto r = __builtin_amdgcn_permlane16_swap(__float_as_uint(v), __float_as_uint(v), false, false); v = fmaxf(__uint_as_float(r[0]), __uint_as_float(r[1])); }
    { const auto r = __builtin_amdgcn_permlane32_swap(__float_as_uint(v), __float_as_uint(v), false, false); v = fmaxf(__uint_as_float(r[0]), __uint_as_float(r[1])); }
    return v;
}
__device__ __forceinline__ float sigmoidf_(float x) { return __builtin_amdgcn_rcpf(1.0f + __expf(-x)); }
__device__ __forceinline__ int kappa(int rho) { return (rho & 0x13) | ((rho & 4) << 1) | ((rho & 8) >> 1); }
__device__ __forceinline__ bf16x8 as_bf16x8(v4u v) { return __builtin_bit_cast(bf16x8, v); }

__device__ __forceinline__ void p0_transpose_item(const float* W, int K, int N, bf16* WT, const float* gain, LAS float* scr, int item, int lane) {
    const int nblk = N / 32, kb = item / nblk, nb = item % nblk, k0 = 64 * kb, n0 = 32 * nb;
    float wv[32];
#pragma unroll
    for (int i = 0; i < 32; ++i) { const int kk = 2 * i + (lane >> 5); wv[i] = W[(size_t)(k0 + kk) * N + n0 + (lane & 31)]; }
#pragma unroll
    for (int i = 0; i < 32; ++i) { const int kk = 2 * i + (lane >> 5); const float g = gain ? gain[k0 + kk] : 1.0f; scr[kk * 33 + (lane & 31)] = wv[i] * g; }
    LDS_WAIT();
    const int c = lane & 7;
#pragma unroll
    for (int j = 0; j < 4; ++j) { const int n = (lane >> 3) + 8 * j; const LAS float* s = scr + (8 * c) * 33 + n;
        v4u o; o.x = pk2(s[0 * 33], s[1 * 33]); o.y = pk2(s[2 * 33], s[3 * 33]); o.z = pk2(s[4 * 33], s[5 * 33]); o.w = pk2(s[6 * 33], s[7 * 33]);
        *(v4u*)(WT + (size_t)(n0 + n) * K + k0 + 8 * c) = o; }
    LDS_WAIT();
}
__device__ __forceinline__ void rms_row_to_bf16(const float* xrow, const float* gain, bf16* orow, int lane) {
    const f32x4* xr = (const f32x4*)xrow + lane; f32x4 v[4]; float s = 0.f;
#pragma unroll
    for (int j = 0; j < 4; ++j) { v[j] = xr[64 * j]; s += (v[j].x * v[j].x + v[j].y * v[j].y) + (v[j].z * v[j].z + v[j].w * v[j].w); }
    const float r = rsqrtf(wave_sum(s) * (1.0f / 1024.0f) + EPS);
    const f32x4* gr = (const f32x4*)gain + lane; unsigned long long* o8 = (unsigned long long*)orow + lane;
#pragma unroll
    for (int j = 0; j < 4; ++j) { const f32x4 g = gr[64 * j]; o8[64 * j] = (unsigned long long)pk2(v[j].x * r * g.x, v[j].y * r * g.y) | ((unsigned long long)pk2(v[j].z * r * g.z, v[j].w * r * g.w) << 32); }
}
__device__ __forceinline__ void p0_weffq_wg(const float* wquery, const float* subkeys, const float* gain, signed char* WQ, float* wscale, int item, LAS unsigned char* lds, int tid) {
    const int hp = item >> 4, kg = item & 15, lane = tid & 63, wave = tid >> 6;
    LAS f32x4* sk = (LAS f32x4*)lds;
    LAS float* am_s = (LAS float*)(lds + 8192);
    if (tid < 256) sk[tid] = ((const f32x4*)(subkeys + (size_t)(hp * 128 + kg * 8) * 128))[tid];
    __syncthreads();
    float acc[2][8];
#pragma unroll
    for (int ph = 0; ph < 2; ++ph) { const int k = (ph * 8 + wave) * 64 + lane; const f32x4* wrow = (const f32x4*)(wquery + (size_t)k * 2048 + hp * 128);
#pragma unroll
        for (int i = 0; i < 8; ++i) acc[ph][i] = 0.f;
#pragma unroll 4
        for (int d4 = 0; d4 < 32; ++d4) { const f32x4 w = wrow[d4];
#pragma unroll
            for (int key = 0; key < 8; ++key) { const f32x4 sv = sk[key * 32 + d4]; acc[ph][key] += (w.x * sv.x + w.y * sv.y) + (w.z * sv.z + w.w * sv.w); } }
        const float g = gain[k];
#pragma unroll
        for (int i = 0; i < 8; ++i) acc[ph][i] *= g; }
#pragma unroll
    for (int key = 0; key < 8; ++key) { const float m = wave_max(fmaxf(fabsf(acc[0][key]), fabsf(acc[1][key]))); if (lane == 0) am_s[wave * 8 + key] = m; }
    __syncthreads();
    if (tid < 8) { float m = 0.f;
#pragma unroll
        for (int w8 = 0; w8 < 8; ++w8) m = fmaxf(m, am_s[w8 * 8 + tid]);
        am_s[256 + tid] = m; wscale[hp * 128 + kg * 8 + tid] = m * (1.0f / 127.0f); }
    __syncthreads();
#pragma unroll
    for (int key = 0; key < 8; ++key) { const float am = am_s[256 + key]; const float inv = am > 0.f ? 127.0f / am : 0.f;
#pragma unroll
        for (int ph = 0; ph < 2; ++ph) WQ[(size_t)(hp * 128 + kg * 8 + key) * 1024 + (ph * 8 + wave) * 64 + lane] = (signed char)(int)rintf(acc[ph][key] * inv); }
    __syncthreads();
}
__device__ __forceinline__ void p0_win_wg(const float* W, signed char* WQ, float* wscale, int item, LAS unsigned char* lds, int tid) {
    const int n0 = 14 * item, nl = tid & 15, kr = tid >> 4; const bool act = nl < 14;
    LAS float* am_s = (LAS float*)lds;
    LAS unsigned char* tile = lds + 4096;
    float wv[32]; float am = 0.f;
#pragma unroll
    for (int i = 0; i < 32; ++i) wv[i] = act ? W[(size_t)(kr + 32 * i) * IN_COLS + n0 + nl] : 0.f;
#pragma unroll
    for (int i = 0; i < 32; ++i) am = fmaxf(am, fabsf(wv[i]));
    am_s[kr * 16 + nl] = am;
    __syncthreads();
    if (tid < 16) { float m = 0.f;
#pragma unroll
        for (int r = 0; r < 32; ++r) m = fmaxf(m, am_s[r * 16 + tid]);
        am_s[512 + tid] = m; if (tid < 14) wscale[n0 + tid] = m * (1.0f / 127.0f); }
    __syncthreads();
    { const float amx = am_s[512 + nl]; const float inv = amx > 0.f ? 127.0f / amx : 0.f;
      if (act) {
#pragma unroll
          for (int i = 0; i < 32; ++i) tile[nl * 1028 + kr + 32 * i] = (unsigned char)((int)rintf(wv[i] * inv) & 255); } }
    __syncthreads();
    for (int p = tid; p < 14 * 64; p += NT) { const int n = p >> 6, c = p & 63; const LAS unsigned* src = (const LAS unsigned*)(tile + n * 1028 + 16 * c);
        *(v4u*)(WQ + (size_t)(n0 + n) * 1024 + 16 * c) = (v4u){src[0], src[1], src[2], src[3]}; }
    __syncthreads();
}
__device__ __forceinline__ void p0_prologue(const float* const* in, unsigned char* ws, LAS unsigned char* lds, int vcu, int G, int tid, int sel) {
    const int lane = tid & 63, wave = __builtin_amdgcn_readfirstlane(tid >> 6), gw = vcu * NWAVES + wave, NGW = G * NWAVES;
    LAS float* scr = (LAS float*)(lds + wave * 16384);
    const float *x = in[0], *mem = in[1], *mix_norm_w = in[2], *w_in = in[3], *w_out = in[8], *xattn_norm_w = in[9], *mem_norm_w = in[10], *wq = in[11], *wkv = in[12], *wo = in[13],
                *ffn_norm_w = in[14], *w_query = in[15], *sub_keys = in[16];
    if (sel & 1) for (int it = vcu; it < 256; it += G) { p0_weffq_wg(w_query, sub_keys, ffn_norm_w, (signed char*)(ws + WS_WEFF), (float*)(ws + WS_WEFF + 2 * MiB), it, lds, tid);
                                                          p0_win_wg(w_in, (signed char*)(ws + WS_WIN), (float*)(ws + WS_WIN + 4 * MiB), it, lds, tid); }
    constexpr int I_SQ = 16 * 32, I_KV = 16 * 64;
    constexpr int NITEMS = 3 * I_SQ + I_KV;
    if (sel & 2) for (int it = gw; it < NITEMS; it += NGW) {
        int r = it;
        if (r < I_SQ) { p0_transpose_item(w_out, 1024, 1024, (bf16*)(ws + WS_WOUT), nullptr, scr, r, lane); continue; } r -= I_SQ;
        if (r < I_SQ) { p0_transpose_item(wq, 1024, 1024, (bf16*)(ws + WS_WQ), xattn_norm_w, scr, r, lane); continue; } r -= I_SQ;
        if (r < I_KV) { p0_transpose_item(wkv, 1024, 2048, (bf16*)(ws + WS_WKV), nullptr, scr, r, lane); continue; } r -= I_KV;
        p0_transpose_item(wo, 1024, 1024, (bf16*)(ws + WS_WO), nullptr, scr, r, lane);
    }
    if (!(sel & 4)) return;
    for (int m = gw; m < MROWS; m += NGW) rms_row_to_bf16(mem + (size_t)m * D, mem_norm_w, (bf16*)(ws + WS_MEMN) + (size_t)m * D, lane);
    for (int m = gw; m < M; m += 4 * NGW) {
        f32x4 v[4][4]; float ss[4], am[4];
#pragma unroll
        for (int r = 0; r < 4; ++r) { const int mr = m + r * NGW < M ? m + r * NGW : m; const f32x4* xr = (const f32x4*)(x + (size_t)mr * D) + lane;
#pragma unroll
            for (int j = 0; j < 4; ++j) v[r][j] = xr[64 * j]; }
        const f32x4* gr = (const f32x4*)mix_norm_w + lane;
#pragma unroll
        for (int r = 0; r < 4; ++r) { float s = 0.f, a_ = 0.f;
#pragma unroll
            for (int j = 0; j < 4; ++j) { s += (v[r][j].x * v[r][j].x + v[r][j].y * v[r][j].y) + (v[r][j].z * v[r][j].z + v[r][j].w * v[r][j].w); v[r][j] = v[r][j] * gr[64 * j];
                a_ = fmaxf(a_, fmaxf(fmaxf(fabsf(v[r][j].x), fabsf(v[r][j].y)), fmaxf(fabsf(v[r][j].z), fabsf(v[r][j].w)))); }
            ss[r] = s; am[r] = a_; }
#pragma unroll
        for (int r = 0; r < 4; ++r) { ss[r] = wave_sum(ss[r]); am[r] = wave_max(am[r]); }
#pragma unroll
        for (int r = 0; r < 4; ++r) { if (m + r * NGW < M) { const int mr = m + r * NGW; const float rr = rsqrtf(ss[r] * (1.0f / 1024.0f) + EPS), inv = am[r] > 0.f ? 127.0f / am[r] : 0.f;
            unsigned* o4 = (unsigned*)(ws + WS_A + (size_t)mr * D) + lane;
#pragma unroll
            for (int j = 0; j < 4; ++j) { const int q0 = (int)rintf(v[r][j].x * inv), q1 = (int)rintf(v[r][j].y * inv), q2 = (int)rintf(v[r][j].z * inv), q3 = (int)rintf(v[r][j].w * inv);
                o4[64 * j] = (unsigned)(q0 & 255) | ((unsigned)(q1 & 255) << 8) | ((unsigned)(q2 & 255) << 16) | ((unsigned)(q3 & 255) << 24); }
            if (lane == 0) ((float*)(ws + WS_PART1))[mr] = rr * am[r] * (1.0f / 127.0f); } }
    }
}

struct ConvIn { v4u bg, cg0, vv0, cg1, vv1, cg2, vv2; };
__device__ __forceinline__ ConvIn conv_load(const bf16* P, int m, int lane) {
    const int t = m & (SEQ - 1), c0 = 8 * lane; const bf16* row = P + (size_t)m * IN_COLS; ConvIn in;
    in.bg = *(const v4u*)(row + c0); in.cg0 = *(const v4u*)(row + 512 + c0); in.vv0 = *(const v4u*)(row + 1024 + c0);
    in.cg1 = (v4u){0, 0, 0, 0}; in.vv1 = (v4u){0, 0, 0, 0}; in.cg2 = (v4u){0, 0, 0, 0}; in.vv2 = (v4u){0, 0, 0, 0};
    if (t >= 1) { in.cg1 = *(const v4u*)(row - IN_COLS + 512 + c0); in.vv1 = *(const v4u*)(row - IN_COLS + 1024 + c0); }
    if (t >= 2) { in.cg2 = *(const v4u*)(row - 2 * IN_COLS + 512 + c0); in.vv2 = *(const v4u*)(row - 2 * IN_COLS + 1024 + c0); }
    return in;
}
__device__ __forceinline__ void conv_finish(const ConvIn& in, const float* conv_w, const float* conv_norm_w, bf16* Y, int m, int lane) {
    const int c0 = 8 * lane;
    const f32x4 w0a = *(const f32x4*)(conv_w + c0), w0b = *(const f32x4*)(conv_w + c0 + 4);
    const f32x4 w1a = *(const f32x4*)(conv_w + 512 + c0), w1b = *(const f32x4*)(conv_w + 512 + c0 + 4);
    const f32x4 w2a = *(const f32x4*)(conv_w + 1024 + c0), w2b = *(const f32x4*)(conv_w + 1024 + c0 + 4);
    float y[8]; float ss = 0.f;
#pragma unroll
    for (int q = 0; q < 4; ++q) {
#pragma unroll
        for (int hl = 0; hl < 2; ++hl) { const int e = 2 * q + hl;
            const float b = hl ? bfhi(in.bg[q]) : bflo(in.bg[q]);
            const float u0 = (hl ? bfhi(in.cg0[q]) : bflo(in.cg0[q])) * (hl ? bfhi(in.vv0[q]) : bflo(in.vv0[q]));
            const float u1 = (hl ? bfhi(in.cg1[q]) : bflo(in.cg1[q])) * (hl ? bfhi(in.vv1[q]) : bflo(in.vv1[q]));
            const float u2 = (hl ? bfhi(in.cg2[q]) : bflo(in.cg2[q])) * (hl ? bfhi(in.vv2[q]) : bflo(in.vv2[q]));
            const float wt0 = e < 4 ? w0a[e & 3] : w0b[e & 3], wt1 = e < 4 ? w1a[e & 3] : w1b[e & 3], wt2 = e < 4 ? w2a[e & 3] : w2b[e & 3];
            y[e] = b * (wt0 * u2 + wt1 * u1 + wt2 * u0); ss += y[e] * y[e]; } }
    const float r = rsqrtf(wave_sum(ss) * (1.0f / 512.0f) + EPS);
    const f32x4 ga = *(const f32x4*)(conv_norm_w + c0), gb = *(const f32x4*)(conv_norm_w + c0 + 4);
    v4u o; o.x = pk2(y[0] * r * ga[0], y[1] * r * ga[1]); o.y = pk2(y[2] * r * ga[2], y[3] * r * ga[3]); o.z = pk2(y[4] * r * gb[0], y[5] * r * gb[1]); o.w = pk2(y[6] * r * gb[2], y[7] * r * gb[3]);
    *(v4u*)(Y + (size_t)m * 1024 + c0) = o;
}
__device__ __forceinline__ void conv_tokens4(const bf16* P, const float* conv_w, const float* conv_norm_w, bf16* Y, int m0, int lane) {
    const int t0 = m0 & (SEQ - 1), c0 = 8 * lane; const bf16* row = P + (size_t)m0 * IN_COLS;
    v4u bg[4], cg[6], vv[6];
#pragma unroll
    for (int r = 0; r < 4; ++r) bg[r] = *(const v4u*)(row + (size_t)r * IN_COLS + c0);
#pragma unroll
    for (int r = 0; r < 6; ++r) { if (t0 + r - 2 >= 0) { cg[r] = *(const v4u*)(row + (ptrdiff_t)(r - 2) * IN_COLS + 512 + c0); vv[r] = *(const v4u*)(row + (ptrdiff_t)(r - 2) * IN_COLS + 1024 + c0); } else { cg[r] = (v4u){0, 0, 0, 0}; vv[r] = (v4u){0, 0, 0, 0}; } }
    const f32x4 w0a = *(const f32x4*)(conv_w + c0), w0b = *(const f32x4*)(conv_w + c0 + 4);
    const f32x4 w1a = *(const f32x4*)(conv_w + 512 + c0), w1b = *(const f32x4*)(conv_w + 512 + c0 + 4);
    const f32x4 w2a = *(const f32x4*)(conv_w + 1024 + c0), w2b = *(const f32x4*)(conv_w + 1024 + c0 + 4);
    const f32x4 ga = *(const f32x4*)(conv_norm_w + c0), gb = *(const f32x4*)(conv_norm_w + c0 + 4);
    float u[6][8];
#pragma unroll
    for (int r = 0; r < 6; ++r)
#pragma unroll
        for (int q = 0; q < 4; ++q) { u[r][2 * q] = bflo(cg[r][q]) * bflo(vv[r][q]); u[r][2 * q + 1] = bfhi(cg[r][q]) * bfhi(vv[r][q]); }
    float y[4][8], ss[4];
#pragma unroll
    for (int r = 0; r < 4; ++r) { float s = 0.f;
#pragma unroll
        for (int e = 0; e < 8; ++e) { const float b = (e & 1) ? bfhi(bg[r][e >> 1]) : bflo(bg[r][e >> 1]);
            const float wt0 = e < 4 ? w0a[e & 3] : w0b[e & 3], wt1 = e < 4 ? w1a[e & 3] : w1b[e & 3], wt2 = e < 4 ? w2a[e & 3] : w2b[e & 3];
            y[r][e] = b * (wt0 * u[r][e] + wt1 * u[r + 1][e] + wt2 * u[r + 2][e]); s += y[r][e] * y[r][e]; }
        ss[r] = s; }
#pragma unroll
    for (int r = 0; r < 4; ++r) { const float rr = rsqrtf(wave_sum(ss[r]) * (1.0f / 512.0f) + EPS);
        v4u o; o.x = pk2(y[r][0] * rr * ga[0], y[r][1] * rr * ga[1]); o.y = pk2(y[r][2] * rr * ga[2], y[r][3] * rr * ga[3]); o.z = pk2(y[r][4] * rr * gb[0], y[r][5] * rr * gb[1]); o.w = pk2(y[r][6] * rr * gb[2], y[r][7] * rr * gb[3]);
        *(v4u*)(Y + (size_t)(m0 + r) * 1024 + c0) = o; }
}

__device__ __forceinline__ void h1_unit(int b, int n, const bf16* P, const float* lbl, bf16* UsT, float* decay, LAS unsigned char* lds, int tid) {
    const int c = tid, h = c >> 7, kch = c & 127, lane = tid & 63, w = tid >> 6;
    const size_t tok0 = (size_t)b * SEQ + (size_t)n * 64;
    const float lb = sigmoidf_(lbl[c] - lbl[512 + c]), oml = 1.0f - lb;
    LAS unsigned char* KT = lds; LAS unsigned char* IT = lds + 65536; LAS float* DEC = (LAS float*)(lds + 131072);
    {
        const bf16* pf = P + tok0 * IN_COLS + 2048 + c;
        float Pf = 1.f;
#pragma unroll 1
        for (int seg = 0; seg < 2; ++seg) {
            float fv[32]; unsigned iv[16];
#pragma unroll
            for (int j = 0; j < 32; ++j) fv[j] = bf2f(pf[(size_t)j * IN_COLS]);
#pragma unroll
            for (int j = 0; j < 16; ++j) iv[j] = (unsigned)pf[(size_t)(2 * j) * IN_COLS + 512] | ((unsigned)pf[(size_t)(2 * j + 1) * IN_COLS + 512] << 16);
            pf += (size_t)32 * IN_COLS;
#pragma unroll
            for (int q = 0; q < 4; ++q) { unsigned pk[4];
#pragma unroll
                for (int e = 0; e < 4; ++e) { float kt2[2];
#pragma unroll
                    for (int hl = 0; hl < 2; ++hl) { const float sg = sigmoidf_(fv[8 * q + 2 * e + hl]); Pf *= lb + oml * sg; kt2[hl] = oml * (1.0f - sg) * __builtin_amdgcn_rcpf(Pf); }
                    pk[e] = pk2(kt2[0], kt2[1]); }
                *(LAS v4u*)(KT + c * 128 + (((4 * seg + q) ^ (c & 7)) * 16)) = (v4u){pk[0], pk[1], pk[2], pk[3]}; }
#pragma unroll
            for (int q = 0; q < 4; ++q) *(LAS v4u*)(IT + c * 128 + (((4 * seg + q) ^ (c & 7)) * 16)) = (v4u){iv[4 * q], iv[4 * q + 1], iv[4 * q + 2], iv[4 * q + 3]};
        }
        const float dcy = Pf;
        DEC[c] = dcy;
        decay[((size_t)(b * 4 + h) * 128 + n) * 128 + kch] = dcy;
    }
    __syncthreads();
    {
        const int hd = w >> 1, half = w & 1, l31 = lane & 31, hh = lane >> 5;
        bf16* ub = UsT + ((size_t)(b * 4 + hd) * 128 + n) * 16384;
#pragma unroll 1
        for (int vb = 0; vb < 2; ++vb) {
            f32x16 acc[4];
#pragma unroll
            for (int bq = 0; bq < 4; ++bq)
#pragma unroll
                for (int r = 0; r < 16; ++r) acc[bq][r] = 0.f;
            const int v = hd * 128 + (half * 2 + vb) * 32 + l31;
#pragma unroll
            for (int s = 0; s < 4; ++s) { const int chunk = 2 * s + hh; bf16x8 bfr[4];
                const bf16x8 af = *(const LAS bf16x8*)(IT + v * 128 + ((chunk ^ (v & 7)) * 16));
#pragma unroll
                for (int kb = 0; kb < 4; ++kb) { const int k = hd * 128 + kb * 32 + l31; bfr[kb] = *(const LAS bf16x8*)(KT + k * 128 + ((chunk ^ (k & 7)) * 16)); }
#pragma unroll
                for (int kb = 0; kb < 4; ++kb) acc[kb] = __builtin_amdgcn_mfma_f32_32x32x16_bf16(af, bfr[kb], acc[kb], 0, 0, 0); }
#pragma unroll
            for (int kb = 0; kb < 4; ++kb) { const float dk = DEC[hd * 128 + kb * 32 + l31];
#pragma unroll
                for (int r = 0; r < 16; ++r) { const int vr = (half * 2 + vb) * 32 + (r & 3) + 8 * (r >> 2) + 4 * hh; ub[(size_t)vr * 128 + kb * 32 + l31] = (bf16)(pk2(acc[kb][r] * dk, 0.f) & 0xffffu); } }
        }
    }
    __syncthreads();
}

__device__ __forceinline__ void h2_scan(bf16* UsT, const float* decay, int gw, int NGW, int lane, long dry_off) {
    for (int task = gw; task < 16 * 128; task += NGW) {
        const int bh = task >> 7, v = task & 127;
        unsigned* p = (unsigned*)(UsT + (size_t)bh * 128 * 16384 + (size_t)v * 128) + lane;
        const f32x2* dp = (const f32x2*)(decay + (size_t)bh * 128 * 128) + lane;
        f32x2 S = {0.f, 0.f};
        for (int n0 = 0; n0 < 128; n0 += 16) { unsigned u[16]; f32x2 d[16];
#pragma unroll
            for (int j = 0; j < 16; ++j) { u[j] = p[(size_t)(n0 + j) * 8192]; d[j] = dp[(size_t)(n0 + j) * 64]; }
#pragma unroll
            for (int j = 0; j < 16; ++j) { p[(size_t)(n0 + j) * 8192 + dry_off] = pk2(S.x, S.y); S = d[j] * S + (f32x2){bflo(u[j]), bfhi(u[j])}; } }
    }
}

__device__ __forceinline__ void h3_unit(int b, int n, int h, const bf16* P, const float* lbl, const bf16* UsT, const float* hnw, bf16* Y, LAS unsigned char* lds, int tid) {
    const int lane = tid & 63, w = tid >> 6, bh = b * 4 + h;
    const size_t tok0 = (size_t)b * SEQ + (size_t)n * 64;
    LAS unsigned char* RAW = lds; LAS unsigned char* QD = lds + 49152; LAS unsigned char* KI = lds + 65536; LAS unsigned char* IT = lds + 81920; LAS unsigned char* ST = lds + 98304;
    LAS float* OS = (LAS float*)lds; LAS float* TOT = (LAS float*)(lds + 131072);
    {
        { v4u raw[3][2];
#pragma unroll
          for (int tl = 0; tl < 3; ++tl)
#pragma unroll
              for (int i = 0; i < 2; ++i) { const int idx = tid + 512 * i, row = idx >> 4, ch = idx & 15; raw[tl][i] = *(const v4u*)(P + (tok0 + row) * IN_COLS + 1536 + 512 * tl + h * 128 + 8 * ch); }
          const int v = tid >> 2, kq = tid & 3; const v4u* src = (const v4u*)(UsT + ((size_t)bh * 128 + n) * 16384 + (size_t)v * 128 + 32 * kq); v4u stv[4];
#pragma unroll
          for (int i = 0; i < 4; ++i) stv[i] = src[i];
#pragma unroll
          for (int tl = 0; tl < 3; ++tl)
#pragma unroll
              for (int i = 0; i < 2; ++i) *(LAS v4u*)(RAW + tl * 16384 + (tid + 512 * i) * 16) = raw[tl][i];
#pragma unroll
          for (int i = 0; i < 4; ++i) *(LAS v4u*)(ST + v * 256 + (((4 * kq + i) ^ (v & 15)) * 16)) = stv[i]; }
        __syncthreads();
        const int k = tid & 127, tq = tid >> 7;
        const float lb = sigmoidf_(lbl[h * 128 + k] - lbl[512 + h * 128 + k]), oml = 1.0f - lb;
        const LAS bf16* rq = (const LAS bf16*)RAW + (16 * tq) * 128 + k; const LAS bf16* rf = rq + 8192; const LAS bf16* ri = rq + 16384;
        float sg[16], cs[16], qv[16]; float c = 1.f;
#pragma unroll
        for (int j = 0; j < 16; ++j) { const float f = bf2f(rf[j * 128]); qv[j] = bf2f(rq[j * 128]); sg[j] = sigmoidf_(f); c *= lb + oml * sg[j]; cs[j] = c; }
        TOT[tq * 128 + k] = c;
        { unsigned iv[8];
#pragma unroll
          for (int j = 0; j < 8; ++j) iv[j] = (unsigned)ri[(2 * j) * 128] | ((unsigned)ri[(2 * j + 1) * 128] << 16);
          const int sw = (k >> 1) & 7;
          *(LAS v4u*)(IT + k * 128 + (((2 * tq) ^ sw) * 16)) = (v4u){iv[0], iv[1], iv[2], iv[3]};
          *(LAS v4u*)(IT + k * 128 + (((2 * tq + 1) ^ sw) * 16)) = (v4u){iv[4], iv[5], iv[6], iv[7]}; }
        __syncthreads();
        float off = 1.f;
#pragma unroll
        for (int q = 0; q < 4; ++q) off *= (q < tq) ? TOT[q * 128 + k] : 1.f;
#pragma unroll
        for (int j = 0; j < 16; ++j) { const int t = 16 * tq + j; const float eg = off * cs[j];
            const float qd = qv[j] * sigmoidf_(qv[j]) * eg, ki = oml * (1.0f - sg[j]) * __builtin_amdgcn_rcpf(eg);
            const int o = t * 256 + (((k >> 3) ^ (t & 15)) * 16) + (k & 7) * 2;
            *(LAS bf16*)(QD + o) = (bf16)(pk2(qd, 0.f) & 0xffffu); *(LAS bf16*)(KI + o) = (bf16)(pk2(ki, 0.f) & 0xffffu); }
    }
    __syncthreads();
    {
        const int tb = w & 1, vb = w >> 1, l31 = lane & 31, hh = lane >> 5, t = 32 * tb + l31;
        bf16x8 qf[8];
#pragma unroll
        for (int ks = 0; ks < 8; ++ks) qf[ks] = *(const LAS bf16x8*)(QD + t * 256 + (((2 * ks + hh) ^ (t & 15)) * 16));
        f32x16 o;
#pragma unroll
        for (int r = 0; r < 16; ++r) o[r] = 0.f;
        const int v = 32 * vb + l31;
#pragma unroll
        for (int sb = 0; sb < 2; ++sb) {
            if (sb <= tb) {
                f32x16 x;
#pragma unroll
                for (int r = 0; r < 16; ++r) x[r] = 0.f;
                const int srow = 32 * sb + kappa(l31);
#pragma unroll
                for (int ks = 0; ks < 8; ++ks) { const bf16x8 a = *(const LAS bf16x8*)(KI + srow * 256 + (((2 * ks + hh) ^ (srow & 15)) * 16)); x = __builtin_amdgcn_mfma_f32_32x32x16_bf16(a, qf[ks], x, 0, 0, 0); }
                if (sb == tb) {
#pragma unroll
                    for (int r = 0; r < 16; ++r) { const int sp = 16 * ((r >> 3) & 1) + 8 * hh + 4 * ((r >> 2) & 1) + (r & 3); if (sp > l31) x[r] = 0.f; } }
#pragma unroll
                for (int st = 0; st < 2; ++st) {
                    const v4u pb = {pk2(x[8 * st + 0], x[8 * st + 1]), pk2(x[8 * st + 2], x[8 * st + 3]), pk2(x[8 * st + 4], x[8 * st + 5]), pk2(x[8 * st + 6], x[8 * st + 7])};
                    const bf16x8 a = *(const LAS bf16x8*)(IT + v * 128 + (((4 * sb + 2 * st + hh) ^ ((v >> 1) & 7)) * 16));
                    o = __builtin_amdgcn_mfma_f32_32x32x16_bf16(a, as_bf16x8(pb), o, 0, 0, 0); }
            }
        }
#pragma unroll
        for (int ks = 0; ks < 8; ++ks) { const bf16x8 a = *(const LAS bf16x8*)(ST + v * 256 + (((2 * ks + hh) ^ (v & 15)) * 16)); o = __builtin_amdgcn_mfma_f32_32x32x16_bf16(a, qf[ks], o, 0, 0, 0); }
#pragma unroll
        for (int r = 0; r < 16; ++r) OS[t * 129 + 32 * vb + (r & 3) + 8 * (r >> 2) + 4 * hh] = o[r];
    }
    __syncthreads();
    {
        const int t = tid >> 3, vc = tid & 7; float ov[16]; float ss = 0.f;
#pragma unroll
        for (int j = 0; j < 16; ++j) { ov[j] = OS[t * 129 + 16 * vc + j]; ss += ov[j] * ov[j]; }
        ss += xlane_dpp_b1(ss); ss += xlane_dpp_4e(ss); ss += xlane_dpp_x4(ss);
        const float r = rsqrtf(ss * (1.0f / 128.0f) + EPS);
        const bf16* gp = P + (tok0 + t) * IN_COLS + 3072 + h * 128 + 16 * vc;
        const v4u g0 = *(const v4u*)gp, g1 = *(const v4u*)(gp + 8);
        const float* nw = hnw + h * 128 + 16 * vc;
        unsigned ow[8];
#pragma unroll
        for (int j = 0; j < 8; ++j) { const unsigned gw_ = j < 4 ? g0[j] : g1[j - 4]; const float ga = bflo(gw_), gb = bfhi(gw_);
            ow[j] = pk2(ov[2 * j] * r * nw[2 * j] * (ga * sigmoidf_(ga)), ov[2 * j + 1] * r * nw[2 * j + 1] * (gb * sigmoidf_(gb))); }
        bf16* yp = Y + (tok0 + t) * 1024 + 512 + h * 128 + 16 * vc;
        *(v4u*)yp = (v4u){ow[0], ow[1], ow[2], ow[3]}; *(v4u*)(yp + 8) = (v4u){ow[4], ow[5], ow[6], ow[7]};
    }
    __syncthreads();
}

typedef float f32x4a __attribute__((ext_vector_type(4)));
__device__ __forceinline__ int kswz(int row) { return (row & 3) | (((row >> 3) & 3) << 2); }
__device__ __forceinline__ void attn_phase(const bf16* Q, const bf16* Kb, const bf16* VT, bf16* O, LAS unsigned char* lds, int tid, int vcu, int G) {
    const int lane = tid & 63, w = __builtin_amdgcn_readfirstlane(tid >> 6), l15 = lane & 15, kq = lane >> 4;
    int u = vcu; if (u >= 1024) return;
    unsigned koff[4], voff[4];
#pragma unroll
    for (int i = 0; i < 4; ++i) { const int idx = tid + 512 * i; { const int row = idx >> 5, ch = idx & 31; koff[i] = (unsigned)(row * 256 + ((ch ^ kswz(row)) * 8)) * 2u; }
        { const int row = idx >> 3, ch = idx & 7; voff[i] = (unsigned)(row * 256 + ((ch ^ ((row >> 1) & 7)) * 8)) * 2u; } }
#define ATT_LOAD(j, kbase_, vbase_) do { const char* tb_ = (j) < 4 ? (const char*)(kbase_) + (size_t)(j) * 32768 : (const char*)(vbase_) + (size_t)((j) - 4) * 128; \
        _Pragma("unroll") for (int i = 0; i < 4; ++i) { unsigned o_ = (j) < 4 ? koff[i] : voff[i]; asm volatile("" : "+v"(o_));     \
            __builtin_amdgcn_global_load_lds((const unsigned*)(tb_ + o_), (LAS unsigned*)(lds + ((j) & 3) * 32768 + i * 8192 + w * 1024), 16, 0, 0); } } while (0)
#define ATT_LANDED(n) do { asm volatile("s_waitcnt vmcnt(" #n ") lgkmcnt(0)" ::: "memory"); __builtin_amdgcn_s_barrier(); asm volatile("" ::: "memory"); } while (0)
#define ATT_LANDED2(n_next, n_last) do { if (has_next) asm volatile("s_waitcnt vmcnt(" #n_next ") lgkmcnt(0)" ::: "memory"); else asm volatile("s_waitcnt vmcnt(" #n_last ") lgkmcnt(0)" ::: "memory"); __builtin_amdgcn_s_barrier(); asm volatile("" ::: "memory"); } while (0)
#define ATT_UNIT(u_, tok_, kbase_, vbase_, hd_) const int b_##u_ = (u_) >> 8, hd_ = ((u_) >> 6) & 3; const int tok_ = b_##u_ * SEQ + ((u_) & 63) * 128 + 16 * w;     \
        const bf16* kbase_ = Kb + (size_t)(b_##u_ * 4 + hd_) * 65536; const bf16* vbase_ = VT + (size_t)(b_##u_ * 4 + hd_) * 65536;
    bf16x8 qf[8];
    { ATT_UNIT(u, tok0, kb0, vb0, hd0)
      const bf16* qp = Q + (size_t)tok0 * 1024 + hd0 * 256 + (l15 * 1024 + 8 * kq);
#pragma unroll
      for (int ks = 0; ks < 8; ++ks) qf[ks] = *(const bf16x8*)(qp + 32 * ks);
      asm volatile("" ::: "memory");
      ATT_LOAD(0, kb0, vb0); ATT_LOAD(1, kb0, vb0); ATT_LOAD(2, kb0, vb0); }
    ATT_LANDED(0);
#define ATT_TOUCH_Q() do { _Pragma("unroll") for (int ks = 0; ks < 8; ++ks) asm volatile("" :: "v"(__builtin_bit_cast(v4u, qf[ks]))); } while (0)
    ATT_TOUCH_Q();
#pragma unroll 1
    for (; u < 1024; u += G) {
        const bool has_next = u + G < 1024;
        const int un = has_next ? u + G : u;
        ATT_UNIT(u, tok, kbase, vbase, hd)
        ATT_UNIT(un, tokn, kbn, vbn, hdn)
        f32x4a p[16];
#pragma unroll
        for (int j = 0; j < 4; ++j) {
            ATT_LOAD(j + 3, kbase, vbase);
            const LAS unsigned char* buf = lds + (j & 3) * 32768;
#define S_READ(dst, blk) do { const int row = 32 * ((blk) >> 1) + 8 * (l15 >> 2) + 4 * ((blk) & 1) + (l15 & 3); \
                _Pragma("unroll") for (int ks = 0; ks < 8; ++ks) dst[ks] = *(const LAS bf16x8*)(buf + row * 512 + (((4 * ks + kq) ^ kswz(row)) * 16)); } while (0)
#define S_MMA(src, blk) do { f32x4a x0 = {0.f, 0.f, 0.f, 0.f}, x1 = {0.f, 0.f, 0.f, 0.f}; \
                _Pragma("unroll") for (int ks = 0; ks < 8; ks += 2) { x0 = __builtin_amdgcn_mfma_f32_16x16x32_bf16(src[ks], qf[ks], x0, 0, 0, 0); x1 = __builtin_amdgcn_mfma_f32_16x16x32_bf16(src[ks + 1], qf[ks + 1], x1, 0, 0, 0); } \
                p[4 * j + (blk)] = x0 + x1; } while (0)
            { bf16x8 fa[8], fb[8];
              S_READ(fa, 0); __builtin_amdgcn_sched_barrier(0);
              S_READ(fb, 1); __builtin_amdgcn_sched_barrier(0); S_MMA(fa, 0); __builtin_amdgcn_sched_barrier(0);
              S_READ(fa, 2); __builtin_amdgcn_sched_barrier(0); S_MMA(fb, 1); __builtin_amdgcn_sched_barrier(0);
              S_READ(fb, 3); __builtin_amdgcn_sched_barrier(0); S_MMA(fa, 2); __builtin_amdgcn_sched_barrier(0);
              S_MMA(fb, 3); }
#undef S_READ
#undef S_MMA
            if (j < 2) ATT_LANDED(63); else ATT_LANDED(8);
        }
        float mx = p[0][0];
#pragma unroll
        for (int i = 0; i < 16; ++i)
#pragma unroll
            for (int r = 0; r < 4; ++r) mx = fmaxf(mx, p[i][r]);
        mx = fmaxf(mx, __shfl_xor(mx, 16)); mx = fmaxf(mx, __shfl_xor(mx, 32));
        float lsum = 0.f;
#pragma unroll
        for (int i = 0; i < 16; ++i)
#pragma unroll
            for (int r = 0; r < 4; ++r) { p[i][r] = __builtin_amdgcn_exp2f(p[i][r] - mx); lsum += p[i][r]; }
        lsum += __shfl_xor(lsum, 16); lsum += __shfl_xor(lsum, 32);
        const float inv = 1.0f / lsum;
        v4u pb[8];
#pragma unroll
        for (int s = 0; s < 8; ++s) pb[s] = (v4u){pk2(p[2 * s][0], p[2 * s][1]), pk2(p[2 * s][2], p[2 * s][3]), pk2(p[2 * s + 1][0], p[2 * s + 1][1]), pk2(p[2 * s + 1][2], p[2 * s + 1][3])};
        f32x4a ot[16];
#pragma unroll
        for (int i = 0; i < 16; ++i) ot[i] = (f32x4a){0.f, 0.f, 0.f, 0.f};
#pragma unroll
        for (int j = 4; j < 8; ++j) {
            if (j == 4) ATT_LOAD(7, kbase, vbase);
            else if (has_next) { if (j == 5) ATT_LOAD(0, kbn, vbn); else if (j == 6) ATT_LOAD(1, kbn, vbn); else ATT_LOAD(2, kbn, vbn); }
            const LAS unsigned char* buf = lds + (j & 3) * 32768;
#define PV_READ(dst, g) do { _Pragma("unroll") for (int d4 = 0; d4 < 4; ++d4) { const int row = 16 * (4 * (g) + d4) + l15; \
                _Pragma("unroll") for (int s = 0; s < 2; ++s) dst[2 * d4 + s] = *(const LAS bf16x8*)(buf + row * 128 + (((4 * s + kq) ^ ((row >> 1) & 7)) * 16)); } } while (0)
#define PV_MMA(src, g) do { _Pragma("unroll") for (int s = 0; s < 2; ++s) _Pragma("unroll") for (int d4 = 0; d4 < 4; ++d4) \
                ot[4 * (g) + d4] = __builtin_amdgcn_mfma_f32_16x16x32_bf16(src[2 * d4 + s], as_bf16x8(pb[2 * (j - 4) + s]), ot[4 * (g) + d4], 0, 0, 0); } while (0)
            { bf16x8 fa[8], fb[8];
              PV_READ(fa, 0); __builtin_amdgcn_sched_barrier(0);
              PV_READ(fb, 1); __builtin_amdgcn_sched_barrier(0); PV_MMA(fa, 0); __builtin_amdgcn_sched_barrier(0);
              PV_READ(fa, 2); __builtin_amdgcn_sched_barrier(0); PV_MMA(fb, 1); __builtin_amdgcn_sched_barrier(0);
              PV_READ(fb, 3); __builtin_amdgcn_sched_barrier(0); PV_MMA(fa, 2); __builtin_amdgcn_sched_barrier(0);
              PV_MMA(fb, 3); }
#undef PV_READ
#undef PV_MMA
            if (j == 4) { if (has_next) { const bf16* qp = Q + (size_t)tokn * 1024 + hdn * 256 + (l15 * 1024 + 8 * kq);
#pragma unroll
                    for (int ks = 0; ks < 8; ++ks) qf[ks] = *(const bf16x8*)(qp + 32 * ks); }
                ATT_LANDED2(16, 8); }
            else if (j == 5) ATT_LANDED2(16, 4);
            else if (j == 6) ATT_LANDED2(16, 0);
            else ATT_LANDED(0);
        }
        ATT_TOUCH_Q();
        bf16* op = O + (size_t)tok * 1024 + hd * 256 + (l15 * 1024 + 4 * kq);
#pragma unroll
        for (int db = 0; db < 16; ++db) { v2u o2 = {pk2(ot[db][0] * inv, ot[db][1] * inv), pk2(ot[db][2] * inv, ot[db][3] * inv)}; *(v2u*)(op + 16 * db) = o2; }
    }
#undef ATT_LOAD
#undef ATT_LANDED
#undef ATT_LANDED2
#undef ATT_TOUCH_Q
#undef ATT_UNIT
}

__device__ __forceinline__ unsigned ord_f32(float f) { const unsigned u = __float_as_uint(f); return u ^ ((unsigned)((int)u >> 31) | 0x80000000u); }
__device__ __forceinline__ float unord_f32(unsigned o) { return __uint_as_float(o ^ (~(unsigned)((int)o >> 31) | 0x80000000u)); }
__device__ __forceinline__ void ce_desc(unsigned& a, unsigned& b) { const unsigned hi = a > b ? a : b, lo = a > b ? b : a; a = hi; b = lo; }
__device__ __forceinline__ void sort16_desc(unsigned (&a)[16]) {
    ce_desc(a[0], a[1]); ce_desc(a[2], a[3]); ce_desc(a[0], a[2]); ce_desc(a[1], a[3]); ce_desc(a[1], a[2]); ce_desc(a[4], a[5]); ce_desc(a[6], a[7]); ce_desc(a[4], a[6]); ce_desc(a[5], a[7]); ce_desc(a[5], a[6]);
    ce_desc(a[0], a[4]); ce_desc(a[2], a[6]); ce_desc(a[2], a[4]); ce_desc(a[1], a[5]); ce_desc(a[3], a[7]); ce_desc(a[3], a[5]); ce_desc(a[1], a[2]); ce_desc(a[3], a[4]); ce_desc(a[5], a[6]); ce_desc(a[8], a[9]);
    ce_desc(a[10], a[11]); ce_desc(a[8], a[10]); ce_desc(a[9], a[11]); ce_desc(a[9], a[10]); ce_desc(a[12], a[13]); ce_desc(a[14], a[15]); ce_desc(a[12], a[14]); ce_desc(a[13], a[15]); ce_desc(a[13], a[14]);
    ce_desc(a[8], a[12]); ce_desc(a[10], a[14]); ce_desc(a[10], a[12]); ce_desc(a[9], a[13]); ce_desc(a[11], a[15]); ce_desc(a[11], a[13]); ce_desc(a[9], a[10]); ce_desc(a[11], a[12]); ce_desc(a[13], a[14]);
    ce_desc(a[0], a[8]); ce_desc(a[4], a[12]); ce_desc(a[4], a[8]); ce_desc(a[2], a[10]); ce_desc(a[6], a[14]); ce_desc(a[6], a[10]); ce_desc(a[2], a[4]); ce_desc(a[6], a[8]); ce_desc(a[10], a[12]); ce_desc(a[1], a[9]);
    ce_desc(a[5], a[13]); ce_desc(a[5], a[9]); ce_desc(a[3], a[11]); ce_desc(a[7], a[15]); ce_desc(a[7], a[11]); ce_desc(a[3], a[5]); ce_desc(a[7], a[9]); ce_desc(a[11], a[13]); ce_desc(a[1], a[2]); ce_desc(a[3], a[4]);
    ce_desc(a[5], a[6]); ce_desc(a[7], a[8]); ce_desc(a[9], a[10]); ce_desc(a[11], a[12]); ce_desc(a[13], a[14]);
}
__device__ __forceinline__ void merge_prune16(unsigned (&top)[16], const unsigned (&nw)[16]) {
#pragma unroll
    for (int i = 0; i < 16; ++i) top[i] = top[i] > nw[15 - i] ? top[i] : nw[15 - i];
#pragma unroll
    for (int j = 8; j > 0; j >>= 1)
#pragma unroll
        for (int i = 0; i < 16; ++i) { const int l = i ^ j; if (l > i) ce_desc(top[i], top[l]); }
}
__device__ __forceinline__ void topk_load(const unsigned short* scT, int hp, int token, v2u (&raw)[32]) {
#pragma unroll
    for (int kq = 0; kq < 32; ++kq) raw[kq] = *(const v2u*)(scT + ((size_t)(hp * 32 + kq) * M + token) * 4);
}
typedef short s16x2v __attribute__((ext_vector_type(2)));
__device__ __forceinline__ unsigned ord_f16x2(unsigned w) { const s16x2v m = __builtin_bit_cast(s16x2v, w) >> 15; return w ^ (__builtin_bit_cast(unsigned, m) | 0x80008000u); }
__device__ __forceinline__ float unord_f16_hi(unsigned key) { const unsigned o = key >> 16; const unsigned h = o ^ ((o & 0x8000u) ? 0x8000u : 0xffffu); return (float)__builtin_bit_cast(_Float16, (unsigned short)h); }
__device__ __forceinline__ void topk_half(const v2u (&raw)[32], unsigned (&top)[16]) {
#pragma unroll
    for (int c = 0; c < 8; ++c) { unsigned nw[16];
#pragma unroll
        for (int q = 0; q < 4; ++q) { const unsigned x0 = ord_f16x2(raw[4 * c + q].x), x1 = ord_f16x2(raw[4 * c + q].y); const int b0 = 127 - (16 * c + 4 * q);
            nw[4 * q + 0] = (x0 << 16) | (unsigned)b0;         nw[4 * q + 1] = (x0 & 0xffff0000u) | (unsigned)(b0 - 1);
            nw[4 * q + 2] = (x1 << 16) | (unsigned)(b0 - 2);   nw[4 * q + 3] = (x1 & 0xffff0000u) | (unsigned)(b0 - 3); }
        sort16_desc(nw);
        if (c == 0) {
#pragma unroll
            for (int i = 0; i < 16; ++i) top[i] = nw[i]; }
        else merge_prune16(top, nw); }
}
__device__ __forceinline__ void peer_topk_task(const unsigned short* scT, int head, int token, unsigned short* idx_out, float* gate_out, LAS unsigned char* slot) {
    unsigned ta[16], tb[16];
    { v2u ra[32], rb[32]; topk_load(scT, 2 * head, token, ra); topk_load(scT, 2 * head + 1, token, rb); topk_half(ra, ta); topk_half(rb, tb); }
    float av[16], bv[16];
#pragma unroll
    for (int i = 0; i < 16; ++i) { av[i] = unord_f16_hi(ta[i]); bv[i] = unord_f16_hi(tb[i]); }
#pragma unroll
    for (int q = 0; q < 4; ++q) {
        unsigned wa = 0, wb = 0;
#pragma unroll
        for (int e = 0; e < 4; ++e) { wa |= (127u - (ta[4 * q + e] & 127u)) << (8 * e); wb |= (127u - (tb[4 * q + e] & 127u)) << (8 * e); }
        *(LAS unsigned*)(slot + 4 * q) = wa; *(LAS unsigned*)(slot + 16 + 4 * q) = wb; }
    unsigned cd[4][16];
#pragma unroll
    for (int q = 0; q < 4; ++q)
#pragma unroll
        for (int e = 0; e < 16; ++e) cd[q][e] = 0u;
    {
        constexpr int cnt[16] = {16, 8, 5, 4, 3, 2, 2, 2, 1, 1, 1, 1, 1, 1, 1, 1};
        constexpr int stt[16] = {0, 16, 24, 29, 33, 36, 38, 40, 42, 43, 44, 45, 46, 47, 48, 49};
#pragma unroll
        for (int i = 0; i < 16; ++i)
#pragma unroll
            for (int j = 0; j < 16; ++j) if (j < cnt[i]) { const int t = stt[i] + j; const int ch = t < 16 ? 0 : t < 24 ? 1 : t < 40 ? 2 : 3, ps = t < 16 ? t : t < 24 ? t - 16 : t < 40 ? t - 24 : t - 40;
                cd[ch][ps] = (ord_f32(av[i] + bv[j]) & ~63u) | (unsigned)(63 - t); }
    }
    sort16_desc(cd[2]); sort16_desc(cd[3]);
    merge_prune16(cd[0], cd[1]); merge_prune16(cd[2], cd[3]); merge_prune16(cd[0], cd[2]);
    LDS_WAIT();
    float gv[16]; float gs = 0.f; const float vmax = unord_f32(cd[0][0] & ~63u);
    unsigned ex[16];
#pragma unroll
    for (int r = 0; r < 16; ++r) {
        const int t = 63 - (int)(cd[0][r] & 63u);
        int i = (t >= 16) + (t >= 24) + (t >= 29) + (t >= 33) + (t >= 36) + (t >= 38) + (t >= 40);
        int st = t >= 40 ? 40 : t >= 38 ? 38 : t >= 36 ? 36 : t >= 33 ? 33 : t >= 29 ? 29 : t >= 24 ? 24 : t >= 16 ? 16 : 0;
        int j = t - st;
        if (t >= 42) { i = 8 + (t - 42); j = 0; }
        const unsigned ia = *(LAS unsigned char*)(slot + i), ib = *(LAS unsigned char*)(slot + 16 + j);
        ex[r] = ia * 128u + ib;
        gv[r] = __expf(unord_f32(cd[0][r] & ~63u) - vmax); gs += gv[r]; }
    const float ginv = 1.0f / gs;
    float* gp = gate_out + (size_t)token * 128 + head * 16;
#pragma unroll
    for (int jj = 0; jj < 8; ++jj) *(unsigned*)(idx_out + (size_t)token * 128 + jj * 16 + 2 * head) = ex[jj] | (ex[jj + 8] << 16);
#pragma unroll
    for (int q = 0; q < 4; ++q) *(f32x4*)(gp + 4 * q) = (f32x4){gv[4 * q] * ginv, gv[4 * q + 1] * ginv, gv[4 * q + 2] * ginv, gv[4 * q + 3] * ginv};
}

__device__ __forceinline__ float quant_row_sliced(const float* src, const float* gain, unsigned char* dst, int rows, int r, int offset, int lane) {
    f32x4 v[4]; float am = 0.f;
#pragma unroll
    for (int jq = 0; jq < 4; ++jq) { v[jq] = ((const f32x4*)src)[64 * jq + lane]; if (gain) v[jq] = v[jq] * ((const f32x4*)gain)[64 * jq + lane];
        am = fmaxf(am, fmaxf(fmaxf(fabsf(v[jq].x), fabsf(v[jq].y)), fmaxf(fabsf(v[jq].z), fabsf(v[jq].w)))); }
    am = wave_max(am);
    const float inv = am > 0.f ? 127.0f / am : 0.f;
#pragma unroll
    for (int jq = 0; jq < 4; ++jq) { const int sl = 2 * jq + (lane >> 5);
        const int q0 = (int)rintf(v[jq].x * inv) + offset, q1 = (int)rintf(v[jq].y * inv) + offset, q2 = (int)rintf(v[jq].z * inv) + offset, q3 = (int)rintf(v[jq].w * inv) + offset;
        *(unsigned*)(dst + ((size_t)sl * rows + r) * 128 + 4 * (lane & 31)) = (unsigned)(q0 & 255) | ((unsigned)(q1 & 255) << 8) | ((unsigned)(q2 & 255) << 16) | ((unsigned)(q3 & 255) << 24); }
    return am * (1.0f / 127.0f);
}
template <bool EO = false>
__device__ __forceinline__ void quant_store_row(const f32x4 (&v)[4], float inv, unsigned char* dst, int rows, int r, int lane) {
#pragma unroll
    for (int jq = 0; jq < 4; ++jq) { const int sl = 2 * jq + (lane >> 5);
        const int q0 = (int)rintf(v[jq].x * inv), q1 = (int)rintf(v[jq].y * inv), q2 = (int)rintf(v[jq].z * inv), q3 = (int)rintf(v[jq].w * inv);
        unsigned char* d_ = dst + ((size_t)sl * rows + r) * 128;
        if (EO) { *(unsigned short*)(d_ + 2 * (lane & 31)) = (unsigned short)((q0 & 255) | ((q2 & 255) << 8)); *(unsigned short*)(d_ + 64 + 2 * (lane & 31)) = (unsigned short)((q1 & 255) | ((q3 & 255) << 8)); }
        else *(unsigned*)(d_ + 4 * (lane & 31)) = (unsigned)(q0 & 255) | ((unsigned)(q1 & 255) << 8) | ((unsigned)(q2 & 255) << 16) | ((unsigned)(q3 & 255) << 24); }
}
__device__ __forceinline__ float row_amax(const f32x4 (&v)[4]) { float am = 0.f;
#pragma unroll
    for (int jq = 0; jq < 4; ++jq) am = fmaxf(am, fmaxf(fmaxf(fabsf(v[jq].x), fabsf(v[jq].y)), fmaxf(fabsf(v[jq].z), fabsf(v[jq].w))));
    return wave_max(am); }
__device__ __forceinline__ void quant_rows4(const float* down, const float* up, const float* gain, unsigned char* dstd, unsigned char* dstu, int e0, int e1, int lane, float* dscale, float* uscale) {
    f32x4 vd0[4], vu0[4], vd1[4], vu1[4];
#pragma unroll
    for (int jq = 0; jq < 4; ++jq) { vd0[jq] = ((const f32x4*)(down + (size_t)e0 * 1024))[64 * jq + lane]; vu0[jq] = ((const f32x4*)(up + (size_t)e0 * 1024))[64 * jq + lane];
        vd1[jq] = ((const f32x4*)(down + (size_t)e1 * 1024))[64 * jq + lane]; vu1[jq] = ((const f32x4*)(up + (size_t)e1 * 1024))[64 * jq + lane]; }
#pragma unroll
    for (int jq = 0; jq < 4; ++jq) { const f32x4 g = ((const f32x4*)gain)[64 * jq + lane]; vd0[jq] = vd0[jq] * g; vd1[jq] = vd1[jq] * g; }
    const float ad0 = row_amax(vd0), au0 = row_amax(vu0), ad1 = row_amax(vd1), au1 = row_amax(vu1);
    quant_store_row(vd0, ad0 > 0.f ? 127.0f / ad0 : 0.f, dstd, NEXP, e0, lane); quant_store_row<true>(vu0, au0 > 0.f ? 127.0f / au0 : 0.f, dstu, NEXP, e0, lane);
    if (lane == 0) { dscale[e0] = ad0 * (1.0f / 127.0f); uscale[e0] = au0 * (1.0f / 127.0f); }
    if (e1 != e0) { quant_store_row(vd1, ad1 > 0.f ? 127.0f / ad1 : 0.f, dstd, NEXP, e1, lane); quant_store_row<true>(vu1, au1 > 0.f ? 127.0f / au1 : 0.f, dstu, NEXP, e1, lane);
        if (lane == 0) { dscale[e1] = ad1 * (1.0f / 127.0f); uscale[e1] = au1 * (1.0f / 127.0f); } }
}
__device__ __forceinline__ void quant_x2_rows4(const bf16* x2S, unsigned char* dst, float* xscale, int m, int stride, int lane) {
    f32x4 v[4][4]; int mr[4];
#pragma unroll
    for (int r = 0; r < 4; ++r) { mr[r] = m + r * stride < M ? m + r * stride : m;
#pragma unroll
        for (int jq = 0; jq < 4; ++jq) { const v2u w = *(const v2u*)(x2S + ((size_t)(4 * jq + (lane >> 4)) * M + mr[r]) * 64 + 4 * (lane & 15)); v[r][jq] = (f32x4){bflo(w.x), bfhi(w.x), bflo(w.y), bfhi(w.y)}; } }
#pragma unroll
    for (int r = 0; r < 4; ++r) { const float am = row_amax(v[r]);
        if (r == 0 || mr[r] != m) { quant_store_row(v[r], am > 0.f ? 127.0f / am : 0.f, dst, M, mr[r], lane); if (lane == 0) xscale[mr[r]] = am * (1.0f / 127.0f); } }
}
__device__ __forceinline__ float swap_add32(float a, float b) { const auto r = __builtin_amdgcn_permlane32_swap(__float_as_uint(a), __float_as_uint(b), false, false); return __uint_as_float(r[0]) + __uint_as_float(r[1]); }
__device__ __forceinline__ float swap_add16(float a, float b) { const auto r = __builtin_amdgcn_permlane16_swap(__float_as_uint(a), __float_as_uint(b), false, false); return __uint_as_float(r[0]) + __uint_as_float(r[1]); }
template <int CTRL> __device__ __forceinline__ float dpp_f(float v) { return __uint_as_float((unsigned)__builtin_amdgcn_update_dpp(0, (int)__float_as_uint(v), CTRL, 0xF, 0xF, false)); }
__device__ __forceinline__ float dpp_xor4(float v) {
    int r = __builtin_amdgcn_update_dpp(0, (int)__float_as_uint(v), 0x12C, 0xF, 0x5, false);
    r = __builtin_amdgcn_update_dpp(r, (int)__float_as_uint(v), 0x124, 0xF, 0xA, false);
    return __uint_as_float((unsigned)r);
}
__device__ __forceinline__ float bfly8_low(const float (&p)[8], int lane) {
    float q4[4], q2[2];
    { const bool u = (lane & 4) != 0;
#pragma unroll
      for (int i = 0; i < 4; ++i) { const float keep = u ? p[4 + i] : p[i], send = u ? p[i] : p[4 + i]; q4[i] = keep + dpp_xor4(send); } }
    { const bool u = (lane & 2) != 0;
#pragma unroll
      for (int i = 0; i < 2; ++i) { const float keep = u ? q4[2 + i] : q4[i], send = u ? q4[i] : q4[2 + i]; q2[i] = keep + dpp_f<0x4E>(send); } }
    { const bool u = (lane & 1) != 0; const float keep = u ? q2[1] : q2[0], send = u ? q2[0] : q2[1]; return keep + dpp_f<0xB1>(send); }
}
__device__ __forceinline__ f32x2 bfly16_high(const float (&p)[16], int lane) {
    float q8[8], q4[4];
#pragma unroll
    for (int i = 0; i < 8; ++i) q8[i] = swap_add32(p[i], p[8 + i]);
#pragma unroll
    for (int i = 0; i < 4; ++i) q4[i] = swap_add16(q8[i], q8[4 + i]);
    { const bool u = (lane & 8) != 0; f32x2 r;
      { const float keep = u ? q4[2] : q4[0], send = u ? q4[0] : q4[2]; r.x = keep + dpp_f<0x128>(send); }
      { const float keep = u ? q4[3] : q4[1], send = u ? q4[1] : q4[3]; r.y = keep + dpp_f<0x128>(send); }
      return r; }
}
#define PEER_ISSUE(dst, iwa, iwb, base) do { _Pragma("unroll") for (int i = 0; i < 16; ++i) { const unsigned wvv_ = i < 8 ? (iwa)[i >> 1] : (iwb)[(i - 8) >> 1]; \
        const unsigned e_ = (i & 1) ? (wvv_ >> 16) : (wvv_ & 0xffffu); dst[i] = *(const v4u*)((base) + (size_t)e_ * 128); } } while (0)
#define PEER_LOADIDX(da, db, k) do { const v4u* ip_ = (const v4u*)(idxp + (size_t)TOKC(k) * 128 + 16 * j); da = ip_[0]; db = ip_[1]; } while (0)
#define TOKC(k) (wv + ((k) < ntok ? (k) : ntok - 1) * nwv)
__device__ __forceinline__ void peer_down_phase(const unsigned char* xq, const unsigned char* downQ, const unsigned short* idxp, unsigned* part, int sl, int wv, int nwv, int lane) {
    const int j = lane >> 3, sub = lane & 7;
    const int ntok = wv < M ? (M - wv + nwv - 1) / nwv : 0;
    const unsigned char* xs = xq + (size_t)sl * M * 128 + 16 * sub; const unsigned char* ds = downQ + (size_t)sl * NEXP * 128 + 16 * sub;
    unsigned* ps = part + (size_t)sl * M * 64 + ((j & 1) ? 32 + 4 * sub + (j >> 1) : 4 * sub + (j >> 1));
    if (ntok == 0) return;
#define D_COMPUTE(dsrc, xvv, k) do { float p0[8], p1[8]; _Pragma("unroll") for (int i = 0; i < 8; ++i) { int s = 0, u = 0; \
        _Pragma("unroll") for (int q = 0; q < 4; ++q) { s = __builtin_amdgcn_sdot4((int)dsrc[i][q], (int)xvv[q], s, false); u = __builtin_amdgcn_sdot4((int)dsrc[8 + i][q], (int)xvv[q], u, false); } p0[i] = (float)s; p1[i] = (float)u; } \
        const float r0 = bfly8_low(p0, lane) * 0.015625f, r1 = bfly8_low(p1, lane) * 0.015625f;     \
        const float rc_ = dpp_f<0x128>((j & 1) ? r0 : r1);              \
        const pg8::f16x2 hv_ = (j & 1) ? (pg8::f16x2){(_Float16)rc_, (_Float16)r1} : (pg8::f16x2){(_Float16)r0, (_Float16)rc_}; \
        ps[(size_t)(wv + (k) * nwv) * 64] = __builtin_bit_cast(unsigned, hv_); } while (0)
    v4u dA[16], dB[16];
    v4u ia0, ib0, ia1, ib1; PEER_LOADIDX(ia0, ib0, 0); PEER_LOADIDX(ia1, ib1, 1);
    v4u xv0 = *(const v4u*)(xs + (size_t)TOKC(0) * 128), xv1 = *(const v4u*)(xs + (size_t)TOKC(1) * 128);
    PEER_ISSUE(dA, ia0, ib0, ds);
#pragma unroll 1
    for (int k = 0; k < ntok; k += 2) {
        v4u ia2, ib2; PEER_LOADIDX(ia2, ib2, k + 2); const v4u xv2 = *(const v4u*)(xs + (size_t)TOKC(k + 2) * 128);
        PEER_ISSUE(dB, ia1, ib1, ds);
        D_COMPUTE(dA, xv0, k);
        v4u ia3, ib3; PEER_LOADIDX(ia3, ib3, k + 3); const v4u xv3 = *(const v4u*)(xs + (size_t)TOKC(k + 3) * 128);
        PEER_ISSUE(dA, ia2, ib2, ds);
        if (k + 1 < ntok) D_COMPUTE(dB, xv1, k + 1);
        ia0 = ia2; ib0 = ib2; xv0 = xv2; ia1 = ia3; ib1 = ib3; xv1 = xv3;
    }
#undef D_COMPUTE
}
__device__ __forceinline__ void peer_combine_tokens4(const unsigned* part, const float* part2, const unsigned short* idxp, const float* dscale, const float* uscale, const float* xscale, const float* gate, unsigned* wpk, float* wscale, int t0, int stride, int lane) {
    int tk[4]; float pp[4], xs[4]; f32x2 s[4], gt[4]; unsigned ex[4];
#pragma unroll
    for (int r = 0; r < 4; ++r) { tk[r] = t0 + r * stride < M ? t0 + r * stride : t0; pp[r] = lane < 16 ? part2[(size_t)tk[r] * 16 + lane] : 0.f; xs[r] = xscale[tk[r]];
        const size_t o = (size_t)tk[r] * 64 + lane; { const unsigned short* ipp = idxp + (size_t)tk[r] * 128 + 32 * (lane & 3) + (lane >> 2); ex[r] = (unsigned)ipp[0] | ((unsigned)ipp[16] << 16); }
        gt[r] = *(const f32x2*)(gate + 2 * o); f32x2 a = {0.f, 0.f};
#pragma unroll
        for (int sl = 0; sl < 8; ++sl) { const pg8::f16x2 h = __builtin_bit_cast(pg8::f16x2, part[(size_t)sl * M * 64 + o]); a.x += (float)h[0]; a.y += (float)h[1]; }
        s[r] = a; }
    f32x2 ds[4], us[4];
#pragma unroll
    for (int r = 0; r < 4; ++r) { ds[r] = (f32x2){dscale[ex[r] & 0xffffu], dscale[ex[r] >> 16]}; us[r] = (f32x2){uscale[ex[r] & 0xffffu], uscale[ex[r] >> 16]}; }
#pragma unroll
    for (int r = 0; r < 4; ++r) { if (r > 0 && tk[r] == t0) continue;
        const float rx = rsqrtf(wave_sum(pp[r]) * (1.0f / 1024.0f) + EPS) * xs[r] * 64.0f;
        const float z0 = s[r].x * rx * ds[r].x, z1 = s[r].y * rx * ds[r].y;
        const float w0 = 0.5f * z0 * (1.0f + erff(z0 * 0.70710678118654752f)) * gt[r].x * us[r].x, w1 = 0.5f * z1 * (1.0f + erff(z1 * 0.70710678118654752f)) * gt[r].y * us[r].y;
        const float am = wave_max(fmaxf(fabsf(w0), fabsf(w1)));
        const float inv = am > 0.f ? 127.0f / am : 0.f;
        const int qq = ((int)rintf(w0 * inv) & 255) | (((int)rintf(w1 * inv) & 255) << 8);
        ((unsigned short*)wpk)[(size_t)tk[r] * 64 + lane] = (unsigned short)qq;
        if (lane == 0) wscale[tk[r]] = am * (1.0f / 127.0f); }
}
typedef int v2i_t __attribute__((ext_vector_type(2)));
#define U_COMPUTE(dsrc, wreg, k) do { const size_t tk_ = (size_t)(wv + (k) * nwv); const unsigned xx_ = *(const unsigned*)(xi0 + tk_ * 64); const float ws_ = wscale[tk_]; int acc0 = 0, acc1 = 0; \
        _Pragma("unroll") for (int h = 0; h < 2; ++h) { LAS unsigned char* buf_ = ubuf + h * 8192; \
            _Pragma("unroll") for (int i = 0; i < 8; ++i) *(LAS v4u*)(buf_ + i * 1024 + wr_off) = dsrc[8 * h + i]; \
            _Pragma("unroll") for (int i = 0; i < 8; ++i) { const int wlo_ = __builtin_amdgcn_readlane((int)(wreg), 2 * (8 * h + i)), whi_ = __builtin_amdgcn_readlane((int)(wreg), 2 * (8 * h + i) + 1); \
                const v2i_t t0_ = __builtin_amdgcn_ds_read_tr8_b64_v2i32((LAS v2i_t*)(buf_ + i * 1024 + rd_off0)), t1_ = __builtin_amdgcn_ds_read_tr8_b64_v2i32((LAS v2i_t*)(buf_ + i * 1024 + rd_off1)); \
                acc0 = __builtin_amdgcn_sdot4(t0_.x, wlo_, acc0, false); acc0 = __builtin_amdgcn_sdot4(t0_.y, whi_, acc0, false); \
                acc1 = __builtin_amdgcn_sdot4(t1_.x, wlo_, acc1, false); acc1 = __builtin_amdgcn_sdot4(t1_.y, whi_, acc1, false); } } \
        *(unsigned*)(xo0 + tk_ * 64) = pk2(__uint_as_float(xx_ << 16) + (float)acc0 * ws_, __uint_as_float(xx_ & 0xffff0000u) + (float)acc1 * ws_); } while (0)
#define U_LOADW(dst, k) do { dst = wpk[(size_t)TOKC(k) * 32 + (lane & 31)]; } while (0)
__device__ __forceinline__ void peer_up_phase(bf16* x2S, bf16* x3S, const unsigned char* upQ, const unsigned short* idxp, const unsigned* wpk, const float* wscale, int sl, int wv, int nwv, int lane, LAS unsigned char* ubuf) {
    const int j = lane >> 3, sub = lane & 7;
    const int ntok = wv < M ? (M - wv + nwv - 1) / nwv : 0;
    const unsigned char* us = upQ + (size_t)sl * NEXP * 128 + 16 * sub;
    const bf16* xi0 = x2S + (size_t)(2 * sl + (lane >> 5)) * M * 64 + 2 * (lane & 31);
    bf16* xo0 = x3S + (size_t)(2 * sl + (lane >> 5)) * M * 64 + 2 * (lane & 31);
    const int wr_off = j * 128 + ((sub ^ (j >> 1)) * 16);
    const int g_ = lane >> 4, p_ = lane & 15, r_ = p_ >> 1;
    const int rd_off0 = r_ * 128 + (((g_) ^ (r_ >> 1)) * 16) + 8 * (p_ & 1);
    const int rd_off1 = r_ * 128 + (((4 + g_) ^ (r_ >> 1)) * 16) + 8 * (p_ & 1);
    if (ntok == 0) return;
    v4u dA[16], dB[16];
    v4u ia0, ib0, ia1, ib1; PEER_LOADIDX(ia0, ib0, 0); PEER_LOADIDX(ia1, ib1, 1);
    unsigned wq0, wq1; U_LOADW(wq0, 0); U_LOADW(wq1, 1);
    PEER_ISSUE(dA, ia0, ib0, us);
#pragma unroll 1
    for (int k = 0; k < ntok; k += 2) {
        v4u ia2, ib2; PEER_LOADIDX(ia2, ib2, k + 2); unsigned wq2; U_LOADW(wq2, k + 2);
        PEER_ISSUE(dB, ia1, ib1, us);
        U_COMPUTE(dA, wq0, k);
        v4u ia3, ib3; PEER_LOADIDX(ia3, ib3, k + 3); unsigned wq3; U_LOADW(wq3, k + 3);
        PEER_ISSUE(dA, ia2, ib2, us);
        if (k + 1 < ntok) U_COMPUTE(dB, wq1, k + 1);
        ia0 = ia2; ib0 = ib2; ia1 = ia3; ib1 = ib3; wq0 = wq2; wq1 = wq3;
    }
}
#undef U_COMPUTE
#undef U_LOADW
#undef TOKC
#undef PEER_ISSUE
#undef PEER_LOADIDX
#define FN_LOAD(dst, tb) do { _Pragma("unroll") for (int r = 0; r < 4; ++r) { const int t_ = (tb) + r * NGW < M ? (tb) + r * NGW : (tb); \
        _Pragma("unroll") for (int jq = 0; jq < 4; ++jq) dst[r][jq] = *(const v2u*)(xs_ + (size_t)jq * 4 * M * 64 + (size_t)t_ * 64); } } while (0)
__device__ __forceinline__ void final_norm_phase(const bf16* x3S, float* out, const float* fin_w, int gw, int NGW, int lane) {
    if (gw >= M) return;
    const bf16* xs_ = x3S + (size_t)(lane >> 4) * M * 64 + 4 * (lane & 15);
    f32x4 w[4];
#pragma unroll
    for (int jq = 0; jq < 4; ++jq) w[jq] = ((const f32x4*)fin_w + lane)[64 * jq];
    v2u cur[4][4], nxt[4][4];
    FN_LOAD(cur, gw);
#pragma unroll 1
    for (int t = gw; t < M; t += 4 * NGW) {
        if (t + 4 * NGW < M) FN_LOAD(nxt, t + 4 * NGW);
#pragma unroll
        for (int r = 0; r < 4; ++r) { if (t + r * NGW >= M) break;
            float sa = 0.f;
#pragma unroll
            for (int jq = 0; jq < 4; ++jq) sa += (bflo(cur[r][jq].x) * bflo(cur[r][jq].x) + bfhi(cur[r][jq].x) * bfhi(cur[r][jq].x)) + (bflo(cur[r][jq].y) * bflo(cur[r][jq].y) + bfhi(cur[r][jq].y) * bfhi(cur[r][jq].y));
            const float ra = rsqrtf(wave_sum(sa) * (1.0f / 1024.0f) + EPS);
            f32x4* oa = (f32x4*)(out + (size_t)(t + r * NGW) * 1024) + lane;
#pragma unroll
            for (int jq = 0; jq < 4; ++jq) oa[64 * jq] = (f32x4){bflo(cur[r][jq].x) * ra * w[jq].x, bfhi(cur[r][jq].x) * ra * w[jq].y, bflo(cur[r][jq].y) * ra * w[jq].z, bfhi(cur[r][jq].y) * ra * w[jq].w}; }
#pragma unroll
        for (int r = 0; r < 4; ++r)
#pragma unroll
            for (int jq = 0; jq < 4; ++jq) cur[r][jq] = nxt[r][jq];
    }
}

#define XB_TMO      128
#define XB_XCNT(j)  (256  + 64 * (j))
#define XB_XSUB(j)  (1280 + 64 * (j))
#define XB_XGEN(j)  (2304 + 64 * (j))
#define XB_TOP      3328
#define XB_TOPGEN   3392
#define XCD_BAR_WORDS 3456
#define XB_SPIN_CAP (1u << 22)
__device__ __forceinline__ unsigned xb_ld(unsigned* p)              { return __hip_atomic_load(p, __ATOMIC_RELAXED, __HIP_MEMORY_SCOPE_AGENT); }
__device__ __forceinline__ unsigned xb_add(unsigned* p, unsigned v) { return __hip_atomic_fetch_add(p, v, __ATOMIC_RELAXED, __HIP_MEMORY_SCOPE_AGENT); }
__device__ __forceinline__ unsigned xb_xcc_id() { return (unsigned)__builtin_amdgcn_s_getreg((3 << 11) | 20) & 0xFu; }
#define XB_SPIN(cond, bar) do { unsigned _sp = 0; while (cond) { __builtin_amdgcn_s_sleep(1); \
    if ((++_sp & 255u) == 0u) { if (xb_ld(&(bar)[XB_TMO])) break; if (_sp > XB_SPIN_CAP) { atomicAdd(&(bar)[XB_TMO], 1u); break; } } } } while (0)
__device__ __forceinline__ unsigned xcd_barrier_post(unsigned* bar, volatile LAS unsigned* st) {
    const unsigned x = xb_xcc_id();
    if (threadIdx.x == 0) { st[2] = xb_add(&bar[XB_XCNT(x)], 1u); st[3] = x; }
    return x;
}
__device__ __forceinline__ void xcd_barrier_complete(unsigned* bar, unsigned x, unsigned& nloc, unsigned& nx) {
    const unsigned G = gridDim.x * gridDim.y * gridDim.z;
    unsigned sum, cnt, mine, sp = 0u;
    for (;;) {
        sum = 0u; cnt = 0u; mine = 0u;
#pragma unroll
        for (unsigned jx = 0; jx < 16; ++jx) { const unsigned c = xb_ld(&bar[XB_XCNT(jx)]); sum += c; cnt += (c > 0u) ? 1u : 0u; mine = (jx == x) ? c : mine; }
        if (sum == G) break;
        __builtin_amdgcn_s_sleep(1);
        if ((++sp & 255u) == 0u) { if (xb_ld(&bar[XB_TMO])) break; if (sp > XB_SPIN_CAP) { atomicAdd(&bar[XB_TMO], 1u); break; } }
    }
    nloc = mine > 0u ? mine : 1u; nx = cnt > 0u ? cnt : 1u;
}
__device__ __forceinline__ void xcd_barrier(unsigned* bar, unsigned x, volatile LAS unsigned* st, const bool thread0) {
    asm volatile("s_waitcnt vmcnt(0)" ::: "memory");
    __syncthreads();
    if (thread0) {
        __builtin_amdgcn_s_waitcnt(0);
        unsigned nloc = st[0], nx = st[1];
        if (nloc == 0u) { xcd_barrier_complete(bar, x, nloc, nx); st[0] = nloc; st[1] = nx; }
        const unsigned old = xb_add(&bar[XB_XSUB(x)], 1u);
        const unsigned gen = old / nloc;
        if (old + 1u == (gen + 1u) * nloc) {
            __builtin_amdgcn_fence(__ATOMIC_RELEASE, "agent");
            asm volatile("s_waitcnt vmcnt(0)" ::: "memory");
            const unsigned og = xb_add(&bar[XB_TOP], 1u);
            const unsigned tg = og / nx;
            if (og + 1u == (tg + 1u) * nx) xb_add(&bar[XB_TOPGEN], 1u);
            else XB_SPIN(xb_ld(&bar[XB_TOPGEN]) == tg, bar);
            __builtin_amdgcn_fence(__ATOMIC_ACQUIRE, "agent");
            xb_add(&bar[XB_XGEN(x)], 1u);
            asm volatile("s_waitcnt vmcnt(0)" ::: "memory");
        } else {
            XB_SPIN(xb_ld(&bar[XB_XGEN(x)]) == gen, bar);
            __builtin_amdgcn_fence(__ATOMIC_ACQUIRE, "agent");
            asm volatile("s_waitcnt vmcnt(0)" ::: "memory");
        }
    }
    __syncthreads();
}

struct Args { const float* in[20]; float* out; unsigned char* ws; int ph_lo, ph_hi; };
constexpr int N_PHASES = 16;
constexpr int LDS_MISC = RING_BYTES + 4096;
#define REPS(k) for (int rep_ = 0; rep_ < (((PROBE_MASK >> (k)) & 1) ? PROBE_REP : 1); ++rep_)

__global__ void __launch_bounds__(NT, 2) fwd(Args args) {
    extern __shared__ __attribute__((aligned(16))) unsigned char lds_raw[];
    LAS unsigned char* lds = (LAS unsigned char*)lds_raw;
    const int G = gridDim.x, bx = blockIdx.x;
    const int wave_s = __builtin_amdgcn_readfirstlane((int)threadIdx.x >> 6);
#define TID_FLAT (wave_s * 64 + (int)__builtin_amdgcn_mbcnt_hi(~0u, __builtin_amdgcn_mbcnt_lo(~0u, 0u)))
    const int vcu = (G % 8 == 0) ? (bx % 8) * (G / 8) + bx / 8 : bx;
    const int NGW = G * NWAVES;
    unsigned char* ws = args.ws;
    const int lo = args.ph_lo, hi = args.ph_hi;
    volatile LAS unsigned* bst = (volatile LAS unsigned*)(lds + LDS_MISC);
#if MK_N_LAUNCHES == 1
    cg::grid_group grid = cg::this_grid();
    unsigned* const barw = (unsigned*)(ws + WS_CTL);
    if (threadIdx.x < 8) bst[threadIdx.x] = 0u;
    __syncthreads();
    const unsigned bxcc = xcd_barrier_post(barw, bst);
    if (hi > 1000) grid.sync();
#ifdef PROBE_T
#define PROBE_T_MARK(k) do { if ((k) == PROBE_T && bx == PROBE_T_BLK && TID_FLAT == 0) *(volatile LAS unsigned long long*)(lds + LDS_MISC + 136) = wall_clock64(); } while (0)
    if (bx == PROBE_T_BLK && threadIdx.x == 0) { *(volatile LAS unsigned long long*)(lds + LDS_MISC + 128) = wall_clock64(); *(volatile LAS unsigned long long*)(lds + LDS_MISC + 136) = 0ull; }
#else
#define PROBE_T_MARK(k) do { } while (0)
#endif
#define SEAM(k) do { PROBE_T_MARK(100 + (k)); if (lo <= (k) && (k) + 1 < hi) { REPS(15) xcd_barrier(barw, bxcc, bst, TID_FLAT == 0); } PROBE_T_MARK(k); } while (0)
#else
#define SEAM(k) do { } while (0)
#endif
#ifndef PH_MASK
#define PH_MASK 0xFFFFF
#endif
#define IN(k) (((PH_MASK >> (k)) & 1) && lo <= (k) && (k) < hi)
#define PH_IDS int tid = TID_FLAT; asm volatile("" : "+v"(tid)); const int lane = tid & 63; const int wave = __builtin_amdgcn_readfirstlane(tid >> 6); const int gw = vcu * NWAVES + wave; (void)lane; (void)gw;
#if MK_N_LAUNCHES == 1
#define PEER_GROUP int grp, mem, nmem; { const unsigned nl_ = bst[0], nx_ = bst[1]; if (nx_ == 8u && nl_ > 0u) { grp = (int)bst[3]; mem = (int)bst[2]; nmem = (int)nl_; } else { grp = bx & 7; mem = bx >> 3; nmem = G >> 3; } } \
    grp = __builtin_amdgcn_readfirstlane(grp); mem = __builtin_amdgcn_readfirstlane(mem); nmem = __builtin_amdgcn_readfirstlane(nmem);
#else
#define PEER_GROUP const int grp = bx & 7, mem = bx >> 3, nmem = G >> 3;
#endif
#define ABUF ((bf16*)(ws + WS_A))
#define PROJ ((bf16*)(ws + WS_PROJ))
#define UST ((bf16*)(ws + WS_US))
#define DECAY ((float*)(ws + WS_DECAY))

    if (IN(0)) REPS(0) { PH_IDS p0_prologue(args.in, ws, lds, vcu, G, tid, rep_ == 0 ? 7 : PROBE_SUB); }
    SEAM(0);
    if (IN(1)) {
        { pg8::Gemm g{ABUF, (const bf16*)(ws + WS_WIN), M, IN_COLS, 512}; pg8::StaticOrder S; S.init(M, IN_COLS, G, bx, ((PROBE_MASK >> 1) & 1) ? PROBE_REP : 1);
          pg8::EpiBf16I8 E{PROJ, IN_COLS, (const float*)(ws + WS_PART1), (const float*)(ws + WS_WIN + 4 * MiB)};
          pg8::gemm_phase_i8<pg8::EpiBf16I8, pg8::StaticOrder, PG8_ALIGN, PG8_SP2>(lds, g, S, E, TID_FLAT); }
        { pg8::Gemm g{(const bf16*)(ws + WS_MEMN), (const bf16*)(ws + WS_WKV), MROWS, 1024, 1024}; pg8::StaticOrder S; S.init(MROWS, 1024, G, bx); pg8::EpiTile E{(bf16*)(ws + WS_KB), 4, 1};
          pg8::gemm_phase<pg8::EpiTile, pg8::StaticOrder, PG8_ALIGN, PG8_SP2>(lds, g, S, E, TID_FLAT); }
        { pg8::Gemm g{(const bf16*)(ws + WS_WKV) + (size_t)1024 * 1024, (const bf16*)(ws + WS_MEMN), 1024, MROWS, 1024}; pg8::StaticOrder S; S.init(1024, MROWS, G, (bx + 128) % G); pg8::EpiTile E{(bf16*)(ws + WS_VT), 1, 4};
          pg8::gemm_phase<pg8::EpiTile, pg8::StaticOrder, PG8_ALIGN, PG8_SP2>(lds, g, S, E, TID_FLAT); }
    }
    SEAM(1);
    if (IN(2)) REPS(2) { PH_IDS
        for (int m = 4 * gw; m < M; m += 4 * NGW) conv_tokens4(PROJ, args.in[4], args.in[5], ABUF, m, lane);
        for (int u = vcu; u < BATCH * 128; u += G) h1_unit(u >> 7, u & 127, PROJ, args.in[6], UST, DECAY, lds, tid);
    }
    SEAM(2);
    if (IN(3)) REPS(3) { PH_IDS const bool dry = rep_ + 1 < ((((PROBE_MASK >> 3) & 1) ? PROBE_REP : 1)); h2_scan(UST, DECAY, gw, NGW, lane, dry ? (long)((WS_X + 288 * MiB - WS_US) / 4) : 0L); }
    SEAM(3);
    if (IN(4)) REPS(4) { PH_IDS for (int u = vcu; u < BATCH * 128 * 4; u += G) h3_unit(u >> 9, (u >> 2) & 127, u & 3, PROJ, args.in[6], UST, args.in[7], ABUF, lds, tid); }
    SEAM(4);
    if (IN(5)) {
        pg8::Gemm g{ABUF, (const bf16*)(ws + WS_WOUT), M, 1024, 1024}; pg8::StaticOrder S; S.init(M, 1024, G, bx, ((PROBE_MASK >> 5) & 1) ? PROBE_REP : 1);
        pg8::EpiResid E{args.in[0], nullptr, (bf16*)(ws + WS_B1), (float*)(ws + WS_PART1), 0};
        pg8::gemm_phase<pg8::EpiResid, pg8::StaticOrder, PG8_ALIGN, PG8_SP2>(lds, g, S, E, TID_FLAT);
    }
    SEAM(5);
    if (IN(6)) {
        pg8::Gemm g{(const bf16*)(ws + WS_B1), (const bf16*)(ws + WS_WQ), M, 1024, 1024}; pg8::StaticOrder S; S.init(M, 1024, G, bx, ((PROBE_MASK >> 6) & 1) ? PROBE_REP : 1);
        pg8::EpiScaleBf16 E{(bf16*)(ws + WS_Q), 1024, (const float*)(ws + WS_PART1), QSCALE};
        pg8::gemm_phase<pg8::EpiScaleBf16, pg8::StaticOrder, PG8_ALIGN, PG8_SP2>(lds, g, S, E, TID_FLAT);
    }
    SEAM(6);
    if (IN(7)) REPS(7) { PH_IDS attn_phase((const bf16*)(ws + WS_Q), (const bf16*)(ws + WS_KB), (const bf16*)(ws + WS_VT), ABUF, lds, tid, vcu, G); }
    SEAM(7);
    if (IN(8)) {
        pg8::Gemm g{ABUF, (const bf16*)(ws + WS_WO), M, 1024, 1024}; pg8::StaticOrder S; S.init(M, 1024, G, bx, ((PROBE_MASK >> 8) & 1) ? PROBE_REP : 1);
        pg8::EpiResid E{nullptr, (const bf16*)(ws + WS_B1), (bf16*)(ws + WS_X2S), (float*)(ws + WS_PART2), M};
        pg8::gemm_phase<pg8::EpiResid, pg8::StaticOrder, PG8_ALIGN, PG8_SP2>(lds, g, S, E, TID_FLAT);
    }
    SEAM(8);
    if (IN(9)) REPS(9) { PH_IDS
        const int sel = rep_ == 0 ? 7 : PROBE_SUB;
        if (sel & 4) for (int m = gw; m < M; m += 4 * NGW) quant_x2_rows4((const bf16*)(ws + WS_X2S), ws + WS_XQ, (float*)(ws + WS_XSCALE), m, NGW, lane);
        if (sel & 2) for (int e = gw; e < NEXP; e += 2 * NGW) {
            const int e2 = e + NGW < NEXP ? e + NGW : e;
            quant_rows4(args.in[17], args.in[18], args.in[14], ws + WS_PDOWN, ws + WS_PUP, e, e2, lane, (float*)(ws + WS_DSCALE), (float*)(ws + WS_USCALE)); }
    }
    SEAM(9);
    if (IN(10)) {
        pg8::Gemm g{(const bf16*)(ws + WS_XQ), (const bf16*)(ws + WS_WEFF), M, 2048, 512, 64}; pg8::StaticOrder S; S.init(M, 2048, G, bx, ((PROBE_MASK >> 10) & 1) ? PROBE_REP : 1);
        pg8::EpiScoresI8 E{(unsigned short*)(ws + WS_SCT), M, (const float*)(ws + WS_PART2), (const float*)(ws + WS_XSCALE), (const float*)(ws + WS_WEFF + 2 * MiB)};
        pg8::gemm_phase_i8<pg8::EpiScoresI8, pg8::StaticOrder, PG8_ALIGN, PG8_SP2>(lds, g, S, E, TID_FLAT);
    }
    SEAM(10);
    if (IN(11)) REPS(11) { PH_IDS
        for (int task = gw; task < 8 * (M / 64); task += NGW) { const int head = task & 7, token = (task >> 3) * 64 + lane;
            peer_topk_task((const unsigned short*)(ws + WS_SCT), head, token, (unsigned short*)(ws + WS_IDX), (float*)(ws + WS_GATE), lds + tid * 32); }
    }
    SEAM(11);
    if (IN(12)) REPS(12) { PH_IDS PEER_GROUP
        peer_down_phase(ws + WS_XQ, ws + WS_PDOWN, (const unsigned short*)(ws + WS_IDX), (unsigned*)(ws + WS_SCT), grp, mem * NWAVES + wave, nmem * NWAVES, lane);
    }
    SEAM(12);
    if (IN(13)) REPS(13) { PH_IDS
        for (int t = gw; t < M; t += 4 * NGW) peer_combine_tokens4((const unsigned*)(ws + WS_SCT), (const float*)(ws + WS_PART2), (const unsigned short*)(ws + WS_IDX), (const float*)(ws + WS_DSCALE), (const float*)(ws + WS_USCALE),
                                                                          (const float*)(ws + WS_XSCALE), (const float*)(ws + WS_GATE), (unsigned*)(ws + WS_WPK), (float*)(ws + WS_CORR), t, NGW, lane); }
    SEAM(13);
    if (IN(14)) REPS(14) { PH_IDS PEER_GROUP
        const bool dry = rep_ + 1 < ((((PROBE_MASK >> 14) & 1) ? PROBE_REP : 1));
        peer_up_phase((bf16*)(ws + WS_X2S), (bf16*)(ws + (dry ? WS_PROBE_DUMMY : WS_X2S)), ws + WS_PUP, (const unsigned short*)(ws + WS_IDX), (const unsigned*)(ws + WS_WPK), (const float*)(ws + WS_CORR), grp, mem * NWAVES + wave, nmem * NWAVES, lane, lds + wave * 16384); }
    SEAM(14);
    if (IN(15)) REPS(15) { PH_IDS final_norm_phase((const bf16*)(ws + WS_X2S), args.out, args.in[19], gw, NGW, lane); }
    PROBE_T_MARK(15);
#ifdef PROBE_T
    if (bx == PROBE_T_BLK && TID_FLAT == 0) { const unsigned long long t0_ = *(volatile LAS unsigned long long*)(lds + LDS_MISC + 128), t1_ = *(volatile LAS unsigned long long*)(lds + LDS_MISC + 136);
        if (t1_ > t0_) { const unsigned long long te_ = wall_clock64(); while (wall_clock64() - te_ < (t1_ - t0_) * PROBE_T_MUL) __builtin_amdgcn_s_sleep(8); } }
#endif
#undef IN
#undef SEAM
}

extern "C" void kernel_launch(void* const* d_in, const int* in_sizes, int n_in, void* d_out, int out_size, void* d_ws, size_t ws_size, hipStream_t stream) {
    static int grid = 0;
    if (grid == 0) {
        if (n_in != 20 || in_sizes[0] != M * D || out_size != M * D || ws_size < WS_END) { fprintf(stderr, "kernel_launch: unexpected shapes: n_in %d in0 %d out %d ws %zu (need %zu)\n", n_in, n_in > 0 ? in_sizes[0] : -1, out_size, ws_size, (size_t)WS_END); grid = -1; return; }
        int dev = 0, cus = 0, per_cu = 0;
        if (hipGetDevice(&dev) != hipSuccess || hipDeviceGetAttribute(&cus, hipDeviceAttributeMultiprocessorCount, dev) != hipSuccess) { grid = -1; return; }
        if (hipFuncSetAttribute((const void*)fwd, hipFuncAttributeMaxDynamicSharedMemorySize, LDS_BYTES) != hipSuccess) { fprintf(stderr, "kernel_launch: hipFuncSetAttribute failed\n"); grid = -1; return; }
        if (hipOccupancyMaxActiveBlocksPerMultiprocessor(&per_cu, (const void*)fwd, NT, LDS_BYTES) != hipSuccess || per_cu < 1) { fprintf(stderr, "kernel_launch: occupancy query says %d blocks per CU\n", per_cu); (void)hipGetLastError(); grid = -1; return; }
        grid = cus;
    }
    if (grid < 0) return;
    Args a{};
    for (int i = 0; i < 20; ++i) a.in[i] = (const float*)d_in[i];
    a.out = (float*)d_out; a.ws = (unsigned char*)d_ws;
#if MK_N_LAUNCHES == 1
    if (hipMemsetAsync((char*)d_ws + WS_CTL, 0, CTL_ZERO_BYTES, stream) != hipSuccess) { fprintf(stderr, "kernel_launch: hipMemsetAsync failed\n"); return; }
    a.ph_lo = 0; a.ph_hi = N_PHASES;
    void* kargs[] = {&a};
    hipError_t e = hipLaunchCooperativeKernel((const void*)fwd, dim3(grid), dim3(NT), kargs, LDS_BYTES, stream);
    if (e != hipSuccess) fprintf(stderr, "kernel_launch: cooperative launch failed: %s (grid %d)\n", hipGetErrorString(e), grid);
#else
    for (int ph = 0; ph < N_PHASES; ++ph) { a.ph_lo = ph; a.ph_hi = ph + 1; hipLaunchKernelGGL(fwd, dim3(grid), dim3(NT), LDS_BYTES, stream, a); }
#endif
}
```

```cpp
#include <hip/hip_runtime.h>
#include <hip/hip_cooperative_groups.h>
#include <cstdio>
#include <cstdint>
namespace cg = cooperative_groups;

#ifndef MK_N_LAUNCHES
#define MK_N_LAUNCHES 1
#endif

#ifndef PROBE_REP
#define PROBE_REP 1
#endif
#ifndef PROBE_MASK
#define PROBE_MASK 0
#endif

#ifndef PROBE_T_BLK
#define PROBE_T_BLK 0
#endif
#ifndef PROBE_T_MUL
#define PROBE_T_MUL 1
#endif
#ifndef PROBE_SUB
#define PROBE_SUB 7
#endif

namespace pg8 {
#define PG8_LAS __attribute__((address_space(3)))
typedef unsigned short bf16_t;
typedef short bf16x8 __attribute__((ext_vector_type(8)));
typedef float f32x4 __attribute__((ext_vector_type(4)));
typedef unsigned u32x4 __attribute__((ext_vector_type(4)));
constexpr int BM = 256, BK = 64, HALF = 128, HTB = HALF * BK * 2  , STAGE_BYTES = 8 * HTB, NXCD = 8, WGM = 8;

__host__ __device__ __forceinline__ int lds_byte(int r, int c) { const int st = (r >> 4) * 2 + (c >> 5), rr = r & 15, cc = c & 31, ob = rr * 64 + cc * 2; return st * 1024 + (ob ^ (((ob >> 9) & 1) << 5)); }
__host__ __device__ __forceinline__ void stage_rc(int b, int& R, int& C) { const int st = b / 1024, sb = b % 1024, swz = sb ^ (((sb >> 9) & 1) << 5); R = (st >> 1) * 16 + swz / 64; C = (st & 1) * 32 + (swz % 64) / 2; }
__host__ __device__ __forceinline__ int perm32(int rho) { const int n = rho >> 4, i = rho & 15; return 8 * (i >> 2) + 4 * n + (i & 3); }

struct Unit { int pm, pn; };
struct Gemm { const bf16_t* A; const bf16_t* Bt; int M, N, K; int lda; };

struct StaticOrder {
    int nM, nN, nwg, G, c, rep;
    __host__ __device__ void init(int M, int N, int G_, int c_, int rep_ = 1) { nM = M / BM; nN = N / BM; nwg = nM * nN; G = G_; c = c_; rep = rep_; }
    __host__ __device__ bool next(int i, Unit& u) const {
        long L = (long)i * G + c; if (L >= (long)nwg * rep) return false; L %= nwg;
        int wgid = (int)L; { const int q = nwg / NXCD, r = nwg % NXCD, xcd = wgid % NXCD, off = wgid / NXCD; wgid = (xcd < r ? xcd * (q + 1) : r * (q + 1) + (xcd - r) * q) + off; }
        const int nig = WGM * nN, gid = wgid / nig, fm = gid * WGM, gsz = (nM - fm) < WGM ? (nM - fm) : WGM;
        u.pm = fm + ((wgid % nig) % gsz); u.pn = (wgid % nig) / gsz; return true;
    }
    __device__ __forceinline__ void a_ready(const Unit&) const {}
    __device__ __forceinline__ void done(const Unit&) const {}
};


__device__ __forceinline__ float sum_x16_x32(float v) {
    { const auto r = __builtin_amdgcn_permlane16_swap(__float_as_uint(v), __float_as_uint(v), false, false); v = __uint_as_float(r[0]) + __uint_as_float(r[1]); }
    { const auto r = __builtin_amdgcn_permlane32_swap(__float_as_uint(v), __float_as_uint(v), false, false); v = __uint_as_float(r[0]) + __uint_as_float(r[1]); }
    return v;
}
__device__ __forceinline__ unsigned cvt_pk_bf16(float lo, float hi) { unsigned r; asm volatile("v_cvt_pk_bf16_f32 %0, %1, %2" : "=v"(r) : "v"(lo), "v"(hi)); return r; }

struct EpiBf16 {
    static constexpr bool PERM = true, AFTER_DRAIN = false;
    bf16_t* O; int ldc;
    __device__ __forceinline__ void operator()(const f32x4 (&acc)[2][2][4][2], const Unit& u, int wr, int wc, int fr, int fq) const {
        const int row0 = u.pm * BM + wr * 64 + fr, col0 = u.pn * BM + wc * 32 + 8 * fq;
#pragma unroll
        for (int ai = 0; ai < 2; ++ai)
#pragma unroll
            for (int m = 0; m < 4; ++m) { bf16_t* rowp = O + (size_t)(row0 + ai * HALF + m * 16) * ldc + col0;
#pragma unroll
                for (int bj = 0; bj < 2; ++bj) { const f32x4 v0 = acc[ai][bj][m][0], v1 = acc[ai][bj][m][1];
                    u32x4 w; w.x = cvt_pk_bf16(v0[0], v0[1]); w.y = cvt_pk_bf16(v0[2], v0[3]); w.z = cvt_pk_bf16(v1[0], v1[1]); w.w = cvt_pk_bf16(v1[2], v1[3]);
                    *(u32x4*)(rowp + bj * HALF) = w; } }
    }
};
struct EpiTile {
    static constexpr bool PERM = true, AFTER_DRAIN = false;
    bf16_t* O; int sm, sn;
    __device__ __forceinline__ void operator()(const f32x4 (&acc)[2][2][4][2], const Unit& u, int wr, int wc, int fr, int fq) const {
        bf16_t* base = O + (size_t)(u.pm * sm + u.pn * sn) * 65536 + (size_t)(wr * 64 + fr) * 256 + wc * 32 + 8 * fq;
#pragma unroll
        for (int ai = 0; ai < 2; ++ai)
#pragma unroll
            for (int m = 0; m < 4; ++m) { bf16_t* rowp = base + (size_t)(ai * HALF + m * 16) * 256;
#pragma unroll
                for (int bj = 0; bj < 2; ++bj) { const f32x4 v0 = acc[ai][bj][m][0], v1 = acc[ai][bj][m][1];
                    u32x4 w; w.x = cvt_pk_bf16(v0[0], v0[1]); w.y = cvt_pk_bf16(v0[2], v0[3]); w.z = cvt_pk_bf16(v1[0], v1[1]); w.w = cvt_pk_bf16(v1[2], v1[3]);
                    *(u32x4*)(rowp + bj * HALF) = w; } }
    }
};
struct EpiResid {
    static constexpr bool PERM = true, AFTER_DRAIN = false;
    const float* basef; const bf16_t* baseb; bf16_t* xb; float* part; int sliced;
    __device__ __forceinline__ void operator()(const f32x4 (&acc)[2][2][4][2], const Unit& u, int wr, int wc, int fr, int fq) const {
        const int row0 = u.pm * BM + wr * 64 + fr, col0 = u.pn * BM + wc * 32 + 8 * fq;
#pragma unroll
        for (int ai = 0; ai < 2; ++ai)
#pragma unroll
            for (int m = 0; m < 4; ++m) { const int row = row0 + ai * HALF + m * 16; const size_t off = (size_t)row * 1024 + col0; float s = 0.f;
#pragma unroll
                for (int bj = 0; bj < 2; ++bj) {
                    f32x4 b0, b1;
                    if (basef) { b0 = *(const f32x4*)(basef + off + bj * HALF); b1 = *(const f32x4*)(basef + off + bj * HALF + 4); }
                    else { const u32x4 bw = *(const u32x4*)(baseb + off + bj * HALF);
                        b0 = (f32x4){__uint_as_float(bw.x << 16), __uint_as_float(bw.x & 0xffff0000u), __uint_as_float(bw.y << 16), __uint_as_float(bw.y & 0xffff0000u)};
                        b1 = (f32x4){__uint_as_float(bw.z << 16), __uint_as_float(bw.z & 0xffff0000u), __uint_as_float(bw.w << 16), __uint_as_float(bw.w & 0xffff0000u)}; }
                    const f32x4 v0 = acc[ai][bj][m][0] + b0, v1 = acc[ai][bj][m][1] + b1;
                    u32x4 w; w.x = cvt_pk_bf16(v0[0], v0[1]); w.y = cvt_pk_bf16(v0[2], v0[3]); w.z = cvt_pk_bf16(v1[0], v1[1]); w.w = cvt_pk_bf16(v1[2], v1[3]);
                    if (sliced) { const int col = col0 + bj * HALF; *(u32x4*)(xb + ((size_t)(col >> 6) * sliced + row) * 64 + (col & 63)) = w; }
                    else *(u32x4*)(xb + off + bj * HALF) = w;
                    s += (v0[0] * v0[0] + v0[1] * v0[1]) + (v0[2] * v0[2] + v0[3] * v0[3]) + (v1[0] * v1[0] + v1[1] * v1[1]) + (v1[2] * v1[2] + v1[3] * v1[3]); }
                s = sum_x16_x32(s);
                if (fq == 0) part[(size_t)row * 16 + u.pn * 4 + wc] = s; }
    }
};
__device__ __forceinline__ float row_rstd(const float* part, int row, int fq) {
    const f32x4 p = *(const f32x4*)(part + (size_t)row * 16 + 4 * fq); float t = (p[0] + p[1]) + (p[2] + p[3]);
    t = sum_x16_x32(t);
    return rsqrtf(t * (1.0f / 1024.0f) + 1e-6f);
}
struct EpiScaleBf16 {
    static constexpr bool PERM = true, AFTER_DRAIN = false;
    bf16_t* O; int ldc; const float* part; float scale;
    __device__ __forceinline__ void operator()(const f32x4 (&acc)[2][2][4][2], const Unit& u, int wr, int wc, int fr, int fq) const {
        const int row0 = u.pm * BM + wr * 64 + fr, col0 = u.pn * BM + wc * 32 + 8 * fq;
#pragma unroll
        for (int ai = 0; ai < 2; ++ai)
#pragma unroll
            for (int m = 0; m < 4; ++m) { const int row = row0 + ai * HALF + m * 16; const float sc = row_rstd(part, row, fq) * scale; bf16_t* rowp = O + (size_t)row * ldc + col0;
#pragma unroll
                for (int bj = 0; bj < 2; ++bj) { const f32x4 v0 = acc[ai][bj][m][0] * sc, v1 = acc[ai][bj][m][1] * sc;
                    u32x4 w; w.x = cvt_pk_bf16(v0[0], v0[1]); w.y = cvt_pk_bf16(v0[2], v0[3]); w.z = cvt_pk_bf16(v1[0], v1[1]); w.w = cvt_pk_bf16(v1[2], v1[3]);
                    *(u32x4*)(rowp + bj * HALF) = w; } }
    }
};
typedef int i32x4e __attribute__((ext_vector_type(4)));
typedef _Float16 f16x4 __attribute__((ext_vector_type(4)));
typedef _Float16 f16x2 __attribute__((ext_vector_type(2)));
struct EpiScoresT {
    static constexpr bool PERM = false, AFTER_DRAIN = false;
    unsigned short* scT; int Mtok; const float* part;
    __device__ __forceinline__ void operator()(const f32x4 (&acc)[2][2][4][2], const Unit& u, int wr, int wc, int fr, int fq) const {
        const int row0 = u.pm * BM + wr * 64 + fr;
#pragma unroll
        for (int ai = 0; ai < 2; ++ai)
#pragma unroll
            for (int m = 0; m < 4; ++m) { const int row = row0 + ai * HALF + m * 16; const float sc = row_rstd(part, row, fq);
#pragma unroll
                for (int bj = 0; bj < 2; ++bj)
#pragma unroll
                    for (int n = 0; n < 2; ++n) { const int hp = 2 * u.pn + bj, kq = 8 * wc + 4 * n + fq; const f32x4 v = acc[ai][bj][m][n] * sc;
                        *(f16x4*)(scT + ((size_t)(hp * 32 + kq) * Mtok + row) * 4) = (f16x4){(_Float16)v[0], (_Float16)v[1], (_Float16)v[2], (_Float16)v[3]}; } }
    }
};
struct EpiBf16I8 {
    static constexpr bool PERM = true, AFTER_DRAIN = false;
    bf16_t* O; int ldc; const float* rowscale; const float* colscale;
    __device__ __forceinline__ void operator()(const i32x4e (&acc)[2][2][4][2], const Unit& u, int wr, int wc, int fr, int fq) const {
        const int row0 = u.pm * BM + wr * 64 + fr, col0 = u.pn * BM + wc * 32 + 8 * fq;
        const bool fused = u.pn >= 2 && u.pn < 6;
        f32x4 cs[2][2];
#pragma unroll
        for (int bj = 0; bj < 2; ++bj) { cs[bj][0] = *(const f32x4*)(colscale + col0 + bj * HALF); cs[bj][1] = *(const f32x4*)(colscale + col0 + bj * HALF + 4); }
        float rs[2][4];
#pragma unroll
        for (int ai = 0; ai < 2; ++ai)
#pragma unroll
            for (int m = 0; m < 4; ++m) rs[ai][m] = rowscale[row0 + ai * HALF + m * 16];
#pragma unroll
        for (int ai = 0; ai < 2; ++ai)
#pragma unroll
            for (int m = 0; m < 4; ++m) { bf16_t* rowp = O + (size_t)(row0 + ai * HALF + m * 16) * ldc + col0; const float r_ = rs[ai][m];
                if (fused) {
                    const i32x4e a0 = acc[ai][0][m][0], a1 = acc[ai][0][m][1], b0 = acc[ai][1][m][0], b1 = acc[ai][1][m][1];
                    const f32x4 c0 = cs[0][0] * r_, c1 = cs[0][1] * r_, d0 = cs[1][0] * r_, d1 = cs[1][1] * r_;
                    u32x4 w; w.x = cvt_pk_bf16(((float)a0[0] * c0[0]) * ((float)b0[0] * d0[0]), ((float)a0[1] * c0[1]) * ((float)b0[1] * d0[1])); w.y = cvt_pk_bf16(((float)a0[2] * c0[2]) * ((float)b0[2] * d0[2]), ((float)a0[3] * c0[3]) * ((float)b0[3] * d0[3]));
                    w.z = cvt_pk_bf16(((float)a1[0] * c1[0]) * ((float)b1[0] * d1[0]), ((float)a1[1] * c1[1]) * ((float)b1[1] * d1[1])); w.w = cvt_pk_bf16(((float)a1[2] * c1[2]) * ((float)b1[2] * d1[2]), ((float)a1[3] * c1[3]) * ((float)b1[3] * d1[3]));
                    *(u32x4*)(O + (size_t)(row0 + ai * HALF + m * 16) * ldc + 512 + 128 * (u.pn - 2) + wc * 32 + 8 * fq) = w;
                } else
#pragma unroll
                for (int bj = 0; bj < 2; ++bj) { const i32x4e a0 = acc[ai][bj][m][0], a1 = acc[ai][bj][m][1]; const f32x4 c0 = cs[bj][0] * r_, c1 = cs[bj][1] * r_;
                    u32x4 w; w.x = cvt_pk_bf16((float)a0[0] * c0[0], (float)a0[1] * c0[1]); w.y = cvt_pk_bf16((float)a0[2] * c0[2], (float)a0[3] * c0[3]);
                    w.z = cvt_pk_bf16((float)a1[0] * c1[0], (float)a1[1] * c1[1]); w.w = cvt_pk_bf16((float)a1[2] * c1[2], (float)a1[3] * c1[3]);
                    *(u32x4*)(rowp + bj * HALF) = w; } }
    }
};
struct EpiScoresI8 {
    static constexpr bool PERM = false, AFTER_DRAIN = false;
    unsigned short* scT; int Mtok; const float* part; const float* xscale; const float* wscale;
    __device__ __forceinline__ void operator()(const i32x4e (&acc)[2][2][4][2], const Unit& u, int wr, int wc, int fr, int fq) const {
        const int row0 = u.pm * BM + wr * 64 + fr, colb = u.pn * BM + wc * 32 + 4 * fq;
        f32x4 ws[2][2];
#pragma unroll
        for (int bj = 0; bj < 2; ++bj)
#pragma unroll
            for (int n = 0; n < 2; ++n) ws[bj][n] = *(const f32x4*)(wscale + colb + bj * HALF + 16 * n);
#pragma unroll
        for (int ai = 0; ai < 2; ++ai)
#pragma unroll
            for (int m = 0; m < 4; ++m) { const int row = row0 + ai * HALF + m * 16; const float sc = row_rstd(part, row, fq) * xscale[row];
#pragma unroll
                for (int bj = 0; bj < 2; ++bj)
#pragma unroll
                    for (int n = 0; n < 2; ++n) { const int hp = 2 * u.pn + bj, kq = 8 * wc + 4 * n + fq; const i32x4e a = acc[ai][bj][m][n]; const f32x4 w = ws[bj][n];
                        *(f16x4*)(scT + ((size_t)(hp * 32 + kq) * Mtok + row) * 4) = (f16x4){(_Float16)((float)a[0] * sc * w[0]), (_Float16)((float)a[1] * sc * w[1]), (_Float16)((float)a[2] * sc * w[2]), (_Float16)((float)a[3] * sc * w[3])}; } }
    }
};

template <class Epi, class Sched, bool ALIGN_EPI = false, bool SP2 = false>
__device__ __forceinline__ void gemm_phase(PG8_LAS unsigned char* lds, const Gemm g, const Sched& S, const Epi& E, const int tid) {
    const int wid = __builtin_amdgcn_readfirstlane(tid >> 6), lane = tid & 63, wr = wid >> 2, wc = wid & 3, fr = lane & 15, fq = lane >> 4;
    const int K = g.K, nt = K / BK;
    const int ldA = g.lda ? g.lda : K;
    unsigned voffA[2], voffB[2];
#pragma unroll
    for (int i = 0; i < 2; ++i) { int R, C; stage_rc(tid * 16 + i * 8192, R, C); const int Rb = Epi::PERM ? ((R & ~31) + perm32(R & 31)) : R;
        voffA[i] = (unsigned)(R * ldA + C) * 2u; voffB[i] = (unsigned)(Rb * K + C) * 2u; }
    const size_t kstepA = g.lda ? (size_t)g.M * 64 * 2 : (size_t)(BK * 2);
    const size_t hstepA = (size_t)HALF * ldA * 2, tstepA = 2 * hstepA;
    const size_t kstep = (size_t)(BK * 2);
    const size_t hstep = (size_t)HALF * K * 2;
    const size_t tstep = 2 * hstep;
    const unsigned ldsw = (unsigned)wid * 1024u;
    const int aoff = lds_byte(wr * 64 + fr, fq * 8), boff = lds_byte(wc * 32 + fr, fq * 8);
#define PG8_SA(b, h) (((b) * 2 + (h)) * HTB)
#define PG8_SB(b, h) ((4 + (b) * 2 + (h)) * HTB)
#define PG8_STAGE(bufoff, gbase, voff) do { _Pragma("unroll") for (int _i = 0; _i < 2; ++_i) \
        __builtin_amdgcn_global_load_lds((const unsigned*)((const char*)(gbase) + (voff)[_i]), (PG8_LAS unsigned*)(lds + (bufoff) + ldsw + _i * 8192), 16, 0, 0); } while (0)
#define PG8_LDA(dst, b, h) do { _Pragma("unroll") for (int m = 0; m < 4; ++m) _Pragma("unroll") for (int k = 0; k < 2; ++k) dst[m][k] = *(const PG8_LAS bf16x8*)(lds + PG8_SA(b, h) + aoff + m * 2048 + k * 1024); } while (0)
#define PG8_LDB(dst, b, h) do { _Pragma("unroll") for (int n = 0; n < 2; ++n) _Pragma("unroll") for (int k = 0; k < 2; ++k) dst[n][k] = *(const PG8_LAS bf16x8*)(lds + PG8_SB(b, h) + boff + n * 2048 + k * 1024); } while (0)
#define PG8_MMA(ai, bj, At, Bt) do { __builtin_amdgcn_s_setprio(1); _Pragma("unroll") for (int m = 0; m < 4; ++m) _Pragma("unroll") for (int n = 0; n < 2; ++n) _Pragma("unroll") for (int k = 0; k < 2; ++k) \
        acc[ai][bj][m][n] = __builtin_amdgcn_mfma_f32_16x16x32_bf16(Bt[n][k], At[m][k], acc[ai][bj][m][n], 0, 0, 0); __builtin_amdgcn_s_setprio(0); } while (0)
#define PG8_WAIT_V(n) asm volatile("s_waitcnt vmcnt(" #n ")" ::: "memory")
#define PG8_WAIT_L(n) asm volatile("s_waitcnt lgkmcnt(" #n ")" ::: "memory")
#define PG8_BAR __builtin_amdgcn_s_barrier()
#define PG8_SCHED __builtin_amdgcn_sched_barrier(0)
    Unit cur, nxt; int ui = 0;
    if (!S.next(0, cur)) return;
    f32x4 acc[2][2][4][2];
#pragma unroll
    for (int a = 0; a < 2; ++a)
#pragma unroll
        for (int b = 0; b < 2; ++b)
#pragma unroll
            for (int m = 0; m < 4; ++m)
#pragma unroll
                for (int n = 0; n < 2; ++n) acc[a][b][m][n] = (f32x4){0.f, 0.f, 0.f, 0.f};
    bf16x8 At[4][2], B0[2][2], B1[2][2];
    const char* cA = (const char*)g.A + (size_t)cur.pm * tstepA; const char* cB = (const char*)g.Bt + (size_t)cur.pn * tstep;
    S.a_ready(cur);
    if constexpr (SP2) {
        PG8_STAGE(PG8_SB(0, 0), cB, voffB); PG8_STAGE(PG8_SB(0, 1), cB + hstep, voffB); PG8_STAGE(PG8_SA(0, 0), cA, voffA); PG8_STAGE(PG8_SA(0, 1), cA + hstepA, voffA);
        if (wr == 1) PG8_BAR;
        PG8_WAIT_V(2); PG8_BAR;
        PG8_STAGE(PG8_SB(1, 0), cB + kstep, voffB); PG8_STAGE(PG8_SA(1, 0), cA + kstepA, voffA); PG8_STAGE(PG8_SB(1, 1), cB + hstep + kstep, voffB);
        PG8_WAIT_V(6); PG8_BAR;
    } else {
        PG8_STAGE(PG8_SB(0, 0), cB, voffB); PG8_STAGE(PG8_SA(0, 0), cA, voffA); PG8_STAGE(PG8_SB(0, 1), cB + hstep, voffB); PG8_STAGE(PG8_SA(0, 1), cA + hstepA, voffA);
        if (wr == 1) PG8_BAR;
        PG8_WAIT_V(4); PG8_BAR;
        PG8_STAGE(PG8_SB(1, 0), cB + kstep, voffB); PG8_STAGE(PG8_SA(1, 0), cA + kstepA, voffA); PG8_STAGE(PG8_SB(1, 1), cB + hstep + kstep, voffB);
        PG8_WAIT_V(6); PG8_BAR;
    }
    for (;;) {
        const bool has_next = S.next(ui + 1, nxt);
        const char* nA = has_next ? (const char*)g.A + (size_t)nxt.pm * tstepA : cA; const char* nB = has_next ? (const char*)g.Bt + (size_t)nxt.pn * tstep : cB;
        for (int t = 0; t < nt; t += 2) {
            const bool last = (t == nt - 2);
            const char* a1 = cA + (size_t)(t + 1) * kstepA;
            const char* a2 = last ? nA : cA + (size_t)(t + 2) * kstepA; const char* b2 = last ? nB : cB + (size_t)(t + 2) * kstep;
            const char* a3 = a2 + kstepA; const char* b3 = b2 + kstep;
            if (last && has_next) S.a_ready(nxt);
            if constexpr (SP2) {
            PG8_LDB(B0, 0, 0); PG8_LDB(B1, 0, 1); PG8_SCHED; PG8_LDA(At, 0, 0); PG8_STAGE(PG8_SA(1, 1), a1 + hstepA, voffA);
            PG8_WAIT_V(8); PG8_WAIT_L(0); PG8_BAR; PG8_MMA(0, 0, At, B0); PG8_MMA(0, 1, At, B1); PG8_BAR; PG8_SCHED;
            PG8_LDA(At, 0, 1); PG8_STAGE(PG8_SB(0, 0), b2, voffB); PG8_STAGE(PG8_SB(0, 1), b2 + hstep, voffB); PG8_STAGE(PG8_SA(0, 0), a2, voffA);
            PG8_WAIT_V(8); PG8_WAIT_L(0); PG8_BAR; PG8_MMA(1, 0, At, B0); PG8_MMA(1, 1, At, B1); PG8_BAR; PG8_SCHED;
            PG8_LDB(B0, 1, 0); PG8_LDB(B1, 1, 1); PG8_SCHED; PG8_LDA(At, 1, 0); PG8_STAGE(PG8_SA(0, 1), a2 + hstepA, voffA);
            PG8_WAIT_V(8); PG8_WAIT_L(0); PG8_BAR; PG8_MMA(0, 0, At, B0); PG8_MMA(0, 1, At, B1); PG8_BAR; PG8_SCHED;
            PG8_LDA(At, 1, 1); PG8_STAGE(PG8_SB(1, 0), b3, voffB); PG8_STAGE(PG8_SB(1, 1), b3 + hstep, voffB); PG8_STAGE(PG8_SA(1, 0), a3, voffA);
            PG8_WAIT_V(8); PG8_WAIT_L(0); PG8_BAR; PG8_MMA(1, 0, At, B0); PG8_MMA(1, 1, At, B1); PG8_BAR; PG8_SCHED;
            } else {
            PG8_LDB(B0, 0, 0); PG8_SCHED; PG8_LDA(At, 0, 0); PG8_STAGE(PG8_SA(1, 1), a1 + hstepA, voffA);
            PG8_WAIT_L(8); PG8_BAR; PG8_WAIT_L(0); PG8_MMA(0, 0, At, B0); PG8_BAR; PG8_SCHED;
            PG8_LDB(B1, 0, 1); PG8_STAGE(PG8_SB(0, 0), b2, voffB);
            PG8_BAR; PG8_WAIT_L(0); PG8_MMA(0, 1, At, B1); PG8_BAR;
            PG8_LDA(At, 0, 1); PG8_STAGE(PG8_SA(0, 0), a2, voffA);
            PG8_BAR; PG8_WAIT_L(0); PG8_MMA(1, 0, At, B0); PG8_BAR; PG8_SCHED;
            PG8_STAGE(PG8_SB(0, 1), b2 + hstep, voffB);
            PG8_WAIT_V(6); PG8_BAR; PG8_MMA(1, 1, At, B1); PG8_BAR;
            PG8_LDB(B0, 1, 0); PG8_SCHED; PG8_LDA(At, 1, 0); PG8_STAGE(PG8_SA(0, 1), a2 + hstepA, voffA);
            PG8_WAIT_L(8); PG8_BAR; PG8_WAIT_L(0); PG8_MMA(0, 0, At, B0); PG8_BAR; PG8_SCHED;
            PG8_LDB(B1, 1, 1); PG8_STAGE(PG8_SB(1, 0), b3, voffB);
            PG8_BAR; PG8_WAIT_L(0); PG8_MMA(0, 1, At, B1); PG8_BAR;
            PG8_LDA(At, 1, 1); PG8_STAGE(PG8_SA(1, 0), a3, voffA);
            PG8_BAR; PG8_WAIT_L(0); PG8_MMA(1, 0, At, B0); PG8_BAR; PG8_SCHED;
            PG8_STAGE(PG8_SB(1, 1), b3 + hstep, voffB);
            PG8_WAIT_V(6); PG8_BAR; PG8_MMA(1, 1, At, B1); PG8_BAR;
            }
        }
        if constexpr (ALIGN_EPI) { if (wr == 0) PG8_BAR; }
        if constexpr (!Epi::AFTER_DRAIN) { E(acc, cur, wr, wc, fr, fq); S.done(cur); }
        if (!has_next) break;
#pragma unroll
        for (int a = 0; a < 2; ++a)
#pragma unroll
            for (int b = 0; b < 2; ++b)
#pragma unroll
                for (int m = 0; m < 4; ++m)
#pragma unroll
                    for (int n = 0; n < 2; ++n) acc[a][b][m][n] = (f32x4){0.f, 0.f, 0.f, 0.f};
        cur = nxt; cA = nA; cB = nB; ++ui;
        if constexpr (ALIGN_EPI) { if (wr == 1) PG8_BAR; }
    }
    PG8_WAIT_V(0);
    if constexpr (!ALIGN_EPI) { if (wr == 0) PG8_BAR; }
    PG8_BAR;
    if constexpr (Epi::AFTER_DRAIN) { E.fused(acc, cur, wr, wc, fr, fq, lds, wid, lane); S.done(cur); }
#undef PG8_SA
#undef PG8_SB
#undef PG8_STAGE
#undef PG8_LDA
#undef PG8_LDB
#undef PG8_MMA
#undef PG8_WAIT_V
#undef PG8_WAIT_L
#undef PG8_BAR
#undef PG8_SCHED
}
typedef int i32x4 __attribute__((ext_vector_type(4)));
template <class Epi, class Sched, bool ALIGN_EPI = false, bool SP2 = false>
__device__ __forceinline__ void gemm_phase_i8(PG8_LAS unsigned char* lds, const Gemm g, const Sched& S, const Epi& E, const int tid) {
    const int wid = __builtin_amdgcn_readfirstlane(tid >> 6), lane = tid & 63, wr = wid >> 2, wc = wid & 3, fr = lane & 15, fq = lane >> 4;
    const int K = g.K, nt = K / BK;
    const int ldA = g.lda ? g.lda : K;
    unsigned voffA[2], voffB[2];
#pragma unroll
    for (int i = 0; i < 2; ++i) { int R, C; stage_rc(tid * 16 + i * 8192, R, C); const int Rb = Epi::PERM ? ((R & ~31) + perm32(R & 31)) : R;
        voffA[i] = (unsigned)(R * ldA + C) * 2u; voffB[i] = (unsigned)(Rb * K + C) * 2u; }
    const size_t kstepA = g.lda ? (size_t)g.M * 64 * 2 : (size_t)(BK * 2);
    const size_t hstepA = (size_t)HALF * ldA * 2, tstepA = 2 * hstepA;
    const size_t kstep = (size_t)(BK * 2);
    const size_t hstep = (size_t)HALF * K * 2;
    const size_t tstep = 2 * hstep;
    const unsigned ldsw = (unsigned)wid * 1024u;
    const int aoff = lds_byte(wr * 64 + fr, fq * 8), boff = lds_byte(wc * 32 + fr, fq * 8);
#define PG8_SA(b, h) (((b) * 2 + (h)) * HTB)
#define PG8_SB(b, h) ((4 + (b) * 2 + (h)) * HTB)
#define PG8_STAGE(bufoff, gbase, voff) do { _Pragma("unroll") for (int _i = 0; _i < 2; ++_i) \
        __builtin_amdgcn_global_load_lds((const unsigned*)((const char*)(gbase) + (voff)[_i]), (PG8_LAS unsigned*)(lds + (bufoff) + ldsw + _i * 8192), 16, 0, 0); } while (0)
#define PG8_LDA(dst, b, h) do { _Pragma("unroll") for (int m = 0; m < 4; ++m) _Pragma("unroll") for (int k = 0; k < 2; ++k) dst[m][k] = *(const PG8_LAS bf16x8*)(lds + PG8_SA(b, h) + aoff + m * 2048 + k * 1024); } while (0)
#define PG8_LDB(dst, b, h) do { _Pragma("unroll") for (int n = 0; n < 2; ++n) _Pragma("unroll") for (int k = 0; k < 2; ++k) dst[n][k] = *(const PG8_LAS bf16x8*)(lds + PG8_SB(b, h) + boff + n * 2048 + k * 1024); } while (0)
#define PG8_MMA(ai, bj, At, Bt) do { __builtin_amdgcn_s_setprio(1); _Pragma("unroll") for (int m = 0; m < 4; ++m) _Pragma("unroll") for (int n = 0; n < 2; ++n) _Pragma("unroll") for (int k = 0; k < 2; ++k) \
        acc[ai][bj][m][n] = __builtin_amdgcn_mfma_i32_16x16x64_i8(__builtin_bit_cast(i32x4, Bt[n][k]), __builtin_bit_cast(i32x4, At[m][k]), acc[ai][bj][m][n], 0, 0, 0); __builtin_amdgcn_s_setprio(0); } while (0)
#define PG8_WAIT_V(n) asm volatile("s_waitcnt vmcnt(" #n ")" ::: "memory")
#define PG8_WAIT_L(n) asm volatile("s_waitcnt lgkmcnt(" #n ")" ::: "memory")
#define PG8_BAR __builtin_amdgcn_s_barrier()
#define PG8_SCHED __builtin_amdgcn_sched_barrier(0)
    Unit cur, nxt; int ui = 0;
    if (!S.next(0, cur)) return;
    i32x4 acc[2][2][4][2];
#pragma unroll
    for (int a = 0; a < 2; ++a)
#pragma unroll
        for (int b = 0; b < 2; ++b)
#pragma unroll
            for (int m = 0; m < 4; ++m)
#pragma unroll
                for (int n = 0; n < 2; ++n) acc[a][b][m][n] = (i32x4){0, 0, 0, 0};
    bf16x8 At[4][2], B0[2][2], B1[2][2];
    const char* cA = (const char*)g.A + (size_t)cur.pm * tstepA; const char* cB = (const char*)g.Bt + (size_t)cur.pn * tstep;
    S.a_ready(cur);
    if constexpr (SP2) {
        PG8_STAGE(PG8_SB(0, 0), cB, voffB); PG8_STAGE(PG8_SB(0, 1), cB + hstep, voffB); PG8_STAGE(PG8_SA(0, 0), cA, voffA); PG8_STAGE(PG8_SA(0, 1), cA + hstepA, voffA);
        if (wr == 1) PG8_BAR;
        PG8_WAIT_V(2); PG8_BAR;
        PG8_STAGE(PG8_SB(1, 0), cB + kstep, voffB); PG8_STAGE(PG8_SA(1, 0), cA + kstepA, voffA); PG8_STAGE(PG8_SB(1, 1), cB + hstep + kstep, voffB);
        PG8_WAIT_V(6); PG8_BAR;
    } else {
        PG8_STAGE(PG8_SB(0, 0), cB, voffB); PG8_STAGE(PG8_SA(0, 0), cA, voffA); PG8_STAGE(PG8_SB(0, 1), cB + hstep, voffB); PG8_STAGE(PG8_SA(0, 1), cA + hstepA, voffA);
        if (wr == 1) PG8_BAR;
        PG8_WAIT_V(4); PG8_BAR;
        PG8_STAGE(PG8_SB(1, 0), cB + kstep, voffB); PG8_STAGE(PG8_SA(1, 0), cA + kstepA, voffA); PG8_STAGE(PG8_SB(1, 1), cB + hstep + kstep, voffB);
        PG8_WAIT_V(6); PG8_BAR;
    }
    for (;;) {
        const bool has_next = S.next(ui + 1, nxt);
        const char* nA = has_next ? (const char*)g.A + (size_t)nxt.pm * tstepA : cA; const char* nB = has_next ? (const char*)g.Bt + (size_t)nxt.pn * tstep : cB;
        for (int t = 0; t < nt; t += 2) {
            const bool last = (t == nt - 2);
            const char* a1 = cA + (size_t)(t + 1) * kstepA;
            const char* a2 = last ? nA : cA + (size_t)(t + 2) * kstepA; const char* b2 = last ? nB : cB + (size_t)(t + 2) * kstep;
            const char* a3 = a2 + kstepA; const char* b3 = b2 + kstep;
            if (last && has_next) S.a_ready(nxt);
            if constexpr (SP2) {
            PG8_LDB(B0, 0, 0); PG8_LDB(B1, 0, 1); PG8_SCHED; PG8_LDA(At, 0, 0); PG8_STAGE(PG8_SA(1, 1), a1 + hstepA, voffA);
            PG8_WAIT_V(8); PG8_WAIT_L(0); PG8_BAR; PG8_MMA(0, 0, At, B0); PG8_MMA(0, 1, At, B1); PG8_BAR; PG8_SCHED;
            PG8_LDA(At, 0, 1); PG8_STAGE(PG8_SB(0, 0), b2, voffB); PG8_STAGE(PG8_SB(0, 1), b2 + hstep, voffB); PG8_STAGE(PG8_SA(0, 0), a2, voffA);
            PG8_WAIT_V(8); PG8_WAIT_L(0); PG8_BAR; PG8_MMA(1, 0, At, B0); PG8_MMA(1, 1, At, B1); PG8_BAR; PG8_SCHED;
            PG8_LDB(B0, 1, 0); PG8_LDB(B1, 1, 1); PG8_SCHED; PG8_LDA(At, 1, 0); PG8_STAGE(PG8_SA(0, 1), a2 + hstepA, voffA);
            PG8_WAIT_V(8); PG8_WAIT_L(0); PG8_BAR; PG8_MMA(0, 0, At, B0); PG8_MMA(0, 1, At, B1); PG8_BAR; PG8_SCHED;
            PG8_LDA(At, 1, 1); PG8_STAGE(PG8_SB(1, 0), b3, voffB); PG8_STAGE(PG8_SB(1, 1), b3 + hstep, voffB); PG8_STAGE(PG8_SA(1, 0), a3, voffA);
            PG8_WAIT_V(8); PG8_WAIT_L(0); PG8_BAR; PG8_MMA(1, 0, At, B0); PG8_MMA(1, 1, At, B1); PG8_BAR; PG8_SCHED;
            } else {
            PG8_LDB(B0, 0, 0); PG8_SCHED; PG8_LDA(At, 0, 0); PG8_STAGE(PG8_SA(1, 1), a1 + hstepA, voffA);
            PG8_WAIT_L(8); PG8_BAR; PG8_WAIT_L(0); PG8_MMA(0, 0, At, B0); PG8_BAR; PG8_SCHED;
            PG8_LDB(B1, 0, 1); PG8_STAGE(PG8_SB(0, 0), b2, voffB);
            PG8_BAR; PG8_WAIT_L(0); PG8_MMA(0, 1, At, B1); PG8_BAR;
            PG8_LDA(At, 0, 1); PG8_STAGE(PG8_SA(0, 0), a2, voffA);
            PG8_BAR; PG8_WAIT_L(0); PG8_MMA(1, 0, At, B0); PG8_BAR; PG8_SCHED;
            PG8_STAGE(PG8_SB(0, 1), b2 + hstep, voffB);
            PG8_WAIT_V(6); PG8_BAR; PG8_MMA(1, 1, At, B1); PG8_BAR;
            PG8_LDB(B0, 1, 0); PG8_SCHED; PG8_LDA(At, 1, 0); PG8_STAGE(PG8_SA(0, 1), a2 + hstepA, voffA);
            PG8_WAIT_L(8); PG8_BAR; PG8_WAIT_L(0); PG8_MMA(0, 0, At, B0); PG8_BAR; PG8_SCHED;
            PG8_LDB(B1, 1, 1); PG8_STAGE(PG8_SB(1, 0), b3, voffB);
            PG8_BAR; PG8_WAIT_L(0); PG8_MMA(0, 1, At, B1); PG8_BAR;
            PG8_LDA(At, 1, 1); PG8_STAGE(PG8_SA(1, 0), a3, voffA);
            PG8_BAR; PG8_WAIT_L(0); PG8_MMA(1, 0, At, B0); PG8_BAR; PG8_SCHED;
            PG8_STAGE(PG8_SB(1, 1), b3 + hstep, voffB);
            PG8_WAIT_V(6); PG8_BAR; PG8_MMA(1, 1, At, B1); PG8_BAR;
            }
        }
        if constexpr (ALIGN_EPI) { if (wr == 0) PG8_BAR; }
        if constexpr (!Epi::AFTER_DRAIN) { E(acc, cur, wr, wc, fr, fq); S.done(cur); }
        if (!has_next) break;
#pragma unroll
        for (int a = 0; a < 2; ++a)
#pragma unroll
            for (int b = 0; b < 2; ++b)
#pragma unroll
                for (int m = 0; m < 4; ++m)
#pragma unroll
                    for (int n = 0; n < 2; ++n) acc[a][b][m][n] = (i32x4){0, 0, 0, 0};
        cur = nxt; cA = nA; cB = nB; ++ui;
        if constexpr (ALIGN_EPI) { if (wr == 1) PG8_BAR; }
    }
    PG8_WAIT_V(0);
    if constexpr (!ALIGN_EPI) { if (wr == 0) PG8_BAR; }
    PG8_BAR;
    if constexpr (Epi::AFTER_DRAIN) { E.fused(acc, cur, wr, wc, fr, fq, lds, wid, lane); S.done(cur); }
#undef PG8_SA
#undef PG8_SB
#undef PG8_STAGE
#undef PG8_LDA
#undef PG8_LDB
#undef PG8_MMA
#undef PG8_WAIT_V
#undef PG8_WAIT_L
#undef PG8_BAR
#undef PG8_SCHED
}
}

#ifndef PG8_SP2
#define PG8_SP2 true
#endif
#ifndef PG8_ALIGN
#define PG8_ALIGN true
#endif

constexpr int NWAVES = 8, NT = NWAVES * 64;
constexpr int BATCH = 4, SEQ = 8192, D = 1024, M = BATCH * SEQ;
constexpr int IN_COLS = 3584;
constexpr int NMEM = 256, MROWS = BATCH * NMEM;
constexpr int NEXP = 16384;
constexpr float EPS = 1e-6f;
constexpr float QSCALE = 0.0625f * 1.4426950408889634f;

constexpr size_t MiB = 1u << 20;
constexpr size_t WS_CTL = 0, CTL_ZERO_BYTES = 64 * 1024;
constexpr size_t WS_PART1 = 1 * MiB;
constexpr size_t WS_DECAY = 5 * MiB;
constexpr size_t WS_WIN = 6 * MiB, WS_WOUT = 13 * MiB, WS_WQ = 15 * MiB, WS_WKV = 17 * MiB, WS_WO = 21 * MiB, WS_WEFF = 23 * MiB;
constexpr size_t WS_MEMN = 27 * MiB, WS_KB = 29 * MiB, WS_VT = 31 * MiB;
constexpr size_t WS_PUP = 1 * MiB;
constexpr size_t WS_A = 33 * MiB;
constexpr size_t WS_X = 97 * MiB;
constexpr size_t WS_PROJ = WS_X, WS_US = WS_X + 224 * MiB;
constexpr size_t WS_B1 = WS_X, WS_Q = WS_X + 64 * MiB;
constexpr size_t WS_X2S = WS_X + 64 * MiB;
constexpr size_t WS_SCT = WS_X + 128 * MiB;
constexpr size_t WS_PDOWN = WS_X;
constexpr size_t WS_IDX = WS_A, WS_GATE = WS_A + 8 * MiB;
constexpr size_t WS_PART2 = WS_X + 384 * MiB;
constexpr size_t WS_SSQ = WS_PART2 + 2 * MiB;
constexpr size_t WS_DSCALE = WS_SSQ + 2 * MiB, WS_USCALE = WS_DSCALE + 65536;
constexpr size_t WS_XSCALE = WS_USCALE + 65536, WS_CORR = WS_XSCALE + 131072;
constexpr size_t WS_WPK = WS_A + 56 * MiB;
constexpr size_t WS_XQ = WS_A + 24 * MiB;
constexpr size_t WS_END = WS_CORR + 131072;

constexpr size_t WS_PROBE_DUMMY = WS_X + 256 * MiB;
constexpr int RING_BYTES = 131072, LDS_BYTES = 147456;

#define LAS __attribute__((address_space(3)))
typedef unsigned short bf16;
typedef float f32x2 __attribute__((ext_vector_type(2)));
typedef float f32x4 __attribute__((ext_vector_type(4)));
typedef float f32x16 __attribute__((ext_vector_type(16)));
typedef short bf16x8 __attribute__((ext_vector_type(8)));
typedef unsigned v4u __attribute__((ext_vector_type(4)));
typedef unsigned v2u __attribute__((ext_vector_type(2)));
typedef __bf16 bf16x2_t __attribute__((ext_vector_type(2)));
#define LDS_WAIT() asm volatile("s_waitcnt lgkmcnt(0)" ::: "memory")
__device__ __forceinline__ float bf2f(unsigned short b) { return __uint_as_float(((unsigned)b) << 16); }
__device__ __forceinline__ float bflo(unsigned u) { return __uint_as_float(u << 16); }
__device__ __forceinline__ float bfhi(unsigned u) { return __uint_as_float(u & 0xffff0000u); }
__device__ __forceinline__ unsigned pk2(float lo, float hi) { f32x2 v = {lo, hi}; bf16x2_t b = __builtin_convertvector(v, bf16x2_t); return __builtin_bit_cast(unsigned, b); }
__device__ __forceinline__ float xlane_dpp_b1(float v) { return __uint_as_float((unsigned)__builtin_amdgcn_update_dpp(0, (int)__float_as_uint(v), 0xB1, 0xF, 0xF, false)); }
__device__ __forceinline__ float xlane_dpp_4e(float v) { return __uint_as_float((unsigned)__builtin_amdgcn_update_dpp(0, (int)__float_as_uint(v), 0x4E, 0xF, 0xF, false)); }
__device__ __forceinline__ float xlane_dpp_x4(float v) { int r = __builtin_amdgcn_update_dpp(0, (int)__float_as_uint(v), 0x12C, 0xF, 0x5, false); r = __builtin_amdgcn_update_dpp(r, (int)__float_as_uint(v), 0x124, 0xF, 0xA, false); return __uint_as_float((unsigned)r); }
__device__ __forceinline__ float xlane_dpp_x8(float v) { return __uint_as_float((unsigned)__builtin_amdgcn_update_dpp(0, (int)__float_as_uint(v), 0x128, 0xF, 0xF, false)); }
__device__ __forceinline__ float xlane_x16(float v) { const auto r = __builtin_amdgcn_permlane16_swap(__float_as_uint(v), __float_as_uint(v), false, false); return __uint_as_float((__builtin_amdgcn_mbcnt_lo(~0u, 0u) + __builtin_amdgcn_mbcnt_hi(~0u, 0u)) & 16 ? r[0] : r[1]); }
__device__ __forceinline__ float xlane_x32(float v) { const auto r = __builtin_amdgcn_permlane32_swap(__float_as_uint(v), __float_as_uint(v), false, false); return __uint_as_float((__builtin_amdgcn_mbcnt_lo(~0u, 0u) + __builtin_amdgcn_mbcnt_hi(~0u, 0u)) & 32 ? r[0] : r[1]); }
__device__ __forceinline__ float wave_sum(float v) {
    v += xlane_dpp_b1(v); v += xlane_dpp_4e(v); v += xlane_dpp_x4(v); v += xlane_dpp_x8(v);
    { const auto r = __builtin_amdgcn_permlane16_swap(__float_as_uint(v), __float_as_uint(v), false, false); v = __uint_as_float(r[0]) + __uint_as_float(r[1]); }
    { const auto r = __builtin_amdgcn_permlane32_swap(__float_as_uint(v), __float_as_uint(v), false, false); v = __uint_as_float(r[0]) + __uint_as_float(r[1]); }
    return v;
}
__device__ __forceinline__ float wave_max(float v) {
    v = fmaxf(v, xlane_dpp_b1(v)); v = fmaxf(v, xlane_dpp_4e(v)); v = fmaxf(v, xlane_dpp_x4(v)); v = fmaxf(v, xlane_dpp_x8(v));
    { const auto r = __builtin_amdgcn_permlane16_swap(__float_as_uint(v), __float_as_uint(v), false, false); v = fmaxf(__uint_as_float(r[0]), __uint_as_float(r[1])); }
    { const auto r = __builtin_amdgcn_permlane32_swap(__float_as_uint(v), __float_as_uint(v), false, false); v = fmaxf(__uint_as_float(r[0]), __uint_as_float(r[1])); }
    return v;
}
__device__ __forceinline__ float sigmoidf_(float x) { return __builtin_amdgcn_rcpf(1.0f + __expf(-x)); }
__device__ __forceinline__ int kappa(int rho) { return (rho & 0x13) | ((rho & 4) << 1) | ((rho & 8) >> 1); }
__device__ __forceinline__ bf16x8 as_bf16x8(v4u v) { return __builtin_bit_cast(bf16x8, v); }

__device__ __forceinline__ void p0_transpose_item(const float* W, int K, int N, bf16* WT, const float* gain, LAS float* scr, int item, int lane) {
    const int nblk = N / 32, kb = item / nblk, nb = item % nblk, k0 = 64 * kb, n0 = 32 * nb;
    float wv[32];
#pragma unroll
    for (int i = 0; i < 32; ++i) { const int kk = 2 * i + (lane >> 5); wv[i] = W[(size_t)(k0 + kk) * N + n0 + (lane & 31)]; }
#pragma unroll
    for (int i = 0; i < 32; ++i) { const int kk = 2 * i + (lane >> 5); const float g = gain ? gain[k0 + kk] : 1.0f; scr[kk * 33 + (lane & 31)] = wv[i] * g; }
    LDS_WAIT();
    const int c = lane & 7;
#pragma unroll
    for (int j = 0; j < 4; ++j) { const int n = (lane >> 3) + 8 * j; const LAS float* s = scr + (8 * c) * 33 + n;
        v4u o; o.x = pk2(s[0 * 33], s[1 * 33]); o.y = pk2(s[2 * 33], s[3 * 33]); o.z = pk2(s[4 * 33], s[5 * 33]); o.w = pk2(s[6 * 33], s[7 * 33]);
        *(v4u*)(WT + (size_t)(n0 + n) * K + k0 + 8 * c) = o; }
    LDS_WAIT();
}
__device__ __forceinline__ void rms_row_to_bf16(const float* xrow, const float* gain, bf16* orow, int lane) {
    const f32x4* xr = (const f32x4*)xrow + lane; f32x4 v[4]; float s = 0.f;
#pragma unroll
    for (int j = 0; j < 4; ++j) { v[j] = xr[64 * j]; s += (v[j].x * v[j].x + v[j].y * v[j].y) + (v[j].z * v[j].z + v[j].w * v[j].w); }
    const float r = rsqrtf(wave_sum(s) * (1.0f / 1024.0f) + EPS);
    const f32x4* gr = (const f32x4*)gain + lane; unsigned long long* o8 = (unsigned long long*)orow + lane;
#pragma unroll
    for (int j = 0; j < 4; ++j) { const f32x4 g = gr[64 * j]; o8[64 * j] = (unsigned long long)pk2(v[j].x * r * g.x, v[j].y * r * g.y) | ((unsigned long long)pk2(v[j].z * r * g.z, v[j].w * r * g.w) << 32); }
}
__device__ __forceinline__ void p0_weffq_wg(const float* wquery, const float* subkeys, const float* gain, signed char* WQ, float* wscale, int item, LAS unsigned char* lds, int tid) {
    const int hp = item >> 4, kg = item & 15, lane = tid & 63, wave = tid >> 6;
    LAS f32x4* sk = (LAS f32x4*)lds;
    LAS float* am_s = (LAS float*)(lds + 8192);
    if (tid < 256) sk[tid] = ((const f32x4*)(subkeys + (size_t)(hp * 128 + kg * 8) * 128))[tid];
    __syncthreads();
    float acc[2][8];
#pragma unroll
    for (int ph = 0; ph < 2; ++ph) { const int k = (ph * 8 + wave) * 64 + lane; const f32x4* wrow = (const f32x4*)(wquery + (size_t)k * 2048 + hp * 128);
#pragma unroll
        for (int i = 0; i < 8; ++i) acc[ph][i] = 0.f;
#pragma unroll 4
        for (int d4 = 0; d4 < 32; ++d4) { const f32x4 w = wrow[d4];
#pragma unroll
            for (int key = 0; key < 8; ++key) { const f32x4 sv = sk[key * 32 + d4]; acc[ph][key] += (w.x * sv.x + w.y * sv.y) + (w.z * sv.z + w.w * sv.w); } }
        const float g = gain[k];
#pragma unroll
        for (int i = 0; i < 8; ++i) acc[ph][i] *= g; }
#pragma unroll
    for (int key = 0; key < 8; ++key) { const float m = wave_max(fmaxf(fabsf(acc[0][key]), fabsf(acc[1][key]))); if (lane == 0) am_s[wave * 8 + key] = m; }
    __syncthreads();
    if (tid < 8) { float m = 0.f;
#pragma unroll
        for (int w8 = 0; w8 < 8; ++w8) m = fmaxf(m, am_s[w8 * 8 + tid]);
        am_s[256 + tid] = m; wscale[hp * 128 + kg * 8 + tid] = m * (1.0f / 127.0f); }
    __syncthreads();
#pragma unroll
    for (int key = 0; key < 8; ++key) { const float am = am_s[256 + key]; const float inv = am > 0.f ? 127.0f / am : 0.f;
#pragma unroll
        for (int ph = 0; ph < 2; ++ph) WQ[(size_t)(hp * 128 + kg * 8 + key) * 1024 + (ph * 8 + wave) * 64 + lane] = (signed char)(int)rintf(acc[ph][key] * inv); }
    __syncthreads();
}
__device__ __forceinline__ void p0_win_wg(const float* W, signed char* WQ, float* wscale, int item, LAS unsigned char* lds, int tid) {
    const int n0 = 14 * item, nl = tid & 15, kr = tid >> 4; const bool act = nl < 14;
    LAS float* am_s = (LAS float*)lds;
    LAS unsigned char* tile = lds + 4096;
    float wv[32]; float am = 0.f;
    const int nn = n0 + nl; int src = nn; if (nn >= 512 && nn < 1536) { const int t = (nn - 512) >> 8, w_ = (nn - 512) & 255; src = w_ < 128 ? 512 + 128 * t + w_ : 1024 + 128 * t + (w_ - 128); }
#pragma unroll
    for (int i = 0; i < 32; ++i) wv[i] = act ? W[(size_t)(kr + 32 * i) * IN_COLS + src] : 0.f;
#pragma unroll
    for (int i = 0; i < 32; ++i) am = fmaxf(am, fabsf(wv[i]));
    am_s[kr * 16 + nl] = am;
    __syncthreads();
    if (tid < 16) { float m = 0.f;
#pragma unroll
        for (int r = 0; r < 32; ++r) m = fmaxf(m, am_s[r * 16 + tid]);
        am_s[512 + tid] = m; if (tid < 14) wscale[n0 + tid] = m * (1.0f / 127.0f); }
    __syncthreads();
    { const float amx = am_s[512 + nl]; const float inv = amx > 0.f ? 127.0f / amx : 0.f;
      if (act) {
#pragma unroll
          for (int i = 0; i < 32; ++i) tile[nl * 1028 + kr + 32 * i] = (unsigned char)((int)rintf(wv[i] * inv) & 255); } }
    __syncthreads();
    for (int p = tid; p < 14 * 64; p += NT) { const int n = p >> 6, c = p & 63; const LAS unsigned* src = (const LAS unsigned*)(tile + n * 1028 + 16 * c);
        *(v4u*)(WQ + (size_t)(n0 + n) * 1024 + 16 * c) = (v4u){src[0], src[1], src[2], src[3]}; }
    __syncthreads();
}
__device__ __forceinline__ void p0_prologue(const float* const* in, unsigned char* ws, LAS unsigned char* lds, int vcu, int G, int tid, int sel) {
    const int lane = tid & 63, wave = __builtin_amdgcn_readfirstlane(tid >> 6), gw = vcu * NWAVES + wave, NGW = G * NWAVES;
    LAS float* scr = (LAS float*)(lds + wave * 16384);
    const float *x = in[0], *mem = in[1], *mix_norm_w = in[2], *w_in = in[3], *w_out = in[8], *xattn_norm_w = in[9], *mem_norm_w = in[10], *wq = in[11], *wkv = in[12], *wo = in[13],
                *ffn_norm_w = in[14], *w_query = in[15], *sub_keys = in[16];
    const bool rows_first = (vcu & 1) != 0;
#pragma unroll 1
    for (int pass = 0; pass < 2; ++pass) {
      if ((pass == 0) != rows_first) {
    if (sel & 1) for (int it = vcu; it < 256; it += G) { p0_weffq_wg(w_query, sub_keys, ffn_norm_w, (signed char*)(ws + WS_WEFF), (float*)(ws + WS_WEFF + 2 * MiB), it, lds, tid);
                                                          p0_win_wg(w_in, (signed char*)(ws + WS_WIN), (float*)(ws + WS_WIN + 4 * MiB), it, lds, tid); }
    constexpr int I_SQ = 16 * 32, I_KV = 16 * 64;
    constexpr int NITEMS = 3 * I_SQ + I_KV;
    if (sel & 2) for (int it = gw; it < NITEMS; it += NGW) {
        int r = it;
        if (r < I_SQ) { p0_transpose_item(w_out, 1024, 1024, (bf16*)(ws + WS_WOUT), nullptr, scr, r, lane); continue; } r -= I_SQ;
        if (r < I_SQ) { p0_transpose_item(wq, 1024, 1024, (bf16*)(ws + WS_WQ), xattn_norm_w, scr, r, lane); continue; } r -= I_SQ;
        if (r < I_KV) { p0_transpose_item(wkv, 1024, 2048, (bf16*)(ws + WS_WKV), nullptr, scr, r, lane); continue; } r -= I_KV;
        p0_transpose_item(wo, 1024, 1024, (bf16*)(ws + WS_WO), nullptr, scr, r, lane);
    }
      } else if (sel & 4) {
    for (int m = gw; m < MROWS; m += NGW) rms_row_to_bf16(mem + (size_t)m * D, mem_norm_w, (bf16*)(ws + WS_MEMN) + (size_t)m * D, lane);
    for (int m = gw; m < M; m += 4 * NGW) {
        f32x4 v[4][4]; float ss[4], am[4];
#pragma unroll
        for (int r = 0; r < 4; ++r) { const int mr = m + r * NGW < M ? m + r * NGW : m; const f32x4* xr = (const f32x4*)(x + (size_t)mr * D) + lane;
#pragma unroll
            for (int j = 0; j < 4; ++j) v[r][j] = xr[64 * j]; }
        const f32x4* gr = (const f32x4*)mix_norm_w + lane;
#pragma unroll
        for (int r = 0; r < 4; ++r) { float s = 0.f, a_ = 0.f;
#pragma unroll
            for (int j = 0; j < 4; ++j) { s += (v[r][j].x * v[r][j].x + v[r][j].y * v[r][j].y) + (v[r][j].z * v[r][j].z + v[r][j].w * v[r][j].w); v[r][j] = v[r][j] * gr[64 * j];
                a_ = fmaxf(a_, fmaxf(fmaxf(fabsf(v[r][j].x), fabsf(v[r][j].y)), fmaxf(fabsf(v[r][j].z), fabsf(v[r][j].w)))); }
            ss[r] = s; am[r] = a_; }
#pragma unroll
        for (int r = 0; r < 4; ++r) { ss[r] = wave_sum(ss[r]); am[r] = wave_max(am[r]); }
#pragma unroll
        for (int r = 0; r < 4; ++r) { if (m + r * NGW < M) { const int mr = m + r * NGW; const float rr = rsqrtf(ss[r] * (1.0f / 1024.0f) + EPS), inv = am[r] > 0.f ? 127.0f / am[r] : 0.f;
            unsigned* o4 = (unsigned*)(ws + WS_A + (size_t)mr * D) + lane;
#pragma unroll
            for (int j = 0; j < 4; ++j) { const int q0 = (int)rintf(v[r][j].x * inv), q1 = (int)rintf(v[r][j].y * inv), q2 = (int)rintf(v[r][j].z * inv), q3 = (int)rintf(v[r][j].w * inv);
                o4[64 * j] = (unsigned)(q0 & 255) | ((unsigned)(q1 & 255) << 8) | ((unsigned)(q2 & 255) << 16) | ((unsigned)(q3 & 255) << 24); }
            if (lane == 0) ((float*)(ws + WS_PART1))[mr] = rr * am[r] * (1.0f / 127.0f); } }
    }
      }
    }
}

struct ConvIn { v4u bg, cg0, vv0, cg1, vv1, cg2, vv2; };
__device__ __forceinline__ ConvIn conv_load(const bf16* P, int m, int lane) {
    const int t = m & (SEQ - 1), c0 = 8 * lane; const bf16* row = P + (size_t)m * IN_COLS; ConvIn in;
    in.bg = *(const v4u*)(row + c0); in.cg0 = *(const v4u*)(row + 512 + c0); in.vv0 = *(const v4u*)(row + 1024 + c0);
    in.cg1 = (v4u){0, 0, 0, 0}; in.vv1 = (v4u){0, 0, 0, 0}; in.cg2 = (v4u){0, 0, 0, 0}; in.vv2 = (v4u){0, 0, 0, 0};
    if (t >= 1) { in.cg1 = *(const v4u*)(row - IN_COLS + 512 + c0); in.vv1 = *(const v4u*)(row - IN_COLS + 1024 + c0); }
    if (t >= 2) { in.cg2 = *(const v4u*)(row - 2 * IN_COLS + 512 + c0); in.vv2 = *(const v4u*)(row - 2 * IN_COLS + 1024 + c0); }
    return in;
}
__device__ __forceinline__ void conv_finish(const ConvIn& in, const float* conv_w, const float* conv_norm_w, bf16* Y, int m, int lane) {
    const int c0 = 8 * lane;
    const f32x4 w0a = *(const f32x4*)(conv_w + c0), w0b = *(const f32x4*)(conv_w + c0 + 4);
    const f32x4 w1a = *(const f32x4*)(conv_w + 512 + c0), w1b = *(const f32x4*)(conv_w + 512 + c0 + 4);
    const f32x4 w2a = *(const f32x4*)(conv_w + 1024 + c0), w2b = *(const f32x4*)(conv_w + 1024 + c0 + 4);
    float y[8]; float ss = 0.f;
#pragma unroll
    for (int q = 0; q < 4; ++q) {
#pragma unroll
        for (int hl = 0; hl < 2; ++hl) { const int e = 2 * q + hl;
            const float b = hl ? bfhi(in.bg[q]) : bflo(in.bg[q]);
            const float u0 = (hl ? bfhi(in.cg0[q]) : bflo(in.cg0[q])) * (hl ? bfhi(in.vv0[q]) : bflo(in.vv0[q]));
            const float u1 = (hl ? bfhi(in.cg1[q]) : bflo(in.cg1[q])) * (hl ? bfhi(in.vv1[q]) : bflo(in.vv1[q]));
            const float u2 = (hl ? bfhi(in.cg2[q]) : bflo(in.cg2[q])) * (hl ? bfhi(in.vv2[q]) : bflo(in.vv2[q]));
            const float wt0 = e < 4 ? w0a[e & 3] : w0b[e & 3], wt1 = e < 4 ? w1a[e & 3] : w1b[e & 3], wt2 = e < 4 ? w2a[e & 3] : w2b[e & 3];
            y[e] = b * (wt0 * u2 + wt1 * u1 + wt2 * u0); ss += y[e] * y[e]; } }
    const float r = rsqrtf(wave_sum(ss) * (1.0f / 512.0f) + EPS);
    const f32x4 ga = *(const f32x4*)(conv_norm_w + c0), gb = *(const f32x4*)(conv_norm_w + c0 + 4);
    v4u o; o.x = pk2(y[0] * r * ga[0], y[1] * r * ga[1]); o.y = pk2(y[2] * r * ga[2], y[3] * r * ga[3]); o.z = pk2(y[4] * r * gb[0], y[5] * r * gb[1]); o.w = pk2(y[6] * r * gb[2], y[7] * r * gb[3]);
    *(v4u*)(Y + (size_t)m * 1024 + c0) = o;
}
__device__ __forceinline__ void conv_tokens4(const bf16* P, const float* conv_w, const float* conv_norm_w, bf16* Y, int m0, int lane) {
    const int t0 = m0 & (SEQ - 1), c0 = 8 * lane; const bf16* row = P + (size_t)m0 * IN_COLS;
    v4u bg[4], ug[6];
#pragma unroll
    for (int r = 0; r < 4; ++r) bg[r] = *(const v4u*)(row + (size_t)r * IN_COLS + c0);
#pragma unroll
    for (int r = 0; r < 6; ++r) { if (t0 + r - 2 >= 0) ug[r] = *(const v4u*)(row + (ptrdiff_t)(r - 2) * IN_COLS + 512 + c0); else ug[r] = (v4u){0, 0, 0, 0}; }
    const f32x4 w0a = *(const f32x4*)(conv_w + c0), w0b = *(const f32x4*)(conv_w + c0 + 4);
    const f32x4 w1a = *(const f32x4*)(conv_w + 512 + c0), w1b = *(const f32x4*)(conv_w + 512 + c0 + 4);
    const f32x4 w2a = *(const f32x4*)(conv_w + 1024 + c0), w2b = *(const f32x4*)(conv_w + 1024 + c0 + 4);
    const f32x4 ga = *(const f32x4*)(conv_norm_w + c0), gb = *(const f32x4*)(conv_norm_w + c0 + 4);
    float u[6][8];
#pragma unroll
    for (int r = 0; r < 6; ++r)
#pragma unroll
        for (int q = 0; q < 4; ++q) { u[r][2 * q] = bflo(ug[r][q]); u[r][2 * q + 1] = bfhi(ug[r][q]); }
    float y[4][8], ss[4];
#pragma unroll
    for (int r = 0; r < 4; ++r) { float s = 0.f;
#pragma unroll
        for (int e = 0; e < 8; ++e) { const float b = (e & 1) ? bfhi(bg[r][e >> 1]) : bflo(bg[r][e >> 1]);
            const float wt0 = e < 4 ? w0a[e & 3] : w0b[e & 3], wt1 = e < 4 ? w1a[e & 3] : w1b[e & 3], wt2 = e < 4 ? w2a[e & 3] : w2b[e & 3];
            y[r][e] = b * (wt0 * u[r][e] + wt1 * u[r + 1][e] + wt2 * u[r + 2][e]); s += y[r][e] * y[r][e]; }
        ss[r] = s; }
#pragma unroll
    for (int r = 0; r < 4; ++r) { const float rr = rsqrtf(wave_sum(ss[r]) * (1.0f / 512.0f) + EPS);
        v4u o; o.x = pk2(y[r][0] * rr * ga[0], y[r][1] * rr * ga[1]); o.y = pk2(y[r][2] * rr * ga[2], y[r][3] * rr * ga[3]); o.z = pk2(y[r][4] * rr * gb[0], y[r][5] * rr * gb[1]); o.w = pk2(y[r][6] * rr * gb[2], y[r][7] * rr * gb[3]);
        *(v4u*)(Y + (size_t)(m0 + r) * 1024 + c0) = o; }
}

__device__ __forceinline__ void h1_unit(int b, int n, const bf16* P, const float* lbl, bf16* UsT, float* decay, LAS unsigned char* lds, int tid) {
    const int c = tid, h = c >> 7, kch = c & 127, lane = tid & 63, w = tid >> 6;
    const size_t tok0 = (size_t)b * SEQ + (size_t)n * 64;
    const float lb = sigmoidf_(lbl[c] - lbl[512 + c]), oml = 1.0f - lb;
    LAS unsigned char* KT = lds; LAS unsigned char* IT = lds + 65536; LAS float* DEC = (LAS float*)(lds + 131072);
    {
        const bf16* pf = P + tok0 * IN_COLS + 2048 + c;
        float Pf = 1.f;
#pragma unroll 1
        for (int seg = 0; seg < 2; ++seg) {
            float fv[32]; unsigned iv[16];
#pragma unroll
            for (int j = 0; j < 32; ++j) fv[j] = bf2f(pf[(size_t)j * IN_COLS]);
#pragma unroll
            for (int j = 0; j < 16; ++j) iv[j] = (unsigned)pf[(size_t)(2 * j) * IN_COLS + 512] | ((unsigned)pf[(size_t)(2 * j + 1) * IN_COLS + 512] << 16);
            pf += (size_t)32 * IN_COLS;
#pragma unroll
            for (int q = 0; q < 4; ++q) { unsigned pk[4];
#pragma unroll
                for (int e = 0; e < 4; ++e) { float kt2[2];
#pragma unroll
                    for (int hl = 0; hl < 2; ++hl) { const float sg = sigmoidf_(fv[8 * q + 2 * e + hl]); Pf *= lb + oml * sg; kt2[hl] = oml * (1.0f - sg) * __builtin_amdgcn_rcpf(Pf); }
                    pk[e] = pk2(kt2[0], kt2[1]); }
                *(LAS v4u*)(KT + c * 128 + (((4 * seg + q) ^ (c & 7)) * 16)) = (v4u){pk[0], pk[1], pk[2], pk[3]}; }
#pragma unroll
            for (int q = 0; q < 4; ++q) *(LAS v4u*)(IT + c * 128 + (((4 * seg + q) ^ (c & 7)) * 16)) = (v4u){iv[4 * q], iv[4 * q + 1], iv[4 * q + 2], iv[4 * q + 3]};
        }
        const float dcy = Pf;
        DEC[c] = dcy;
        decay[((size_t)(b * 4 + h) * 128 + n) * 128 + kch] = dcy;
    }
    __syncthreads();
    {
        const int hd = w >> 1, half = w & 1, l31 = lane & 31, hh = lane >> 5;
        bf16* ub = UsT + ((size_t)(b * 4 + hd) * 128 + n) * 16384;
#pragma unroll 1
        for (int vb = 0; vb < 2; ++vb) {
            f32x16 acc[4];
#pragma unroll
            for (int bq = 0; bq < 4; ++bq)
#pragma unroll
                for (int r = 0; r < 16; ++r) acc[bq][r] = 0.f;
            const int v = hd * 128 + (half * 2 + vb) * 32 + l31;
#pragma unroll
            for (int s = 0; s < 4; ++s) { const int chunk = 2 * s + hh; bf16x8 bfr[4];
                const bf16x8 af = *(const LAS bf16x8*)(IT + v * 128 + ((chunk ^ (v & 7)) * 16));
#pragma unroll
                for (int kb = 0; kb < 4; ++kb) { const int k = hd * 128 + kb * 32 + l31; bfr[kb] = *(const LAS bf16x8*)(KT + k * 128 + ((chunk ^ (k & 7)) * 16)); }
#pragma unroll
                for (int kb = 0; kb < 4; ++kb) acc[kb] = __builtin_amdgcn_mfma_f32_32x32x16_bf16(af, bfr[kb], acc[kb], 0, 0, 0); }
#pragma unroll
            for (int kb = 0; kb < 4; ++kb) { const float dk = DEC[hd * 128 + kb * 32 + l31];
#pragma unroll
                for (int r = 0; r < 16; ++r) { const int vr = (half * 2 + vb) * 32 + (r & 3) + 8 * (r >> 2) + 4 * hh; ub[(size_t)vr * 128 + kb * 32 + l31] = (bf16)(pk2(acc[kb][r] * dk, 0.f) & 0xffffu); } }
        }
    }
    __syncthreads();
}

__device__ __forceinline__ void h2_scan(bf16* UsT, const float* decay, int gw, int NGW, int lane, long dry_off) {
    for (int task = gw; task < 16 * 128; task += NGW) {
        const int bh = task >> 7, v = task & 127;
        unsigned* p = (unsigned*)(UsT + (size_t)bh * 128 * 16384 + (size_t)v * 128) + lane;
        const f32x2* dp = (const f32x2*)(decay + (size_t)bh * 128 * 128) + lane;
        f32x2 S = {0.f, 0.f};
        for (int n0 = 0; n0 < 128; n0 += 16) { unsigned u[16]; f32x2 d[16];
#pragma unroll
            for (int j = 0; j < 16; ++j) { u[j] = p[(size_t)(n0 + j) * 8192]; d[j] = dp[(size_t)(n0 + j) * 64]; }
#pragma unroll
            for (int j = 0; j < 16; ++j) { p[(size_t)(n0 + j) * 8192 + dry_off] = pk2(S.x, S.y); S = d[j] * S + (f32x2){bflo(u[j]), bfhi(u[j])}; } }
    }
}

struct H3In { v4u raw[3][2]; v4u stv[4]; v4u g0, g1; };
__device__ __forceinline__ void h3_load(H3In& in, int b, int n, int h, const bf16* P, const bf16* UsT, int tid) {
    const size_t tok0 = (size_t)b * SEQ + (size_t)n * 64; const int bh = b * 4 + h;
#pragma unroll
    for (int tl = 0; tl < 3; ++tl)
#pragma unroll
        for (int i = 0; i < 2; ++i) { const int idx = tid + 512 * i, row = idx >> 4, ch = idx & 15; in.raw[tl][i] = *(const v4u*)(P + (tok0 + row) * IN_COLS + 1536 + 512 * tl + h * 128 + 8 * ch); }
    const int v = tid >> 2, kq = tid & 3; const v4u* src = (const v4u*)(UsT + ((size_t)bh * 128 + n) * 16384 + (size_t)v * 128 + 32 * kq);
#pragma unroll
    for (int i = 0; i < 4; ++i) in.stv[i] = src[i];
    { const int t = tid >> 3, vc = tid & 7; const bf16* gp = P + (tok0 + t) * IN_COLS + 3072 + h * 128 + 16 * vc; in.g0 = *(const v4u*)gp; in.g1 = *(const v4u*)(gp + 8); }
}
__device__ __forceinline__ void h3_unit(int b, int n, int h, const bf16* P, const float* lbl, const bf16* UsT, const float* hnw, bf16* Y, LAS unsigned char* lds, int tid, H3In& in, bool has_next, int un) {
    const int lane = tid & 63, w = tid >> 6, bh = b * 4 + h;
    const size_t tok0 = (size_t)b * SEQ + (size_t)n * 64;
    LAS unsigned char* RAW = lds; LAS unsigned char* QD = lds + 49152; LAS unsigned char* KI = lds + 65536; LAS unsigned char* IT = lds + 81920; LAS unsigned char* ST = lds + 98304;
    LAS float* OS = (LAS float*)lds; LAS float* TOT = (LAS float*)(lds + 131072);
    const v4u g0 = in.g0, g1 = in.g1;
    {
        { const int v = tid >> 2, kq = tid & 3;
#pragma unroll
          for (int tl = 0; tl < 3; ++tl)
#pragma unroll
              for (int i = 0; i < 2; ++i) *(LAS v4u*)(RAW + tl * 16384 + (tid + 512 * i) * 16) = in.raw[tl][i];
#pragma unroll
          for (int i = 0; i < 4; ++i) *(LAS v4u*)(ST + v * 256 + (((4 * kq + i) ^ (v & 15)) * 16)) = in.stv[i];
          if (has_next) h3_load(in, un >> 9, (un >> 2) & 127, un & 3, P, UsT, tid); }
        __syncthreads();
        const int k = tid & 127, tq = tid >> 7;
        const float lb = sigmoidf_(lbl[h * 128 + k] - lbl[512 + h * 128 + k]), oml = 1.0f - lb;
        const LAS bf16* rq = (const LAS bf16*)RAW + (16 * tq) * 128 + k; const LAS bf16* rf = rq + 8192; const LAS bf16* ri = rq + 16384;
        float sg[16], cs[16], qv[16]; float c = 1.f;
#pragma unroll
        for (int j = 0; j < 16; ++j) { const float f = bf2f(rf[j * 128]); qv[j] = bf2f(rq[j * 128]); sg[j] = sigmoidf_(f); c *= lb + oml * sg[j]; cs[j] = c; }
        TOT[tq * 128 + k] = c;
        { unsigned iv[8];
#pragma unroll
          for (int j = 0; j < 8; ++j) iv[j] = (unsigned)ri[(2 * j) * 128] | ((unsigned)ri[(2 * j + 1) * 128] << 16);
          const int sw = (k >> 1) & 7;
          *(LAS v4u*)(IT + k * 128 + (((2 * tq) ^ sw) * 16)) = (v4u){iv[0], iv[1], iv[2], iv[3]};
          *(LAS v4u*)(IT + k * 128 + (((2 * tq + 1) ^ sw) * 16)) = (v4u){iv[4], iv[5], iv[6], iv[7]}; }
        __syncthreads();
        float off = 1.f;
#pragma unroll
        for (int q = 0; q < 4; ++q) off *= (q < tq) ? TOT[q * 128 + k] : 1.f;
#pragma unroll
        for (int j = 0; j < 16; ++j) { const int t = 16 * tq + j; const float eg = off * cs[j];
            const float qd = qv[j] * sigmoidf_(qv[j]) * eg, ki = oml * (1.0f - sg[j]) * __builtin_amdgcn_rcpf(eg);
            const int o = t * 256 + (((k >> 3) ^ (t & 15)) * 16) + (k & 7) * 2;
            *(LAS bf16*)(QD + o) = (bf16)(pk2(qd, 0.f) & 0xffffu); *(LAS bf16*)(KI + o) = (bf16)(pk2(ki, 0.f) & 0xffffu); }
    }
    __syncthreads();
    {
        const int tb = w & 1, vb = w >> 1, l31 = lane & 31, hh = lane >> 5, t = 32 * tb + l31;
        bf16x8 qf[8];
#pragma unroll
        for (int ks = 0; ks < 8; ++ks) qf[ks] = *(const LAS bf16x8*)(QD + t * 256 + (((2 * ks + hh) ^ (t & 15)) * 16));
        f32x16 o;
#pragma unroll
        for (int r = 0; r < 16; ++r) o[r] = 0.f;
        const int v = 32 * vb + l31;
#pragma unroll
        for (int sb = 0; sb < 2; ++sb) {
            if (sb <= tb) {
                f32x16 x;
#pragma unroll
                for (int r = 0; r < 16; ++r) x[r] = 0.f;
                const int srow = 32 * sb + kappa(l31);
#pragma unroll
                for (int ks = 0; ks < 8; ++ks) { const bf16x8 a = *(const LAS bf16x8*)(KI + srow * 256 + (((2 * ks + hh) ^ (srow & 15)) * 16)); x = __builtin_amdgcn_mfma_f32_32x32x16_bf16(a, qf[ks], x, 0, 0, 0); }
                if (sb == tb) {
#pragma unroll
                    for (int r = 0; r < 16; ++r) { const int sp = 16 * ((r >> 3) & 1) + 8 * hh + 4 * ((r >> 2) & 1) + (r & 3); if (sp > l31) x[r] = 0.f; } }
#pragma unroll
                for (int st = 0; st < 2; ++st) {
                    const v4u pb = {pk2(x[8 * st + 0], x[8 * st + 1]), pk2(x[8 * st + 2], x[8 * st + 3]), pk2(x[8 * st + 4], x[8 * st + 5]), pk2(x[8 * st + 6], x[8 * st + 7])};
                    const bf16x8 a = *(const LAS bf16x8*)(IT + v * 128 + (((4 * sb + 2 * st + hh) ^ ((v >> 1) & 7)) * 16));
                    o = __builtin_amdgcn_mfma_f32_32x32x16_bf16(a, as_bf16x8(pb), o, 0, 0, 0); }
            }
        }
#pragma unroll
        for (int ks = 0; ks < 8; ++ks) { const bf16x8 a = *(const LAS bf16x8*)(ST + v * 256 + (((2 * ks + hh) ^ (v & 15)) * 16)); o = __builtin_amdgcn_mfma_f32_32x32x16_bf16(a, qf[ks], o, 0, 0, 0); }
#pragma unroll
        for (int r = 0; r < 16; ++r) OS[t * 129 + 32 * vb + (r & 3) + 8 * (r >> 2) + 4 * hh] = o[r];
    }
    __syncthreads();
    {
        const int t = tid >> 3, vc = tid & 7; float ov[16]; float ss = 0.f;
#pragma unroll
        for (int j = 0; j < 16; ++j) { ov[j] = OS[t * 129 + 16 * vc + j]; ss += ov[j] * ov[j]; }
        ss += xlane_dpp_b1(ss); ss += xlane_dpp_4e(ss); ss += xlane_dpp_x4(ss);
        const float r = rsqrtf(ss * (1.0f / 128.0f) + EPS);
        const float* nw = hnw + h * 128 + 16 * vc;
        unsigned ow[8];
#pragma unroll
        for (int j = 0; j < 8; ++j) { const unsigned gw_ = j < 4 ? g0[j] : g1[j - 4]; const float ga = bflo(gw_), gb = bfhi(gw_);
            ow[j] = pk2(ov[2 * j] * r * nw[2 * j] * (ga * sigmoidf_(ga)), ov[2 * j + 1] * r * nw[2 * j + 1] * (gb * sigmoidf_(gb))); }
        bf16* yp = Y + (tok0 + t) * 1024 + 512 + h * 128 + 16 * vc;
        *(v4u*)yp = (v4u){ow[0], ow[1], ow[2], ow[3]}; *(v4u*)(yp + 8) = (v4u){ow[4], ow[5], ow[6], ow[7]};
    }
    __syncthreads();
}

typedef float f32x4a __attribute__((ext_vector_type(4)));
__device__ __forceinline__ int kswz(int row) { return (row & 3) | (((row >> 3) & 3) << 2); }
__device__ __forceinline__ void attn_phase(const bf16* Q, const bf16* Kb, const bf16* VT, bf16* O, LAS unsigned char* lds, int tid, int vcu, int G) {
    const int lane = tid & 63, w = __builtin_amdgcn_readfirstlane(tid >> 6), l15 = lane & 15, kq = lane >> 4;
    int u = vcu; if (u >= 1024) return;
    unsigned koff[4], voff[4];
#pragma unroll
    for (int i = 0; i < 4; ++i) { const int idx = tid + 512 * i; { const int row = idx >> 5, ch = idx & 31; koff[i] = (unsigned)(row * 256 + ((ch ^ kswz(row)) * 8)) * 2u; }
        { const int row = idx >> 3, ch = idx & 7; voff[i] = (unsigned)(row * 256 + ((ch ^ ((row >> 1) & 7)) * 8)) * 2u; } }
#define ATT_LOAD(j, kbase_, vbase_) do { const char* tb_ = (j) < 4 ? (const char*)(kbase_) + (size_t)(j) * 32768 : (const char*)(vbase_) + (size_t)((j) - 4) * 128; \
        _Pragma("unroll") for (int i = 0; i < 4; ++i) { unsigned o_ = (j) < 4 ? koff[i] : voff[i]; asm volatile("" : "+v"(o_));     \
            __builtin_amdgcn_global_load_lds((const unsigned*)(tb_ + o_), (LAS unsigned*)(lds + ((j) & 3) * 32768 + i * 8192 + w * 1024), 16, 0, 0); } } while (0)
#define ATT_LANDED(n) do { asm volatile("s_waitcnt vmcnt(" #n ") lgkmcnt(0)" ::: "memory"); __builtin_amdgcn_s_barrier(); asm volatile("" ::: "memory"); } while (0)
#define ATT_LANDED2(n_next, n_last) do { if (has_next) asm volatile("s_waitcnt vmcnt(" #n_next ") lgkmcnt(0)" ::: "memory"); else asm volatile("s_waitcnt vmcnt(" #n_last ") lgkmcnt(0)" ::: "memory"); __builtin_amdgcn_s_barrier(); asm volatile("" ::: "memory"); } while (0)
#define ATT_UNIT(u_, tok_, kbase_, vbase_, hd_) const int b_##u_ = (u_) >> 8, hd_ = ((u_) >> 6) & 3; const int tok_ = b_##u_ * SEQ + ((u_) & 63) * 128 + 16 * w;     \
        const bf16* kbase_ = Kb + (size_t)(b_##u_ * 4 + hd_) * 65536; const bf16* vbase_ = VT + (size_t)(b_##u_ * 4 + hd_) * 65536;
    bf16x8 qf[8];
    { ATT_UNIT(u, tok0, kb0, vb0, hd0)
      const bf16* qp = Q + (size_t)tok0 * 1024 + hd0 * 256 + (l15 * 1024 + 8 * kq);
#pragma unroll
      for (int ks = 0; ks < 8; ++ks) qf[ks] = *(const bf16x8*)(qp + 32 * ks);
      asm volatile("" ::: "memory");
      ATT_LOAD(0, kb0, vb0); ATT_LOAD(1, kb0, vb0); ATT_LOAD(2, kb0, vb0); }
    ATT_LANDED(0);
#define ATT_TOUCH_Q() do { _Pragma("unroll") for (int ks = 0; ks < 8; ++ks) asm volatile("" :: "v"(__builtin_bit_cast(v4u, qf[ks]))); } while (0)
    ATT_TOUCH_Q();
#pragma unroll 1
    for (; u < 1024; u += G) {
        const bool has_next = u + G < 1024;
        const int un = has_next ? u + G : u;
        ATT_UNIT(u, tok, kbase, vbase, hd)
        ATT_UNIT(un, tokn, kbn, vbn, hdn)
        f32x4a p[16];
#pragma unroll
        for (int j = 0; j < 4; ++j) {
            ATT_LOAD(j + 3, kbase, vbase);
            const LAS unsigned char* buf = lds + (j & 3) * 32768;
#define S_READ(dst, blk) do { const int row = 32 * ((blk) >> 1) + 8 * (l15 >> 2) + 4 * ((blk) & 1) + (l15 & 3); \
                _Pragma("unroll") for (int ks = 0; ks < 8; ++ks) dst[ks] = *(const LAS bf16x8*)(buf + row * 512 + (((4 * ks + kq) ^ kswz(row)) * 16)); } while (0)
#define S_MMA(src, blk) do { f32x4a x0 = {0.f, 0.f, 0.f, 0.f}, x1 = {0.f, 0.f, 0.f, 0.f}; \
                _Pragma("unroll") for (int ks = 0; ks < 8; ks += 2) { x0 = __builtin_amdgcn_mfma_f32_16x16x32_bf16(src[ks], qf[ks], x0, 0, 0, 0); x1 = __builtin_amdgcn_mfma_f32_16x16x32_bf16(src[ks + 1], qf[ks + 1], x1, 0, 0, 0); } \
                p[4 * j + (blk)] = x0 + x1; } while (0)
            { bf16x8 fa[8], fb[8];
              S_READ(fa, 0); __builtin_amdgcn_sched_barrier(0);
              S_READ(fb, 1); __builtin_amdgcn_sched_barrier(0); S_MMA(fa, 0); __builtin_amdgcn_sched_barrier(0);
              S_READ(fa, 2); __builtin_amdgcn_sched_barrier(0); S_MMA(fb, 1); __builtin_amdgcn_sched_barrier(0);
              S_READ(fb, 3); __builtin_amdgcn_sched_barrier(0); S_MMA(fa, 2); __builtin_amdgcn_sched_barrier(0);
              S_MMA(fb, 3); }
#undef S_READ
#undef S_MMA
            if (j < 2) ATT_LANDED(63); else ATT_LANDED(8);
        }
        float mx = p[0][0];
#pragma unroll
        for (int i = 0; i < 16; ++i)
#pragma unroll
            for (int r = 0; r < 4; ++r) mx = fmaxf(mx, p[i][r]);
        mx = fmaxf(mx, __shfl_xor(mx, 16)); mx = fmaxf(mx, __shfl_xor(mx, 32));
        float lsum = 0.f;
#pragma unroll
        for (int i = 0; i < 16; ++i)
#pragma unroll
            for (int r = 0; r < 4; ++r) { p[i][r] = __builtin_amdgcn_exp2f(p[i][r] - mx); lsum += p[i][r]; }
        lsum += __shfl_xor(lsum, 16); lsum += __shfl_xor(lsum, 32);
        const float inv = 1.0f / lsum;
        v4u pb[8];
#pragma unroll
        for (int s = 0; s < 8; ++s) pb[s] = (v4u){pk2(p[2 * s][0], p[2 * s][1]), pk2(p[2 * s][2], p[2 * s][3]), pk2(p[2 * s + 1][0], p[2 * s + 1][1]), pk2(p[2 * s + 1][2], p[2 * s + 1][3])};
        f32x4a ot[16];
#pragma unroll
        for (int i = 0; i < 16; ++i) ot[i] = (f32x4a){0.f, 0.f, 0.f, 0.f};
#pragma unroll
        for (int j = 4; j < 8; ++j) {
            if (j == 4) ATT_LOAD(7, kbase, vbase);
            else if (has_next) { if (j == 5) ATT_LOAD(0, kbn, vbn); else if (j == 6) ATT_LOAD(1, kbn, vbn); else ATT_LOAD(2, kbn, vbn); }
            const LAS unsigned char* buf = lds + (j & 3) * 32768;
#define PV_READ(dst, g) do { _Pragma("unroll") for (int d4 = 0; d4 < 4; ++d4) { const int row = 16 * (4 * (g) + d4) + l15; \
                _Pragma("unroll") for (int s = 0; s < 2; ++s) dst[2 * d4 + s] = *(const LAS bf16x8*)(buf + row * 128 + (((4 * s + kq) ^ ((row >> 1) & 7)) * 16)); } } while (0)
#define PV_MMA(src, g) do { _Pragma("unroll") for (int s = 0; s < 2; ++s) _Pragma("unroll") for (int d4 = 0; d4 < 4; ++d4) \
                ot[4 * (g) + d4] = __builtin_amdgcn_mfma_f32_16x16x32_bf16(src[2 * d4 + s], as_bf16x8(pb[2 * (j - 4) + s]), ot[4 * (g) + d4], 0, 0, 0); } while (0)
            { bf16x8 fa[8], fb[8];
              PV_READ(fa, 0); __builtin_amdgcn_sched_barrier(0);
              PV_READ(fb, 1); __builtin_amdgcn_sched_barrier(0); PV_MMA(fa, 0); __builtin_amdgcn_sched_barrier(0);
              PV_READ(fa, 2); __builtin_amdgcn_sched_barrier(0); PV_MMA(fb, 1); __builtin_amdgcn_sched_barrier(0);
              PV_READ(fb, 3); __builtin_amdgcn_sched_barrier(0); PV_MMA(fa, 2); __builtin_amdgcn_sched_barrier(0);
              PV_MMA(fb, 3); }
#undef PV_READ
#undef PV_MMA
            if (j == 4) { if (has_next) { const bf16* qp = Q + (size_t)tokn * 1024 + hdn * 256 + (l15 * 1024 + 8 * kq);
#pragma unroll
                    for (int ks = 0; ks < 8; ++ks) qf[ks] = *(const bf16x8*)(qp + 32 * ks); }
                ATT_LANDED2(16, 8); }
            else if (j == 5) ATT_LANDED2(16, 4);
            else if (j == 6) ATT_LANDED2(16, 0);
            else ATT_LANDED(0);
        }
        ATT_TOUCH_Q();
        bf16* op = O + (size_t)tok * 1024 + hd * 256 + (l15 * 1024 + 4 * kq);
#pragma unroll
        for (int db = 0; db < 16; ++db) { v2u o2 = {pk2(ot[db][0] * inv, ot[db][1] * inv), pk2(ot[db][2] * inv, ot[db][3] * inv)}; *(v2u*)(op + 16 * db) = o2; }
    }
#undef ATT_LOAD
#undef ATT_LANDED
#undef ATT_LANDED2
#undef ATT_TOUCH_Q
#undef ATT_UNIT
}

__device__ __forceinline__ unsigned ord_f32(float f) { const unsigned u = __float_as_uint(f); return u ^ ((unsigned)((int)u >> 31) | 0x80000000u); }
__device__ __forceinline__ float unord_f32(unsigned o) { return __uint_as_float(o ^ (~(unsigned)((int)o >> 31) | 0x80000000u)); }
__device__ __forceinline__ void ce_desc(unsigned& a, unsigned& b) { const unsigned hi = a > b ? a : b, lo = a > b ? b : a; a = hi; b = lo; }
__device__ __forceinline__ void sort16_desc(unsigned (&a)[16]) {
    ce_desc(a[0], a[1]); ce_desc(a[2], a[3]); ce_desc(a[0], a[2]); ce_desc(a[1], a[3]); ce_desc(a[1], a[2]); ce_desc(a[4], a[5]); ce_desc(a[6], a[7]); ce_desc(a[4], a[6]); ce_desc(a[5], a[7]); ce_desc(a[5], a[6]);
    ce_desc(a[0], a[4]); ce_desc(a[2], a[6]); ce_desc(a[2], a[4]); ce_desc(a[1], a[5]); ce_desc(a[3], a[7]); ce_desc(a[3], a[5]); ce_desc(a[1], a[2]); ce_desc(a[3], a[4]); ce_desc(a[5], a[6]); ce_desc(a[8], a[9]);
    ce_desc(a[10], a[11]); ce_desc(a[8], a[10]); ce_desc(a[9], a[11]); ce_desc(a[9], a[10]); ce_desc(a[12], a[13]); ce_desc(a[14], a[15]); ce_desc(a[12], a[14]); ce_desc(a[13], a[15]); ce_desc(a[13], a[14]);
    ce_desc(a[8], a[12]); ce_desc(a[10], a[14]); ce_desc(a[10], a[12]); ce_desc(a[9], a[13]); ce_desc(a[11], a[15]); ce_desc(a[11], a[13]); ce_desc(a[9], a[10]); ce_desc(a[11], a[12]); ce_desc(a[13], a[14]);
    ce_desc(a[0], a[8]); ce_desc(a[4], a[12]); ce_desc(a[4], a[8]); ce_desc(a[2], a[10]); ce_desc(a[6], a[14]); ce_desc(a[6], a[10]); ce_desc(a[2], a[4]); ce_desc(a[6], a[8]); ce_desc(a[10], a[12]); ce_desc(a[1], a[9]);
    ce_desc(a[5], a[13]); ce_desc(a[5], a[9]); ce_desc(a[3], a[11]); ce_desc(a[7], a[15]); ce_desc(a[7], a[11]); ce_desc(a[3], a[5]); ce_desc(a[7], a[9]); ce_desc(a[11], a[13]); ce_desc(a[1], a[2]); ce_desc(a[3], a[4]);
    ce_desc(a[5], a[6]); ce_desc(a[7], a[8]); ce_desc(a[9], a[10]); ce_desc(a[11], a[12]); ce_desc(a[13], a[14]);
}
__device__ __forceinline__ void merge_prune16(unsigned (&top)[16], const unsigned (&nw)[16]) {
#pragma unroll
    for (int i = 0; i < 16; ++i) top[i] = top[i] > nw[15 - i] ? top[i] : nw[15 - i];
#pragma unroll
    for (int j = 8; j > 0; j >>= 1)
#pragma unroll
        for (int i = 0; i < 16; ++i) { const int l = i ^ j; if (l > i) ce_desc(top[i], top[l]); }
}
__device__ __forceinline__ void topk_load(const unsigned short* scT, int hp, int token, v2u (&raw)[32]) {
#pragma unroll
    for (int kq = 0; kq < 32; ++kq) raw[kq] = *(const v2u*)(scT + ((size_t)(hp * 32 + kq) * M + token) * 4);
}
typedef short s16x2v __attribute__((ext_vector_type(2)));
__device__ __forceinline__ unsigned ord_f16x2(unsigned w) { const s16x2v m = __builtin_bit_cast(s16x2v, w) >> 15; return w ^ (__builtin_bit_cast(unsigned, m) | 0x80008000u); }
__device__ __forceinline__ float unord_f16_hi(unsigned key) { const unsigned o = key >> 16; const unsigned h = o ^ ((o & 0x8000u) ? 0x8000u : 0xffffu); return (float)__builtin_bit_cast(_Float16, (unsigned short)h); }
__device__ __forceinline__ void topk_half(const v2u (&raw)[32], unsigned (&top)[16]) {
#pragma unroll
    for (int c = 0; c < 8; ++c) { unsigned nw[16];
#pragma unroll
        for (int q = 0; q < 4; ++q) { const unsigned x0 = ord_f16x2(raw[4 * c + q].x), x1 = ord_f16x2(raw[4 * c + q].y); const int b0 = 127 - (16 * c + 4 * q);
            nw[4 * q + 0] = (x0 << 16) | (unsigned)b0;         nw[4 * q + 1] = (x0 & 0xffff0000u) | (unsigned)(b0 - 1);
            nw[4 * q + 2] = (x1 << 16) | (unsigned)(b0 - 2);   nw[4 * q + 3] = (x1 & 0xffff0000u) | (unsigned)(b0 - 3); }
        sort16_desc(nw);
        if (c == 0) {
#pragma unroll
            for (int i = 0; i < 16; ++i) top[i] = nw[i]; }
        else merge_prune16(top, nw); }
}
__device__ __forceinline__ void peer_topk_task(const unsigned short* scT, int head, int token, unsigned short* idx_out, float* gate_out, LAS unsigned char* slot) {
    unsigned ta[16], tb[16];
    { v2u ra[32], rb[32]; topk_load(scT, 2 * head, token, ra); topk_load(scT, 2 * head + 1, token, rb); topk_half(ra, ta); topk_half(rb, tb); }
    float av[16], bv[16];
#pragma unroll
    for (int i = 0; i < 16; ++i) { av[i] = unord_f16_hi(ta[i]); bv[i] = unord_f16_hi(tb[i]); }
#pragma unroll
    for (int q = 0; q < 4; ++q) {
        unsigned wa = 0, wb = 0;
#pragma unroll
        for (int e = 0; e < 4; ++e) { wa |= (127u - (ta[4 * q + e] & 127u)) << (8 * e); wb |= (127u - (tb[4 * q + e] & 127u)) << (8 * e); }
        *(LAS unsigned*)(slot + 4 * q) = wa; *(LAS unsigned*)(slot + 16 + 4 * q) = wb; }
    unsigned cd[4][16];
#pragma unroll
    for (int q = 0; q < 4; ++q)
#pragma unroll
        for (int e = 0; e < 16; ++e) cd[q][e] = 0u;
    {
        constexpr int cnt[16] = {16, 8, 5, 4, 3, 2, 2, 2, 1, 1, 1, 1, 1, 1, 1, 1};
        constexpr int stt[16] = {0, 16, 24, 29, 33, 36, 38, 40, 42, 43, 44, 45, 46, 47, 48, 49};
#pragma unroll
        for (int i = 0; i < 16; ++i)
#pragma unroll
            for (int j = 0; j < 16; ++j) if (j < cnt[i]) { const int t = stt[i] + j; const int ch = t < 16 ? 0 : t < 24 ? 1 : t < 40 ? 2 : 3, ps = t < 16 ? t : t < 24 ? t - 16 : t < 40 ? t - 24 : t - 40;
                cd[ch][ps] = (ord_f32(av[i] + bv[j]) & ~63u) | (unsigned)(63 - t); }
    }
    sort16_desc(cd[2]); sort16_desc(cd[3]);
    merge_prune16(cd[0], cd[1]); merge_prune16(cd[2], cd[3]); merge_prune16(cd[0], cd[2]);
    LDS_WAIT();
    float gv[16]; float gs = 0.f; const float vmax = unord_f32(cd[0][0] & ~63u);
    unsigned ex[16];
#pragma unroll
    for (int r = 0; r < 16; ++r) {
        const int t = 63 - (int)(cd[0][r] & 63u);
        int i = (t >= 16) + (t >= 24) + (t >= 29) + (t >= 33) + (t >= 36) + (t >= 38) + (t >= 40);
        int st = t >= 40 ? 40 : t >= 38 ? 38 : t >= 36 ? 36 : t >= 33 ? 33 : t >= 29 ? 29 : t >= 24 ? 24 : t >= 16 ? 16 : 0;
        int j = t - st;
        if (t >= 42) { i = 8 + (t - 42); j = 0; }
        const unsigned ia = *(LAS unsigned char*)(slot + i), ib = *(LAS unsigned char*)(slot + 16 + j);
        ex[r] = ia * 128u + ib;
        gv[r] = __expf(unord_f32(cd[0][r] & ~63u) - vmax); gs += gv[r]; }
    const float ginv = 1.0f / gs;
    unsigned short* gp = (unsigned short*)gate_out + (size_t)token * 128 + head * 16;
#pragma unroll
    for (int jj = 0; jj < 8; ++jj) *(unsigned*)(idx_out + (size_t)token * 128 + jj * 16 + 2 * head) = ex[jj] | (ex[jj + 8] << 16);
#pragma unroll
    for (int q = 0; q < 2; ++q) { v4u w_;
#pragma unroll
        for (int e = 0; e < 4; ++e) { const pg8::f16x2 h_ = {(_Float16)(gv[8 * q + 2 * e] * ginv), (_Float16)(gv[8 * q + 2 * e + 1] * ginv)}; w_[e] = __builtin_bit_cast(unsigned, h_); }
        *(v4u*)(gp + 8 * q) = w_; }
}

__device__ __forceinline__ float quant_row_sliced(const float* src, const float* gain, unsigned char* dst, int rows, int r, int offset, int lane) {
    f32x4 v[4]; float am = 0.f;
#pragma unroll
    for (int jq = 0; jq < 4; ++jq) { v[jq] = ((const f32x4*)src)[64 * jq + lane]; if (gain) v[jq] = v[jq] * ((const f32x4*)gain)[64 * jq + lane];
        am = fmaxf(am, fmaxf(fmaxf(fabsf(v[jq].x), fabsf(v[jq].y)), fmaxf(fabsf(v[jq].z), fabsf(v[jq].w)))); }
    am = wave_max(am);
    const float inv = am > 0.f ? 127.0f / am : 0.f;
#pragma unroll
    for (int jq = 0; jq < 4; ++jq) { const int sl = 2 * jq + (lane >> 5);
        const int q0 = (int)rintf(v[jq].x * inv) + offset, q1 = (int)rintf(v[jq].y * inv) + offset, q2 = (int)rintf(v[jq].z * inv) + offset, q3 = (int)rintf(v[jq].w * inv) + offset;
        *(unsigned*)(dst + ((size_t)sl * rows + r) * 128 + 4 * (lane & 31)) = (unsigned)(q0 & 255) | ((unsigned)(q1 & 255) << 8) | ((unsigned)(q2 & 255) << 16) | ((unsigned)(q3 & 255) << 24); }
    return am * (1.0f / 127.0f);
}
template <bool EO = false>
__device__ __forceinline__ void quant_store_row(const f32x4 (&v)[4], float inv, unsigned char* dst, int rows, int r, int lane) {
#pragma unroll
    for (int jq = 0; jq < 4; ++jq) { const int sl = 2 * jq + (lane >> 5);
        const int q0 = (int)rintf(v[jq].x * inv), q1 = (int)rintf(v[jq].y * inv), q2 = (int)rintf(v[jq].z * inv), q3 = (int)rintf(v[jq].w * inv);
        unsigned char* d_ = dst + ((size_t)sl * rows + r) * 128;
        if (EO) { *(unsigned short*)(d_ + 2 * (lane & 31)) = (unsigned short)((q0 & 255) | ((q2 & 255) << 8)); *(unsigned short*)(d_ + 64 + 2 * (lane & 31)) = (unsigned short)((q1 & 255) | ((q3 & 255) << 8)); }
        else *(unsigned*)(d_ + 4 * (lane & 31)) = (unsigned)(q0 & 255) | ((unsigned)(q1 & 255) << 8) | ((unsigned)(q2 & 255) << 16) | ((unsigned)(q3 & 255) << 24); }
}
__device__ __forceinline__ float row_amax(const f32x4 (&v)[4]) { float am = 0.f;
#pragma unroll
    for (int jq = 0; jq < 4; ++jq) am = fmaxf(am, fmaxf(fmaxf(fabsf(v[jq].x), fabsf(v[jq].y)), fmaxf(fabsf(v[jq].z), fabsf(v[jq].w))));
    return wave_max(am); }
__device__ __forceinline__ void quant_rows4(const float* down, const float* up, const float* gain, unsigned char* dstd, unsigned char* dstu, int e0, int e1, int lane, float* dscale, float* uscale) {
    f32x4 vd0[4], vu0[4], vd1[4], vu1[4];
#pragma unroll
    for (int jq = 0; jq < 4; ++jq) { vd0[jq] = ((const f32x4*)(down + (size_t)e0 * 1024))[64 * jq + lane]; vu0[jq] = ((const f32x4*)(up + (size_t)e0 * 1024))[64 * jq + lane];
        vd1[jq] = ((const f32x4*)(down + (size_t)e1 * 1024))[64 * jq + lane]; vu1[jq] = ((const f32x4*)(up + (size_t)e1 * 1024))[64 * jq + lane]; }
#pragma unroll
    for (int jq = 0; jq < 4; ++jq) { const f32x4 g = ((const f32x4*)gain)[64 * jq + lane]; vd0[jq] = vd0[jq] * g; vd1[jq] = vd1[jq] * g; }
    const float ad0 = row_amax(vd0), au0 = row_amax(vu0), ad1 = row_amax(vd1), au1 = row_amax(vu1);
    quant_store_row(vd0, ad0 > 0.f ? 127.0f / ad0 : 0.f, dstd, NEXP, e0, lane); quant_store_row<true>(vu0, au0 > 0.f ? 127.0f / au0 : 0.f, dstu, NEXP, e0, lane);
    if (lane == 0) *(f32x2*)(dscale + 2 * (size_t)e0) = (f32x2){ad0 * (1.0f / 127.0f), au0 * (1.0f / 127.0f)};
    if (e1 != e0) { quant_store_row(vd1, ad1 > 0.f ? 127.0f / ad1 : 0.f, dstd, NEXP, e1, lane); quant_store_row<true>(vu1, au1 > 0.f ? 127.0f / au1 : 0.f, dstu, NEXP, e1, lane);
        if (lane == 0) *(f32x2*)(dscale + 2 * (size_t)e1) = (f32x2){ad1 * (1.0f / 127.0f), au1 * (1.0f / 127.0f)}; }
}
__device__ __forceinline__ void quant_x2_rows4(const bf16* x2S, unsigned char* dst, float* xscale, int m, int stride, int lane) {
    f32x4 v[4][4]; int mr[4];
#pragma unroll
    for (int r = 0; r < 4; ++r) { mr[r] = m + r * stride < M ? m + r * stride : m;
#pragma unroll
        for (int jq = 0; jq < 4; ++jq) { const v2u w = *(const v2u*)(x2S + ((size_t)(4 * jq + (lane >> 4)) * M + mr[r]) * 64 + 4 * (lane & 15)); v[r][jq] = (f32x4){bflo(w.x), bfhi(w.x), bflo(w.y), bfhi(w.y)}; } }
#pragma unroll
    for (int r = 0; r < 4; ++r) { const float am = row_amax(v[r]);
        if (r == 0 || mr[r] != m) { quant_store_row(v[r], am > 0.f ? 127.0f / am : 0.f, dst, M, mr[r], lane); if (lane == 0) xscale[mr[r]] = am * (1.0f / 127.0f); } }
}
__device__ __forceinline__ float swap_add32(float a, float b) { const auto r = __builtin_amdgcn_permlane32_swap(__float_as_uint(a), __float_as_uint(b), false, false); return __uint_as_float(r[0]) + __uint_as_float(r[1]); }
__device__ __forceinline__ float swap_add16(float a, float b) { const auto r = __builtin_amdgcn_permlane16_swap(__float_as_uint(a), __float_as_uint(b), false, false); return __uint_as_float(r[0]) + __uint_as_float(r[1]); }
template <int CTRL> __device__ __forceinline__ float dpp_f(float v) { return __uint_as_float((unsigned)__builtin_amdgcn_update_dpp(0, (int)__float_as_uint(v), CTRL, 0xF, 0xF, false)); }
__device__ __forceinline__ float dpp_xor4(float v) {
    int r = __builtin_amdgcn_update_dpp(0, (int)__float_as_uint(v), 0x12C, 0xF, 0x5, false);
    r = __builtin_amdgcn_update_dpp(r, (int)__float_as_uint(v), 0x124, 0xF, 0xA, false);
    return __uint_as_float((unsigned)r);
}
__device__ __forceinline__ int bfly8_low_i(const int (&p)[8], int lane) {
    int q4[4], q2[2];
    { const bool u = (lane & 4) != 0;
#pragma unroll
      for (int i = 0; i < 4; ++i) { int r = __builtin_amdgcn_update_dpp(0, p[i], 0x12C, 0xF, 0x5, false);
          r = __builtin_amdgcn_update_dpp(r, p[4 + i], 0x124, 0xF, 0xA, false);
          q4[i] = (u ? p[4 + i] : p[i]) + r; } }
    { const bool u = (lane & 2) != 0;
#pragma unroll
      for (int i = 0; i < 2; ++i) { const int keep = u ? q4[2 + i] : q4[i], send = u ? q4[i] : q4[2 + i]; q2[i] = keep + __builtin_amdgcn_update_dpp(0, send, 0x4E, 0xF, 0xF, false); } }
    { const bool u = (lane & 1) != 0; const int keep = u ? q2[1] : q2[0], send = u ? q2[0] : q2[1]; return keep + __builtin_amdgcn_update_dpp(0, send, 0xB1, 0xF, 0xF, false); }
}
__device__ __forceinline__ float bfly8_low(const float (&p)[8], int lane) {
    float q4[4], q2[2];
    { const bool u = (lane & 4) != 0;
#pragma unroll
      for (int i = 0; i < 4; ++i) { const float keep = u ? p[4 + i] : p[i], send = u ? p[i] : p[4 + i]; q4[i] = keep + dpp_xor4(send); } }
    { const bool u = (lane & 2) != 0;
#pragma unroll
      for (int i = 0; i < 2; ++i) { const float keep = u ? q4[2 + i] : q4[i], send = u ? q4[i] : q4[2 + i]; q2[i] = keep + dpp_f<0x4E>(send); } }
    { const bool u = (lane & 1) != 0; const float keep = u ? q2[1] : q2[0], send = u ? q2[0] : q2[1]; return keep + dpp_f<0xB1>(send); }
}
__device__ __forceinline__ f32x2 bfly16_high(const float (&p)[16], int lane) {
    float q8[8], q4[4];
#pragma unroll
    for (int i = 0; i < 8; ++i) q8[i] = swap_add32(p[i], p[8 + i]);
#pragma unroll
    for (int i = 0; i < 4; ++i) q4[i] = swap_add16(q8[i], q8[4 + i]);
    { const bool u = (lane & 8) != 0; f32x2 r;
      { const float keep = u ? q4[2] : q4[0], send = u ? q4[0] : q4[2]; r.x = keep + dpp_f<0x128>(send); }
      { const float keep = u ? q4[3] : q4[1], send = u ? q4[1] : q4[3]; r.y = keep + dpp_f<0x128>(send); }
      return r; }
}
#define PEER_ISSUE(dst, iwa, iwb, base) do { _Pragma("unroll") for (int i = 0; i < 16; ++i) { const unsigned wvv_ = i < 8 ? (iwa)[i >> 1] : (iwb)[(i - 8) >> 1]; \
        unsigned o_ = (((i & 1) ? (wvv_ >> 16) : (wvv_ & 0xffffu)) << 7) | suboff; asm volatile("" : "+v"(o_)); dst[i] = *(const v4u*)((base) + (size_t)o_); } } while (0)
#define PEER_FENCE() asm volatile("" ::: "memory")
#define PEER_TOUCH(x) asm volatile("" :: "v"(x))
#define PEER_LOADIDX(da, db, k) do { const v4u* ip_ = (const v4u*)(idxp + (size_t)TOKC(k) * 128 + 16 * j); da = ip_[0]; db = ip_[1]; } while (0)
#define TOKC(k) (wv + ((k) < ntok ? (k) : ntok - 1) * nwv)
__device__ __forceinline__ void peer_down_phase(const unsigned char* xq, const unsigned char* downQ, const unsigned short* idxp, unsigned* part, int sl, int wv, int nwv, int lane) {
    const int j = lane >> 3, sub = lane & 7;
    const int ntok = wv < M ? (M - wv + nwv - 1) / nwv : 0;
    const unsigned char* xs = xq + (size_t)sl * M * 128 + 16 * sub; const unsigned char* ds = downQ + (size_t)sl * NEXP * 128; const unsigned suboff = 16u * (unsigned)sub;
    unsigned* ps = part + (size_t)sl * M * 64 + ((j & 1) ? 32 + 4 * sub + (j >> 1) : 4 * sub + (j >> 1));
    if (ntok == 0) return;
#define D_COMPUTE(dsrc, xvv, k) do { int p0[8], p1[8]; _Pragma("unroll") for (int i = 0; i < 8; ++i) { int s = 0, u = 0; \
        _Pragma("unroll") for (int q = 0; q < 4; ++q) { s = __builtin_amdgcn_sdot4((int)dsrc[i][q], (int)xvv[q], s, false); u = __builtin_amdgcn_sdot4((int)dsrc[8 + i][q], (int)xvv[q], u, false); } p0[i] = s; p1[i] = u; } \
        const float r0 = (float)bfly8_low_i(p0, lane) * 0.015625f, r1 = (float)bfly8_low_i(p1, lane) * 0.015625f;     \
        const float rc_ = dpp_f<0x128>((j & 1) ? r0 : r1);              \
        const pg8::f16x2 hv_ = (j & 1) ? (pg8::f16x2){(_Float16)rc_, (_Float16)r1} : (pg8::f16x2){(_Float16)r0, (_Float16)rc_}; \
        ps[(size_t)(wv + (k) * nwv) * 64] = __builtin_bit_cast(unsigned, hv_); } while (0)
    v4u dA[16], dB[16];
    v4u ia0, ib0, ia1, ib1; PEER_LOADIDX(ia0, ib0, 0); PEER_LOADIDX(ia1, ib1, 1);
    v4u xv0 = *(const v4u*)(xs + (size_t)TOKC(0) * 128), xv1 = *(const v4u*)(xs + (size_t)TOKC(1) * 128);
    PEER_ISSUE(dA, ia0, ib0, ds);
    PEER_TOUCH(xv0); PEER_TOUCH(xv1); PEER_TOUCH(ia1); PEER_TOUCH(ib1);
#pragma unroll 1
    for (int k = 0; k < ntok; k += 2) {
        v4u ia2, ib2; PEER_LOADIDX(ia2, ib2, k + 2); const v4u xv2 = *(const v4u*)(xs + (size_t)TOKC(k + 2) * 128); PEER_FENCE();
        PEER_ISSUE(dB, ia1, ib1, ds); PEER_FENCE();
        D_COMPUTE(dA, xv0, k);
        v4u ia3, ib3; PEER_LOADIDX(ia3, ib3, k + 3); const v4u xv3 = *(const v4u*)(xs + (size_t)TOKC(k + 3) * 128); PEER_FENCE();
        PEER_ISSUE(dA, ia2, ib2, ds); PEER_FENCE();
        if (k + 1 < ntok) D_COMPUTE(dB, xv1, k + 1);
        PEER_TOUCH(ia3); PEER_TOUCH(ib3); PEER_TOUCH(xv3);
        ia0 = ia2; ib0 = ib2; xv0 = xv2; ia1 = ia3; ib1 = ib3; xv1 = xv3;
    }
#undef D_COMPUTE
}
struct CombIn { float pp[4], xs[4]; unsigned ex[4]; unsigned gth[4]; unsigned pr[4][8]; };
__device__ __forceinline__ void peer_combine_load(CombIn& c, const unsigned* part, const float* part2, const unsigned short* idxp, const float* xscale, const float* gate, int t0, int stride, int lane) {
#pragma unroll
    for (int r = 0; r < 4; ++r) { const int tk = t0 + r * stride < M ? t0 + r * stride : t0; c.pp[r] = lane < 16 ? part2[(size_t)tk * 16 + lane] : 0.f; c.xs[r] = xscale[tk];
        const size_t o = (size_t)tk * 64 + lane; { const unsigned short* ipp = idxp + (size_t)tk * 128 + 32 * (lane & 3) + (lane >> 2); c.ex[r] = (unsigned)ipp[0] | ((unsigned)ipp[16] << 16); }
        c.gth[r] = *((const unsigned*)gate + o);
#pragma unroll
        for (int sl = 0; sl < 8; ++sl) c.pr[r][sl] = part[(size_t)sl * M * 64 + o]; }
}
__device__ __forceinline__ void peer_combine_gather(const CombIn& c, const float* dscale, const float* uscale, f32x2 (&ds)[4], f32x2 (&us)[4]) {
#pragma unroll
    for (int r = 0; r < 4; ++r) { const f32x2 a = *(const f32x2*)(dscale + 2 * (size_t)(c.ex[r] & 0xffffu)), b = *(const f32x2*)(dscale + 2 * (size_t)(c.ex[r] >> 16));
        ds[r] = (f32x2){a.x, b.x}; us[r] = (f32x2){a.y, b.y}; }
}
__device__ __forceinline__ void peer_combine_finish(const CombIn& c, const f32x2 (&ds)[4], const f32x2 (&us)[4], unsigned* wpk, float* wscale, int t0, int stride, int lane) {
#pragma unroll
    for (int r = 0; r < 4; ++r) { const int tk = t0 + r * stride; if (tk >= M) break;
        f32x2 a = {0.f, 0.f};
#pragma unroll
        for (int sl = 0; sl < 8; ++sl) { const pg8::f16x2 h = __builtin_bit_cast(pg8::f16x2, c.pr[r][sl]); a.x += (float)h[0]; a.y += (float)h[1]; }
        const float rx = rsqrtf(wave_sum(c.pp[r]) * (1.0f / 1024.0f) + EPS) * c.xs[r] * 64.0f;
        const float z0 = a.x * rx * ds[r].x, z1 = a.y * rx * ds[r].y;
        const float w0 = 0.5f * z0 * (1.0f + erff(z0 * 0.70710678118654752f)) * (float)__builtin_bit_cast(pg8::f16x2, c.gth[r])[0] * us[r].x, w1 = 0.5f * z1 * (1.0f + erff(z1 * 0.70710678118654752f)) * (float)__builtin_bit_cast(pg8::f16x2, c.gth[r])[1] * us[r].y;
        const float am = wave_max(fmaxf(fabsf(w0), fabsf(w1)));
        const float inv = am > 0.f ? 127.0f / am : 0.f;
        const int qq = ((int)rintf(w0 * inv) & 255) | (((int)rintf(w1 * inv) & 255) << 8);
        ((unsigned short*)wpk)[(size_t)tk * 64 + lane] = (unsigned short)qq;
        if (lane == 0) wscale[tk] = am * (1.0f / 127.0f); }
}
__device__ __forceinline__ void peer_combine_phase(const unsigned* part, const float* part2, const unsigned short* idxp, const float* dscale, const float* uscale, const float* xscale, const float* gate, unsigned* wpk, float* wscale, int gw, int NGW, int lane) {
    if (gw >= M) return;
    CombIn ca, cb;
    peer_combine_load(ca, part, part2, idxp, xscale, gate, gw, NGW, lane);
#pragma unroll 1
    for (int t = gw; t < M; t += 8 * NGW) {
        const bool more = t + 4 * NGW < M;
        f32x2 ds[4], us[4];
        peer_combine_gather(ca, dscale, uscale, ds, us); asm volatile("" ::: "memory");
        if (more) peer_combine_load(cb, part, part2, idxp, xscale, gate, t + 4 * NGW, NGW, lane);
        peer_combine_finish(ca, ds, us, wpk, wscale, t, NGW, lane);
        if (more) { peer_combine_gather(cb, dscale, uscale, ds, us); asm volatile("" ::: "memory");
            if (t + 8 * NGW < M) peer_combine_load(ca, part, part2, idxp, xscale, gate, t + 8 * NGW, NGW, lane);
            peer_combine_finish(cb, ds, us, wpk, wscale, t + 4 * NGW, NGW, lane); }
    }
}
typedef int v2i_t __attribute__((ext_vector_type(2)));
#define U_COMPUTE(dsrc, wreg, k) do { const size_t tk_ = (size_t)(wv + (k) * nwv); const unsigned xx_ = *(const unsigned*)(xi0 + tk_ * 64); const float ws_ = wscale[tk_]; int acc0 = 0, acc1 = 0; \
        _Pragma("unroll") for (int h = 0; h < 2; ++h) { LAS unsigned char* buf_ = ubuf + h * 8192; \
            _Pragma("unroll") for (int i = 0; i < 8; ++i) *(LAS v4u*)(buf_ + i * 1024 + wr_off) = dsrc[8 * h + i]; \
            _Pragma("unroll") for (int i = 0; i < 8; ++i) { const int wlo_ = __builtin_amdgcn_readlane((int)(wreg), 2 * (8 * h + i)), whi_ = __builtin_amdgcn_readlane((int)(wreg), 2 * (8 * h + i) + 1); \
                const v2i_t t0_ = __builtin_amdgcn_ds_read_tr8_b64_v2i32((LAS v2i_t*)(buf_ + i * 1024 + rd_off0)), t1_ = __builtin_amdgcn_ds_read_tr8_b64_v2i32((LAS v2i_t*)(buf_ + i * 1024 + rd_off1)); \
                acc0 = __builtin_amdgcn_sdot4(t0_.x, wlo_, acc0, false); acc0 = __builtin_amdgcn_sdot4(t0_.y, whi_, acc0, false); \
                acc1 = __builtin_amdgcn_sdot4(t1_.x, wlo_, acc1, false); acc1 = __builtin_amdgcn_sdot4(t1_.y, whi_, acc1, false); } } \
        *(unsigned*)(xo0 + tk_ * 64) = pk2(__uint_as_float(xx_ << 16) + (float)acc0 * ws_, __uint_as_float(xx_ & 0xffff0000u) + (float)acc1 * ws_); } while (0)
#define U_LOADW(dst, k) do { dst = wpk[(size_t)TOKC(k) * 32 + (lane & 31)]; } while (0)
__device__ __forceinline__ void peer_up_phase(bf16* x2S, bf16* x3S, const unsigned char* upQ, const unsigned short* idxp, const unsigned* wpk, const float* wscale, int sl, int wv, int nwv, int lane, LAS unsigned char* ubuf, LAS unsigned char* sbuf) {
    const int j = lane >> 3, sub = lane & 7;
    const int ntok = wv < M ? (M - wv + nwv - 1) / nwv : 0;
    const unsigned char* us = upQ + (size_t)sl * NEXP * 128; const unsigned suboff = 16u * (unsigned)(sub ^ (j >> 1));
    const bf16* xi0 = x2S + (size_t)(2 * sl + (lane >> 5)) * M * 64 + 2 * (lane & 31);
    bf16* xo0 = x3S + (size_t)(2 * sl + (lane >> 5)) * M * 64 + 2 * (lane & 31);
    const int g_ = lane >> 4, p_ = lane & 15, r_ = p_ >> 1;
    const int rd_off0 = r_ * 128 + (((g_) ^ (r_ >> 1)) * 16) + 8 * (p_ & 1);
    const int rd_off1 = r_ * 128 + (((4 + g_) ^ (r_ >> 1)) * 16) + 8 * (p_ & 1);
    if (ntok == 0) return;
#define U_SMALL(k) do { LAS unsigned char* sb_ = sbuf + (((k) & 1) ? 768 : 0); const size_t tk2_ = (size_t)TOKC(k); \
        __builtin_amdgcn_global_load_lds((const unsigned*)(idxp + tk2_ * 128) + lane, (LAS unsigned*)(sb_), 4, 0, 0); \
        __builtin_amdgcn_global_load_lds(lane < 32 ? wpk + tk2_ * 32 + lane : (const unsigned*)(wscale + tk2_), (LAS unsigned*)(sb_ + 256), 4, 0, 0); \
        __builtin_amdgcn_global_load_lds((const unsigned*)(xi0 + tk2_ * 64), (LAS unsigned*)(sb_ + 512), 4, 0, 0); } while (0)
#define U_IDX(ia_, ib_, k) do { const LAS v4u* ip_ = (const LAS v4u*)(sbuf + (((k) & 1) ? 768 : 0) + 32 * j); ia_ = ip_[0]; ib_ = ip_[1]; } while (0)
#define U_DMA(ia_, ib_, h) do { _Pragma("unroll") for (int i = 0; i < 8; ++i) { const int ii = 8 * (h) + i; const unsigned wvv_ = ii < 8 ? (ia_)[ii >> 1] : (ib_)[(ii - 8) >> 1]; \
        unsigned o_ = (((ii & 1) ? (wvv_ >> 16) : (wvv_ & 0xffffu)) << 7) | suboff; asm volatile("" : "+v"(o_)); \
        __builtin_amdgcn_global_load_lds((const unsigned*)(us + (size_t)o_), (LAS unsigned*)(ubuf + (h) * 8192 + i * 1024), 16, 0, 0); } } while (0)
#define U_HALF(h, wreg) do { LAS unsigned char* buf_ = ubuf + (h) * 8192; \
        _Pragma("unroll") for (int q = 0; q < 4; ++q) { const v4u w4_ = *(const LAS v4u*)(sc_ + 256 + 64 * (h) + 16 * q); \
          _Pragma("unroll") for (int i2 = 0; i2 < 2; ++i2) { const int i = 2 * q + i2; const int wlo_ = (int)(i2 ? w4_.z : w4_.x), whi_ = (int)(i2 ? w4_.w : w4_.y); \
            const v2i_t t0_ = __builtin_amdgcn_ds_read_tr8_b64_v2i32((LAS v2i_t*)(buf_ + i * 1024 + rd_off0)), t1_ = __builtin_amdgcn_ds_read_tr8_b64_v2i32((LAS v2i_t*)(buf_ + i * 1024 + rd_off1)); \
            acc0 = __builtin_amdgcn_sdot4(t0_.x, wlo_, acc0, false); acc0 = __builtin_amdgcn_sdot4(t0_.y, whi_, acc0, false); \
            acc1 = __builtin_amdgcn_sdot4(t1_.x, wlo_, acc1, false); acc1 = __builtin_amdgcn_sdot4(t1_.y, whi_, acc1, false); } } } while (0)
    U_SMALL(0); U_SMALL(1); PEER_FENCE();
    asm volatile("s_waitcnt vmcnt(0)" ::: "memory");
    { v4u fa, fb; U_IDX(fa, fb, 0); U_DMA(fa, fb, 0); U_DMA(fa, fb, 1); PEER_FENCE(); }
#pragma unroll 1
    for (int k = 0; k < ntok; ++k) {
        const size_t tk_ = (size_t)(wv + k * nwv);
        const LAS unsigned char* sc_ = sbuf + ((k & 1) ? 768 : 0);
        int acc0 = 0, acc1 = 0;
        asm volatile("s_waitcnt vmcnt(8)" ::: "memory");
        const unsigned wqc = 0u, xxc = *(const LAS unsigned*)(sc_ + 512 + 4 * lane); const float wsc = *(const LAS float*)(sc_ + 384); (void)wqc;
        v4u ia, ib; U_IDX(ia, ib, k + 1);
        U_HALF(0, wqc);
        asm volatile("s_waitcnt lgkmcnt(0)" ::: "memory");
        U_DMA(ia, ib, 0); PEER_FENCE();
        asm volatile("s_waitcnt vmcnt(8)" ::: "memory");
        U_HALF(1, wqc);
        *(unsigned*)(xo0 + tk_ * 64) = pk2(__uint_as_float(xxc << 16) + (float)acc0 * wsc, __uint_as_float(xxc & 0xffff0000u) + (float)acc1 * wsc);
        asm volatile("s_waitcnt lgkmcnt(0)" ::: "memory");
        U_SMALL(k + 2); PEER_FENCE();
        U_DMA(ia, ib, 1); PEER_FENCE();
    }
    asm volatile("s_waitcnt vmcnt(0)" ::: "memory");
#undef U_SMALL
#undef U_IDX
#undef U_DMA
#undef U_HALF
}
#undef U_COMPUTE
#undef U_LOADW
#undef TOKC
#undef PEER_ISSUE
#undef PEER_LOADIDX
#define FN_LOAD(dst, tb) do { _Pragma("unroll") for (int r = 0; r < 4; ++r) { const int t_ = (tb) + r * NGW < M ? (tb) + r * NGW : (tb); \
        _Pragma("unroll") for (int jq = 0; jq < 4; ++jq) dst[r][jq] = *(const v2u*)(xs_ + (size_t)jq * 4 * M * 64 + (size_t)t_ * 64); } } while (0)
__device__ __forceinline__ void final_norm_phase(const bf16* x3S, float* out, const float* fin_w, int gw, int NGW, int lane) {
    if (gw >= M) return;
    const bf16* xs_ = x3S + (size_t)(lane >> 4) * M * 64 + 4 * (lane & 15);
    f32x4 w[4];
#pragma unroll
    for (int jq = 0; jq < 4; ++jq) w[jq] = ((const f32x4*)fin_w + lane)[64 * jq];
    v2u cur[4][4], nxt[4][4];
    FN_LOAD(cur, gw);
#pragma unroll 1
    for (int t = gw; t < M; t += 4 * NGW) {
        if (t + 4 * NGW < M) FN_LOAD(nxt, t + 4 * NGW);
#pragma unroll
        for (int r = 0; r < 4; ++r) { if (t + r * NGW >= M) break;
            float sa = 0.f;
#pragma unroll
            for (int jq = 0; jq < 4; ++jq) sa += (bflo(cur[r][jq].x) * bflo(cur[r][jq].x) + bfhi(cur[r][jq].x) * bfhi(cur[r][jq].x)) + (bflo(cur[r][jq].y) * bflo(cur[r][jq].y) + bfhi(cur[r][jq].y) * bfhi(cur[r][jq].y));
            const float ra = rsqrtf(wave_sum(sa) * (1.0f / 1024.0f) + EPS);
            f32x4* oa = (f32x4*)(out + (size_t)(t + r * NGW) * 1024) + lane;
#pragma unroll
            for (int jq = 0; jq < 4; ++jq) oa[64 * jq] = (f32x4){bflo(cur[r][jq].x) * ra * w[jq].x, bfhi(cur[r][jq].x) * ra * w[jq].y, bflo(cur[r][jq].y) * ra * w[jq].z, bfhi(cur[r][jq].y) * ra * w[jq].w}; }
#pragma unroll
        for (int r = 0; r < 4; ++r)
#pragma unroll
            for (int jq = 0; jq < 4; ++jq) cur[r][jq] = nxt[r][jq];
    }
}

#define XB_TMO      128
#define XB_XCNT(j)  (256  + 64 * (j))
#define XB_XSUB(j)  (1280 + 64 * (j))
#define XB_XGEN(j)  (2304 + 64 * (j))
#define XB_TOP      3328
#define XB_TOPGEN   3392
#define XCD_BAR_WORDS 3456
#define XB_SPIN_CAP (1u << 22)
__device__ __forceinline__ unsigned xb_ld(unsigned* p)              { return __hip_atomic_load(p, __ATOMIC_RELAXED, __HIP_MEMORY_SCOPE_AGENT); }
__device__ __forceinline__ unsigned xb_add(unsigned* p, unsigned v) { return __hip_atomic_fetch_add(p, v, __ATOMIC_RELAXED, __HIP_MEMORY_SCOPE_AGENT); }
__device__ __forceinline__ unsigned xb_xcc_id() { return (unsigned)__builtin_amdgcn_s_getreg((3 << 11) | 20) & 0xFu; }
#define XB_SPIN(cond, bar) do { unsigned _sp = 0; while (cond) { __builtin_amdgcn_s_sleep(1); \
    if ((++_sp & 255u) == 0u) { if (xb_ld(&(bar)[XB_TMO])) break; if (_sp > XB_SPIN_CAP) { atomicAdd(&(bar)[XB_TMO], 1u); break; } } } } while (0)
__device__ __forceinline__ unsigned xcd_barrier_post(unsigned* bar, volatile LAS unsigned* st) {
    const unsigned x = xb_xcc_id();
    if (threadIdx.x == 0) { st[2] = xb_add(&bar[XB_XCNT(x)], 1u); st[3] = x; }
    return x;
}
__device__ __forceinline__ void xcd_barrier_complete(unsigned* bar, unsigned x, unsigned& nloc, unsigned& nx) {
    const unsigned G = gridDim.x * gridDim.y * gridDim.z;
    unsigned sum, cnt, mine, sp = 0u;
    for (;;) {
        sum = 0u; cnt = 0u; mine = 0u;
#pragma unroll
        for (unsigned jx = 0; jx < 16; ++jx) { const unsigned c = xb_ld(&bar[XB_XCNT(jx)]); sum += c; cnt += (c > 0u) ? 1u : 0u; mine = (jx == x) ? c : mine; }
        if (sum == G) break;
        __builtin_amdgcn_s_sleep(1);
        if ((++sp & 255u) == 0u) { if (xb_ld(&bar[XB_TMO])) break; if (sp > XB_SPIN_CAP) { atomicAdd(&bar[XB_TMO], 1u); break; } }
    }
    nloc = mine > 0u ? mine : 1u; nx = cnt > 0u ? cnt : 1u;
}
__device__ __forceinline__ void xcd_barrier(unsigned* bar, unsigned x, volatile LAS unsigned* st, const bool thread0) {
    asm volatile("s_waitcnt vmcnt(0)" ::: "memory");
    __syncthreads();
    if (thread0) {
        __builtin_amdgcn_s_waitcnt(0);
        unsigned nloc = st[0], nx = st[1];
        if (nloc == 0u) { xcd_barrier_complete(bar, x, nloc, nx); st[0] = nloc; st[1] = nx; }
        const unsigned old = xb_add(&bar[XB_XSUB(x)], 1u);
        const unsigned gen = old / nloc;
        if (old + 1u == (gen + 1u) * nloc) {
            __builtin_amdgcn_fence(__ATOMIC_RELEASE, "agent");
            asm volatile("s_waitcnt vmcnt(0)" ::: "memory");
            const unsigned og = xb_add(&bar[XB_TOP], 1u);
            const unsigned tg = og / nx;
            if (og + 1u == (tg + 1u) * nx) xb_add(&bar[XB_TOPGEN], 1u);
            else XB_SPIN(xb_ld(&bar[XB_TOPGEN]) == tg, bar);
            __builtin_amdgcn_fence(__ATOMIC_ACQUIRE, "agent");
            xb_add(&bar[XB_XGEN(x)], 1u);
            asm volatile("s_waitcnt vmcnt(0)" ::: "memory");
        } else {
            XB_SPIN(xb_ld(&bar[XB_XGEN(x)]) == gen, bar);
            __builtin_amdgcn_fence(__ATOMIC_ACQUIRE, "agent");
            asm volatile("s_waitcnt vmcnt(0)" ::: "memory");
        }
    }
    __syncthreads();
}

struct Args { const float* in[20]; float* out; unsigned char* ws; int ph_lo, ph_hi; };
constexpr int N_PHASES = 16;
constexpr int LDS_MISC = RING_BYTES + 4096;
#define REPS(k) for (int rep_ = 0; rep_ < (((PROBE_MASK >> (k)) & 1) ? PROBE_REP : 1); ++rep_)

__global__ void __launch_bounds__(NT, 2) fwd(Args args) {
    extern __shared__ __attribute__((aligned(16))) unsigned char lds_raw[];
    LAS unsigned char* lds = (LAS unsigned char*)lds_raw;
    const int G = gridDim.x, bx = blockIdx.x;
    const int wave_s = __builtin_amdgcn_readfirstlane((int)threadIdx.x >> 6);
#define TID_FLAT (wave_s * 64 + (int)__builtin_amdgcn_mbcnt_hi(~0u, __builtin_amdgcn_mbcnt_lo(~0u, 0u)))
    const int vcu = (G % 8 == 0) ? (bx % 8) * (G / 8) + bx / 8 : bx;
    const int NGW = G * NWAVES;
    unsigned char* ws = args.ws;
    const int lo = args.ph_lo, hi = args.ph_hi;
    volatile LAS unsigned* bst = (volatile LAS unsigned*)(lds + LDS_MISC);
#if MK_N_LAUNCHES == 1
    cg::grid_group grid = cg::this_grid();
    unsigned* const barw = (unsigned*)(ws + WS_CTL);
    if (threadIdx.x < 8) bst[threadIdx.x] = 0u;
    __syncthreads();
    const unsigned bxcc = xcd_barrier_post(barw, bst);
    if (hi > 1000) grid.sync();
#ifdef PROBE_T
#define PROBE_T_MARK(k) do { if ((k) == PROBE_T && bx == PROBE_T_BLK && TID_FLAT == 0) *(volatile LAS unsigned long long*)(lds + LDS_MISC + 136) = wall_clock64(); } while (0)
    if (bx == PROBE_T_BLK && threadIdx.x == 0) { *(volatile LAS unsigned long long*)(lds + LDS_MISC + 128) = wall_clock64(); *(volatile LAS unsigned long long*)(lds + LDS_MISC + 136) = 0ull; }
#else
#define PROBE_T_MARK(k) do { } while (0)
#endif
#define SEAM(k) do { PROBE_T_MARK(100 + (k)); if (lo <= (k) && (k) + 1 < hi) { REPS(15) xcd_barrier(barw, bxcc, bst, TID_FLAT == 0); } PROBE_T_MARK(k); } while (0)
#else
#define SEAM(k) do { } while (0)
#endif
#ifndef PH_MASK
#define PH_MASK 0xFFFFF
#endif
#define IN(k) (((PH_MASK >> (k)) & 1) && lo <= (k) && (k) < hi)
#define PH_IDS int tid = TID_FLAT; asm volatile("" : "+v"(tid)); const int lane = tid & 63; const int wave = __builtin_amdgcn_readfirstlane(tid >> 6); const int gw = vcu * NWAVES + wave; (void)lane; (void)gw;
#if MK_N_LAUNCHES == 1
#define PEER_GROUP int grp, mem, nmem; { const unsigned nl_ = bst[0], nx_ = bst[1]; if (nx_ == 8u && nl_ > 0u) { grp = (int)bst[3]; mem = (int)bst[2]; nmem = (int)nl_; } else { grp = bx & 7; mem = bx >> 3; nmem = G >> 3; } } \
    grp = __builtin_amdgcn_readfirstlane(grp); mem = __builtin_amdgcn_readfirstlane(mem); nmem = __builtin_amdgcn_readfirstlane(nmem);
#else
#define PEER_GROUP const int grp = bx & 7, mem = bx >> 3, nmem = G >> 3;
#endif
#define ABUF ((bf16*)(ws + WS_A))
#define PROJ ((bf16*)(ws + WS_PROJ))
#define UST ((bf16*)(ws + WS_US))
#define DECAY ((float*)(ws + WS_DECAY))

    if (IN(0)) REPS(0) { PH_IDS p0_prologue(args.in, ws, lds, vcu, G, tid, rep_ == 0 ? 7 : PROBE_SUB); }
    SEAM(0);
    if (IN(1)) {
        { pg8::Gemm g{ABUF, (const bf16*)(ws + WS_WIN), M, IN_COLS, 512}; pg8::StaticOrder S; S.init(M, IN_COLS, G, bx, ((PROBE_MASK >> 1) & 1) ? PROBE_REP : 1);
          pg8::EpiBf16I8 E{PROJ, IN_COLS, (const float*)(ws + WS_PART1), (const float*)(ws + WS_WIN + 4 * MiB)};
          pg8::gemm_phase_i8<pg8::EpiBf16I8, pg8::StaticOrder, PG8_ALIGN, PG8_SP2>(lds, g, S, E, TID_FLAT); }
    }
    SEAM(1);
    if (IN(2)) REPS(2) { PH_IDS
        for (int m = 4 * gw; m < M; m += 4 * NGW) conv_tokens4(PROJ, args.in[4], args.in[5], ABUF, m, lane);
        for (int u = vcu; u < BATCH * 128; u += G) h1_unit(u >> 7, u & 127, PROJ, args.in[6], UST, DECAY, lds, tid);
    }
    SEAM(2);
    if (IN(3)) REPS(3) { PH_IDS const bool dry = rep_ + 1 < ((((PROBE_MASK >> 3) & 1) ? PROBE_REP : 1)); h2_scan(UST, DECAY, gw, NGW, lane, dry ? (long)((WS_X + 288 * MiB - WS_US) / 4) : 0L); }
    SEAM(3);
    if (IN(4)) REPS(4) {
        { pg8::Gemm g{(const bf16*)(ws + WS_MEMN), (const bf16*)(ws + WS_WKV), MROWS, 1024, 1024}; pg8::StaticOrder S; S.init(MROWS, 1024, G, bx); pg8::EpiTile E{(bf16*)(ws + WS_KB), 4, 1};
          pg8::gemm_phase<pg8::EpiTile, pg8::StaticOrder, PG8_ALIGN, PG8_SP2>(lds, g, S, E, TID_FLAT); }
        { pg8::Gemm g{(const bf16*)(ws + WS_WKV) + (size_t)1024 * 1024, (const bf16*)(ws + WS_MEMN), 1024, MROWS, 1024}; pg8::StaticOrder S; S.init(1024, MROWS, G, (bx + 128) % G); pg8::EpiTile E{(bf16*)(ws + WS_VT), 1, 4};
          pg8::gemm_phase<pg8::EpiTile, pg8::StaticOrder, PG8_ALIGN, PG8_SP2>(lds, g, S, E, TID_FLAT); }
        PH_IDS
        if (G == 256) { const int xl = vcu & 31, xq = vcu >> 5; const bool kvcu = xl < 2 || (xl >= 16 && xl < 18);
            if (kvcu) { const int r = xq * 4 + (xl < 2 ? xl : xl - 14);
                H3In in; h3_load(in, (4 * r) >> 9, ((4 * r) >> 2) & 127, (4 * r) & 3, PROJ, UST, tid);
                for (int u = 4 * r; u < 4 * r + 4; ++u) h3_unit(u >> 9, (u >> 2) & 127, u & 3, PROJ, args.in[6], UST, args.in[7], ABUF, lds, tid, in, u + 1 < 4 * r + 4, u + 1); }
            else { const int q = xq * 28 + xl - (xl > 1 ? 2 : 0) - (xl > 17 ? 2 : 0);
                H3In in; h3_load(in, (128 + q) >> 9, ((128 + q) >> 2) & 127, (128 + q) & 3, PROJ, UST, tid);
                for (int u = 128 + q; u < BATCH * 128 * 4; u += 224) h3_unit(u >> 9, (u >> 2) & 127, u & 3, PROJ, args.in[6], UST, args.in[7], ABUF, lds, tid, in, u + 224 < BATCH * 128 * 4, u + 224); } }
        else if (vcu < BATCH * 128 * 4) { H3In in; h3_load(in, vcu >> 9, (vcu >> 2) & 127, vcu & 3, PROJ, UST, tid);
            for (int u = vcu; u < BATCH * 128 * 4; u += G) h3_unit(u >> 9, (u >> 2) & 127, u & 3, PROJ, args.in[6], UST, args.in[7], ABUF, lds, tid, in, u + G < BATCH * 128 * 4, u + G); }
    }
    SEAM(4);
    if (IN(5)) {
        pg8::Gemm g{ABUF, (const bf16*)(ws + WS_WOUT), M, 1024, 1024}; pg8::StaticOrder S; S.init(M, 1024, G, bx, ((PROBE_MASK >> 5) & 1) ? PROBE_REP : 1);
        pg8::EpiResid E{args.in[0], nullptr, (bf16*)(ws + WS_B1), (float*)(ws + WS_PART1), 0};
        pg8::gemm_phase<pg8::EpiResid, pg8::StaticOrder, PG8_ALIGN, PG8_SP2>(lds, g, S, E, TID_FLAT);
    }
    SEAM(5);
    if (IN(6)) {
        pg8::Gemm g{(const bf16*)(ws + WS_B1), (const bf16*)(ws + WS_WQ), M, 1024, 1024}; pg8::StaticOrder S; S.init(M, 1024, G, bx, ((PROBE_MASK >> 6) & 1) ? PROBE_REP : 1);
        pg8::EpiScaleBf16 E{(bf16*)(ws + WS_Q), 1024, (const float*)(ws + WS_PART1), QSCALE};
        pg8::gemm_phase<pg8::EpiScaleBf16, pg8::StaticOrder, PG8_ALIGN, PG8_SP2>(lds, g, S, E, TID_FLAT);
    }
    SEAM(6);
    if (IN(7)) REPS(7) { PH_IDS attn_phase((const bf16*)(ws + WS_Q), (const bf16*)(ws + WS_KB), (const bf16*)(ws + WS_VT), ABUF, lds, tid, vcu, G); }
    SEAM(7);
    if (IN(8)) {
        pg8::Gemm g{ABUF, (const bf16*)(ws + WS_WO), M, 1024, 1024}; pg8::StaticOrder S; S.init(M, 1024, G, bx, ((PROBE_MASK >> 8) & 1) ? PROBE_REP : 1);
        pg8::EpiResid E{nullptr, (const bf16*)(ws + WS_B1), (bf16*)(ws + WS_X2S), (float*)(ws + WS_PART2), M};
        pg8::gemm_phase<pg8::EpiResid, pg8::StaticOrder, PG8_ALIGN, PG8_SP2>(lds, g, S, E, TID_FLAT);
    }
    SEAM(8);
    if (IN(9)) REPS(9) { PH_IDS
        const int sel = rep_ == 0 ? 7 : PROBE_SUB;
        if (sel & 4) for (int m = gw; m < M; m += 4 * NGW) quant_x2_rows4((const bf16*)(ws + WS_X2S), ws + WS_XQ, (float*)(ws + WS_XSCALE), m, NGW, lane);
        if (sel & 2) for (int e = gw; e < NEXP; e += 2 * NGW) {
            const int e2 = e + NGW < NEXP ? e + NGW : e;
            quant_rows4(args.in[17], args.in[18], args.in[14], ws + WS_PDOWN, ws + WS_PUP, e, e2, lane, (float*)(ws + WS_DSCALE), (float*)(ws + WS_USCALE)); }
    }
    SEAM(9);
    if (IN(10)) {
        pg8::Gemm g{(const bf16*)(ws + WS_XQ), (const bf16*)(ws + WS_WEFF), M, 2048, 512, 64}; pg8::StaticOrder S; S.init(M, 2048, G, bx, ((PROBE_MASK >> 10) & 1) ? PROBE_REP : 1);
        pg8::EpiScoresI8 E{(unsigned short*)(ws + WS_SCT), M, (const float*)(ws + WS_PART2), (const float*)(ws + WS_XSCALE), (const float*)(ws + WS_WEFF + 2 * MiB)};
        pg8::gemm_phase_i8<pg8::EpiScoresI8, pg8::StaticOrder, PG8_ALIGN, PG8_SP2>(lds, g, S, E, TID_FLAT);
    }
    SEAM(10);
    if (IN(11)) REPS(11) { PH_IDS
        for (int task = gw; task < 8 * (M / 64); task += NGW) { const int head = task & 7, token = (task >> 3) * 64 + lane;
            peer_topk_task((const unsigned short*)(ws + WS_SCT), head, token, (unsigned short*)(ws + WS_IDX), (float*)(ws + WS_GATE), lds + tid * 32); }
    }
    SEAM(11);
    if (IN(12)) REPS(12) { PH_IDS PEER_GROUP
        peer_down_phase(ws + WS_XQ, ws + WS_PDOWN, (const unsigned short*)(ws + WS_IDX), (unsigned*)(ws + WS_SCT), grp, mem * NWAVES + wave, nmem * NWAVES, lane);
    }
    SEAM(12);
    if (IN(13)) REPS(13) { PH_IDS
        peer_combine_phase((const unsigned*)(ws + WS_SCT), (const float*)(ws + WS_PART2), (const unsigned short*)(ws + WS_IDX), (const float*)(ws + WS_DSCALE), (const float*)(ws + WS_USCALE),
                           (const float*)(ws + WS_XSCALE), (const float*)(ws + WS_GATE), (unsigned*)(ws + WS_WPK), (float*)(ws + WS_CORR), gw, NGW, lane); }
    SEAM(13);
    if (IN(14)) REPS(14) { PH_IDS PEER_GROUP
        const bool dry = rep_ + 1 < ((((PROBE_MASK >> 14) & 1) ? PROBE_REP : 1));
        peer_up_phase((bf16*)(ws + WS_X2S), (bf16*)(ws + (dry ? WS_PROBE_DUMMY : WS_X2S)), ws + WS_PUP, (const unsigned short*)(ws + WS_IDX), (const unsigned*)(ws + WS_WPK), (const float*)(ws + WS_CORR), grp, mem * NWAVES + wave, nmem * NWAVES, lane, lds + wave * 16384, lds + (wave < 2 ? RING_BYTES + wave * 1536 : LDS_MISC + 256 + (wave - 2) * 1536)); }
    SEAM(14);
    if (IN(15)) REPS(15) { PH_IDS final_norm_phase((const bf16*)(ws + WS_X2S), args.out, args.in[19], gw, NGW, lane); }
    PROBE_T_MARK(15);
#ifdef PROBE_T
    if (bx == PROBE_T_BLK && TID_FLAT == 0) { const unsigned long long t0_ = *(volatile LAS unsigned long long*)(lds + LDS_MISC + 128), t1_ = *(volatile LAS unsigned long long*)(lds + LDS_MISC + 136);
        if (t1_ > t0_) { const unsigned long long te_ = wall_clock64(); while (wall_clock64() - te_ < (t1_ - t0_) * PROBE_T_MUL) __builtin_amdgcn_s_sleep(8); } }
#endif
#undef IN
#undef SEAM
}

extern "C" void kernel_launch(void* const* d_in, const int* in_sizes, int n_in, void* d_out, int out_size, void* d_ws, size_t ws_size, hipStream_t stream) {
    static int grid = 0;
    if (grid == 0) {
        if (n_in != 20 || in_sizes[0] != M * D || out_size != M * D || ws_size < WS_END) { fprintf(stderr, "kernel_launch: unexpected shapes: n_in %d in0 %d out %d ws %zu (need %zu)\n", n_in, n_in > 0 ? in_sizes[0] : -1, out_size, ws_size, (size_t)WS_END); grid = -1; return; }
        int dev = 0, cus = 0, per_cu = 0;
        if (hipGetDevice(&dev) != hipSuccess || hipDeviceGetAttribute(&cus, hipDeviceAttributeMultiprocessorCount, dev) != hipSuccess) { grid = -1; return; }
        if (hipFuncSetAttribute((const void*)fwd, hipFuncAttributeMaxDynamicSharedMemorySize, LDS_BYTES) != hipSuccess) { fprintf(stderr, "kernel_launch: hipFuncSetAttribute failed\n"); grid = -1; return; }
        if (hipOccupancyMaxActiveBlocksPerMultiprocessor(&per_cu, (const void*)fwd, NT, LDS_BYTES) != hipSuccess || per_cu < 1) { fprintf(stderr, "kernel_launch: occupancy query says %d blocks per CU\n", per_cu); (void)hipGetLastError(); grid = -1; return; }
        grid = cus;
    }
    if (grid < 0) return;
    Args a{};
    for (int i = 0; i < 20; ++i) a.in[i] = (const float*)d_in[i];
    a.out = (float*)d_out; a.ws = (unsigned char*)d_ws;
#if MK_N_LAUNCHES == 1
    if (hipMemsetAsync((char*)d_ws + WS_CTL, 0, CTL_ZERO_BYTES, stream) != hipSuccess) { fprintf(stderr, "kernel_launch: hipMemsetAsync failed\n"); return; }
    a.ph_lo = 0; a.ph_hi = N_PHASES;
    void* kargs[] = {&a};
    hipError_t e = hipLaunchCooperativeKernel((const void*)fwd, dim3(grid), dim3(NT), kargs, LDS_BYTES, stream);
    if (e != hipSuccess) fprintf(stderr, "kernel_launch: cooperative launch failed: %s (grid %d)\n", hipGetErrorString(e), grid);
#else
    for (int ph = 0; ph < N_PHASES; ++ph) { a.ph_lo = ph; a.ph_hi = ph + 1; hipLaunchKernelGGL(fwd, dim3(grid), dim3(NT), LDS_BYTES, stream, a); }
#endif
}
```
